# Optimizing an MI355X kernel written in HIP

```python
import math
import jax, jax.numpy as jnp
from jax import lax
import numpy as np

D_MODEL = 1024
BATCH = 8
SEQ = 2048
DEPTH = 1

CHUNK = 64
CONV_A_GROUPS = 8
CONV_A_GROUP_DIM = D_MODEL // 16
CONV_A_DIM = CONV_A_GROUPS * CONV_A_GROUP_DIM
CONV_A_WIDTH = 3
DN_HEADS = 4
DN_HEAD_DIM = D_MODEL // 8
DN_DIM = DN_HEADS * DN_HEAD_DIM
DN_CONV_WIDTH = 4
MIX_DIM = CONV_A_DIM + DN_DIM
IN_PROJ_DIM = 3 * CONV_A_DIM + 4 * DN_DIM + 2 * DN_HEADS
N_GROUPS = 4
EXPERTS_PER_GROUP = 8
N_EXPERTS = N_GROUPS * EXPERTS_PER_GROUP
TOP_K = 2
EXPERT_FF = D_MODEL // 2
MOE_BLOCK = 128
EPS = 1e-6

kernel_name = "hybrid_conv_deltanet_hmoe_block"


def rms_norm(x, g):
    xf = x.astype(jnp.float32)
    y = xf * lax.rsqrt(jnp.mean(xf * xf, axis=-1, keepdims=True) + EPS)
    return (y * g.astype(jnp.float32)).astype(x.dtype)


def causal_dwconv(x, w):
    K = w.shape[0]
    S = x.shape[1]
    xp = jnp.pad(x, ((0, 0), (K - 1, 0), (0, 0)))
    y = xp[:, 0:S] * w[0]
    for j in range(1, K):
        y = y + xp[:, j:j + S] * w[j]
    return y


def short_conv_mixer(hx, b, c, conv_w, norm_g):
    Bsz, S, _ = hx.shape
    y = b * causal_dwconv(c * hx, conv_w)
    y = y.reshape(Bsz, S, CONV_A_GROUPS, CONV_A_GROUP_DIM)
    y = rms_norm(y, norm_g.reshape(CONV_A_GROUPS, CONV_A_GROUP_DIM))
    return y.reshape(Bsz, S, CONV_A_DIM)


def chunk_gated_delta(q, k, v, beta, g):
    Bsz, H, S, dk = q.shape
    dv = v.shape[-1]
    n = S // CHUNK

    def chunks(t):
        return t.reshape((Bsz, H, n, CHUNK) + t.shape[3:])

    q, k, v, beta, g = chunks(q), chunks(k), chunks(v), chunks(beta), chunks(g)
    g = jnp.cumsum(g, axis=-1)
    causal = jnp.tril(jnp.ones((CHUNK, CHUNK), bool))
    strict = jnp.tril(jnp.ones((CHUNK, CHUNK), bool), -1)
    decay = jnp.exp(jnp.where(causal, g[..., :, None] - g[..., None, :], -jnp.inf))
    k_beta = k * beta[..., None]
    L = jnp.where(strict, jnp.einsum('bhncd,bhnjd->bhncj', k_beta, k) * decay, 0.0)
    eye = jnp.eye(CHUNK, dtype=jnp.float32)
    rhs = jnp.concatenate([v * beta[..., None], k_beta * jnp.exp(g)[..., None]], axis=-1)
    uw = lax.linalg.triangular_solve(eye + L, rhs, left_side=True, lower=True, unit_diagonal=True)
    u, w = uw[..., :dv], uw[..., dv:]
    intra = jnp.einsum('bhncd,bhnjd->bhncj', q, k) * decay
    q_dec = q * jnp.exp(g)[..., None]
    g_last = g[..., -1]
    k_dec = k * jnp.exp(g_last[..., None] - g)[..., None]

    def to_scan(t):
        return jnp.moveaxis(t, 2, 0)

    xs = (to_scan(u), to_scan(w), to_scan(q_dec), to_scan(intra), to_scan(k_dec), to_scan(g_last))

    def step(state, inp):
        u_i, w_i, qd_i, a_i, kd_i, gl_i = inp
        v_new = u_i - jnp.einsum('bhck,bhkv->bhcv', w_i, state)
        o_i = jnp.einsum('bhck,bhkv->bhcv', qd_i, state) + jnp.einsum('bhcj,bhjv->bhcv', a_i, v_new)
        state = state * jnp.exp(gl_i)[..., None, None] + jnp.einsum('bhck,bhcv->bhkv', kd_i, v_new)
        return state, o_i

    s0 = jnp.zeros((Bsz, H, dk, dv), jnp.float32)
    _, o = lax.scan(step, s0, xs)
    return jnp.moveaxis(o, 0, 2).reshape(Bsz, H, S, dv)


def gated_deltanet(q, k, v, z, beta_logit, a_logit, conv_w, a_log, dt_bias, norm_g):
    Bsz, S, _ = q.shape
    dtype = q.dtype
    qkv = jax.nn.silu(causal_dwconv(jnp.concatenate([q, k, v], axis=-1), conv_w)).astype(jnp.float32)
    q, k, v = jnp.split(qkv, 3, axis=-1)

    def heads(t):
        return t.reshape(Bsz, S, DN_HEADS, DN_HEAD_DIM).transpose(0, 2, 1, 3)

    q, k, v = heads(q), heads(k), heads(v)
    q = q * lax.rsqrt(jnp.sum(q * q, axis=-1, keepdims=True) + EPS) * (DN_HEAD_DIM ** -0.5)
    k = k * lax.rsqrt(jnp.sum(k * k, axis=-1, keepdims=True) + EPS)
    beta = jax.nn.sigmoid(beta_logit.astype(jnp.float32)).transpose(0, 2, 1)
    g = (-jnp.exp(a_log.astype(jnp.float32))
         * jax.nn.softplus(a_logit.astype(jnp.float32) + dt_bias.astype(jnp.float32))).transpose(0, 2, 1)
    o = chunk_gated_delta(q, k, v, beta, g).transpose(0, 2, 1, 3)
    zf = z.astype(jnp.float32).reshape(Bsz, S, DN_HEADS, DN_HEAD_DIM)
    o = rms_norm(o, norm_g) * jax.nn.silu(zf)
    return o.reshape(Bsz, S, DN_DIM).astype(dtype)


def hier_moe(h, router_group_w, router_expert_w, w_gate, w_up, w_down):
    N, D = h.shape
    group_logits = (h @ router_group_w).astype(jnp.float32)
    group_idx = jnp.argmax(group_logits, axis=-1)
    group_prob = jnp.take_along_axis(jax.nn.softmax(group_logits, axis=-1), group_idx[:, None], axis=1)
    exp_logits = (h @ router_expert_w).astype(jnp.float32).reshape(N, N_GROUPS, EXPERTS_PER_GROUP)
    exp_logits = jnp.take_along_axis(exp_logits, group_idx[:, None, None], axis=1)[:, 0]
    top_p, top_local = lax.top_k(jax.nn.softmax(exp_logits, axis=-1), TOP_K)
    gate = group_prob * top_p / jnp.sum(top_p, axis=-1, keepdims=True)
    expert_id = (group_idx[:, None] * EXPERTS_PER_GROUP + top_local).astype(jnp.int32)

    flat_e = expert_id.reshape(-1)
    flat_tok = jnp.repeat(jnp.arange(N, dtype=jnp.int32), TOP_K)
    flat_gate = gate.reshape(-1)
    order = jnp.argsort(flat_e)
    sorted_e = flat_e[order]
    counts = jnp.bincount(flat_e, length=N_EXPERTS)
    padded = (counts + MOE_BLOCK - 1) // MOE_BLOCK * MOE_BLOCK
    pad_end = jnp.cumsum(padded)
    pad_start = pad_end - padded
    start = jnp.cumsum(counts) - counts
    dest = pad_start[sorted_e] + jnp.arange(N * TOP_K, dtype=jnp.int32) - start[sorted_e]
    P = N * TOP_K + N_EXPERTS * MOE_BLOCK
    slot_tok = jnp.full((P,), N, jnp.int32).at[dest].set(flat_tok[order])
    slot_gate = jnp.zeros((P,), jnp.float32).at[dest].set(flat_gate[order])
    n_blocks = P // MOE_BLOCK
    block_expert = jnp.minimum(
        jnp.searchsorted(pad_end, jnp.arange(n_blocks, dtype=jnp.int32) * MOE_BLOCK, side='right'),
        N_EXPERTS - 1)
    h_pad = jnp.concatenate([h, jnp.zeros((1, D), h.dtype)], axis=0)
    xb = h_pad[slot_tok].reshape(n_blocks, MOE_BLOCK, D)

    def expert_block(args):
        xblk, e = args
        a = xblk @ w_gate[e]
        b = xblk @ w_up[e]
        return (jax.nn.silu(a) * b) @ w_down[e]

    yb = lax.map(expert_block, (xb, block_expert)).reshape(P, D)
    out = jnp.zeros((N + 1, D), jnp.float32).at[slot_tok].add(yb.astype(jnp.float32) * slot_gate[:, None])
    return out[:N].astype(h.dtype)


def setup_inputs(seed: int = 0) -> dict:
    key = jax.random.key(seed)
    ks = jax.random.split(key, 18)
    f32 = jnp.float32

    def normal(k, shape, scale):
        return jax.random.normal(k, shape, f32) * scale

    def gain(k, shape):
        return 1.0 + 0.05 * jax.random.normal(k, shape, f32)

    dt = jnp.exp(jax.random.uniform(ks[7], (DEPTH, DN_HEADS), f32, math.log(1e-3), math.log(1e-1)))
    return {
        "x": normal(ks[0], (BATCH, SEQ, D_MODEL), 1.0),
        "mix_norm_g": gain(ks[1], (DEPTH, D_MODEL)),
        "w_in": normal(ks[2], (DEPTH, D_MODEL, IN_PROJ_DIM), D_MODEL ** -0.5),
        "conv_a_w": normal(ks[3], (DEPTH, CONV_A_WIDTH, CONV_A_DIM), CONV_A_WIDTH ** -0.5),
        "conv_a_norm_g": gain(ks[4], (DEPTH, CONV_A_DIM)),
        "dn_conv_w": normal(ks[5], (DEPTH, DN_CONV_WIDTH, 3 * DN_DIM), DN_CONV_WIDTH ** -0.5),
        "dn_a_log": jnp.log(jax.random.uniform(ks[6], (DEPTH, DN_HEADS), f32, 1.0, 16.0)),
        "dn_dt_bias": dt + jnp.log(-jnp.expm1(-dt)),
        "dn_norm_g": gain(ks[8], (DEPTH, DN_HEAD_DIM)),
        "w_out": normal(ks[9], (DEPTH, MIX_DIM, D_MODEL), MIX_DIM ** -0.5),
        "ffn_norm_g": gain(ks[10], (DEPTH, D_MODEL)),
        "router_group_w": normal(ks[11], (DEPTH, D_MODEL, N_GROUPS), D_MODEL ** -0.5),
        "router_expert_w": normal(ks[12], (DEPTH, D_MODEL, N_EXPERTS), D_MODEL ** -0.5),
        "w_gate": normal(ks[13], (DEPTH, N_EXPERTS, D_MODEL, EXPERT_FF), D_MODEL ** -0.5),
        "w_up": normal(ks[14], (DEPTH, N_EXPERTS, D_MODEL, EXPERT_FF), D_MODEL ** -0.5),
        "w_down": normal(ks[15], (DEPTH, N_EXPERTS, EXPERT_FF, D_MODEL), EXPERT_FF ** -0.5),
        "final_norm_g": gain(ks[16], (D_MODEL,)),
    }


def reference(x, mix_norm_g, w_in, conv_a_w, conv_a_norm_g, dn_conv_w, dn_a_log, dn_dt_bias,
              dn_norm_g, w_out, ffn_norm_g, router_group_w, router_expert_w, w_gate, w_up, w_down,
              final_norm_g):
    Bsz, S, D = x.shape
    sizes = (CONV_A_DIM,) * 3 + (DN_DIM,) * 4 + (DN_HEADS,) * 2
    split_idx = []
    acc = 0
    for s in sizes[:-1]:
        acc += s
        split_idx.append(acc)
    for l in range(DEPTH):
        h = rms_norm(x, mix_norm_g[l])
        proj = h @ w_in[l]
        a_h, a_b, a_c, d_q, d_k, d_v, d_z, d_beta, d_alpha = jnp.split(proj, split_idx, axis=-1)
        y_a = short_conv_mixer(a_h, a_b, a_c, conv_a_w[l], conv_a_norm_g[l])
        y_b = gated_deltanet(d_q, d_k, d_v, d_z, d_beta, d_alpha, dn_conv_w[l], dn_a_log[l],
                             dn_dt_bias[l], dn_norm_g[l])
        x = x + jnp.concatenate([y_a, y_b], axis=-1) @ w_out[l]
        h = rms_norm(x, ffn_norm_g[l]).reshape(Bsz * S, D)
        x = x + hier_moe(h, router_group_w[l], router_expert_w[l], w_gate[l], w_up[l], w_down[l]).reshape(Bsz, S, D)
    return rms_norm(x, final_norm_g)
```

```cpp
#include <hip/hip_runtime.h>
#include <cstdio>
#include <cstdint>

constexpr int BATCH = 8, SEQ = 2048, DM = 1024, NTOK = BATCH * SEQ;
constexpr int NH = 4, HD = 128, NPROJ = 3592, NPB = 3584;
constexpr int C_AH = 0, C_AB = 512, C_AC = 1024, C_Q = 1536, C_K = 2048, C_V = 2560, C_Z = 3072;
constexpr int NE = 32, FF = 512;
constexpr float EPS = 1e-6f;
constexpr int NT = 512;
#ifndef REP_PHASE
#define REP_PHASE -1
#endif
#define REP(k) for (int rep_ = 0; rep_ < ((REP_PHASE == (k)) ? 2 : 1); ++rep_)
constexpr int LDS_BYTES = 144 * 1024;
constexpr int LDS_TAB = 131072;

typedef unsigned short bf16_t;
constexpr size_t MiB = 1u << 20;
constexpr size_t WS_CTL = 0;
constexpr size_t WS_BAR = 65536;
constexpr size_t CTL_ZERO_BYTES = 131072;
constexpr size_t WS_RSTD2 = 1 * MiB;
constexpr size_t WS_TOKE = WS_RSTD2 + 65536;
constexpr size_t WS_TOKG = WS_TOKE + 131072;
constexpr size_t WS_TOKP = WS_TOKG + 131072;
constexpr size_t WS_SLOTTOK = WS_TOKP + 131072;
constexpr size_t WS_GL = WS_SLOTTOK + 131072;
constexpr size_t WS_CNTB = WS_GL + 8192;
constexpr size_t WS_BG = 2 * MiB;
constexpr size_t WS_WIN = 3 * MiB;
constexpr size_t WS_WOUT = 10 * MiB;
constexpr size_t WS_WGU = 12 * MiB;
constexpr size_t WS_WD = 76 * MiB;
constexpr size_t WS_PROJ = 108 * MiB;
constexpr size_t WS_HB = 220 * MiB;
constexpr size_t WS_YMIX = 220 * MiB;
constexpr size_t WS_AQK = 252 * MiB;
constexpr size_t WS_H2B = 108 * MiB;
constexpr size_t WS_ACT = 140 * MiB;
constexpr size_t WS_YEXP = 173 * MiB;

struct Params { const float* in[17]; float* out; unsigned char* ws; };

__device__ __forceinline__ float wave_sum(float v) {
#pragma unroll
    for (int o = 1; o < 64; o <<= 1) v += __shfl_xor(v, o);
    return v;
}
__device__ __forceinline__ float silu_f(float x) { return x / (1.f + expf(-x)); }
__device__ __forceinline__ float sigmoid_f(float x) { return 1.f / (1.f + expf(-x)); }
__device__ __forceinline__ float softplus_f(float x) { return fmaxf(x, 0.f) + log1pf(expf(-fabsf(x))); }
__device__ __forceinline__ float bf2f(bf16_t h) { return __uint_as_float((unsigned)h << 16); }
__device__ __forceinline__ unsigned f2bf(float f) { unsigned u = __float_as_uint(f); return (u + 0x7fffu + ((u >> 16) & 1u)) >> 16; }
__device__ __forceinline__ unsigned pk2(float lo, float hi) { return f2bf(lo) | (f2bf(hi) << 16); }


__device__ __forceinline__ float reduce8_tr(const float (&v)[8], int lane) {
    float a[4], b[2];
#pragma unroll
    for (int i = 0; i < 4; ++i) { const bool hi = lane & 32; const float send = hi ? v[i] : v[i + 4], keep = hi ? v[i + 4] : v[i]; a[i] = keep + __shfl_xor(send, 32); }
#pragma unroll
    for (int i = 0; i < 2; ++i) { const bool hi = lane & 16; const float send = hi ? a[i] : a[i + 2], keep = hi ? a[i + 2] : a[i]; b[i] = keep + __shfl_xor(send, 16); }
    const bool hi = lane & 8; const float send = hi ? b[0] : b[1], keep = hi ? b[1] : b[0];
    float c = keep + __shfl_xor(send, 8);
    c += __shfl_xor(c, 4); c += __shfl_xor(c, 2); c += __shfl_xor(c, 1);
    return c;
}
__device__ __forceinline__ float reduce4_tr(const float (&v)[4], int lane) {
    float a[2];
#pragma unroll
    for (int i = 0; i < 2; ++i) { const bool hi = lane & 32; const float send = hi ? v[i] : v[i + 2], keep = hi ? v[i + 2] : v[i]; a[i] = keep + __shfl_xor(send, 32); }
    const bool hi = lane & 16; const float send = hi ? a[0] : a[1], keep = hi ? a[1] : a[0];
    float c = keep + __shfl_xor(send, 16);
    c += __shfl_xor(c, 8); c += __shfl_xor(c, 4); c += __shfl_xor(c, 2); c += __shfl_xor(c, 1);
    return c;
}
__device__ __forceinline__ float lane_bcast(float v, int src) { return __int_as_float(__builtin_amdgcn_readlane(__float_as_int(v), src)); }

namespace pg8 {
#define PG8_LAS __attribute__((address_space(3)))
typedef short bf16x8 __attribute__((ext_vector_type(8)));
typedef float f32x4 __attribute__((ext_vector_type(4)));
typedef unsigned u32x4 __attribute__((ext_vector_type(4)));
constexpr int BM = 256, BK = 64, HALF = 128, HTB = HALF * BK * 2, STAGE_BYTES = 8 * HTB, NXCD = 8, WGM = 8;

__host__ __device__ __forceinline__ int lds_byte(int r, int c) { const int st = (r >> 4) * 2 + (c >> 5), rr = r & 15, cc = c & 31, ob = rr * 64 + cc * 2; return st * 1024 + (ob ^ (((ob >> 9) & 1) << 5)); }
__host__ __device__ __forceinline__ void stage_rc(int b, int& R, int& C) { const int st = b / 1024, sb = b % 1024, swz = sb ^ (((sb >> 9) & 1) << 5); R = (st >> 1) * 16 + swz / 64; C = (st & 1) * 32 + (swz % 64) / 2; }
__host__ __device__ __forceinline__ int perm32(int rho) { const int n = rho >> 4, i = rho & 15; return 8 * (i >> 2) + 4 * n + (i & 3); }

struct Unit { int arow0, rowend, pn; const char* B; };
struct Gemm { const bf16_t* A; int K; const int* gidx; };

struct DenseOrder {
    int nM, nN, nwg, G, c, M; const char* Bt; size_t tstep;
    __device__ void init(int M_, int N, int K, const bf16_t* Bt_, int G_, int c_) { M = M_; nM = M / BM; nN = N / BM; nwg = nM * nN; G = G_; c = c_; Bt = (const char*)Bt_; tstep = (size_t)BM * K * 2; }
    __device__ bool next(int i, Unit& u) const {
        const long L = (long)i * G + c; if (L >= nwg) return false;
        int wgid = (int)L; { const int q = nwg / NXCD, r = nwg % NXCD, xcd = wgid % NXCD, off = wgid / NXCD; wgid = (xcd < r ? xcd * (q + 1) : r * (q + 1) + (xcd - r) * q) + off; }
        const int nig = WGM * nN, gid = wgid / nig, fm = gid * WGM, gsz = (nM - fm) < WGM ? (nM - fm) : WGM;
        const int pm = fm + ((wgid % nig) % gsz); u.pn = (wgid % nig) / gsz; u.arow0 = pm * BM; u.rowend = M; u.B = Bt + (size_t)u.pn * tstep; return true;
    }
};

typedef __bf16 bf16x2_t __attribute__((ext_vector_type(2)));
typedef float f32x2_t __attribute__((ext_vector_type(2)));
__device__ __forceinline__ unsigned cvt_pk_bf16(float lo, float hi) { const f32x2_t v = {lo, hi}; return __builtin_bit_cast(unsigned, __builtin_convertvector(v, bf16x2_t)); }

struct EpiBf16 {
    static constexpr bool PERM = true;
    bf16_t* O; int ldc;
    __device__ __forceinline__ void operator()(const f32x4 (&acc)[2][2][4][2], const Unit& u, int wr, int wc, int fr, int fq) const {
        const int row0 = u.arow0 + wr * 64 + fr, col0 = u.pn * BM + wc * 32 + 8 * fq;
#pragma unroll
        for (int ai = 0; ai < 2; ++ai)
#pragma unroll
            for (int m = 0; m < 4; ++m) { const int row = row0 + ai * HALF + m * 16; bf16_t* rowp = O + (size_t)row * ldc + col0;
                if (row < u.rowend) {
#pragma unroll
                    for (int bj = 0; bj < 2; ++bj) { const f32x4 v0 = acc[ai][bj][m][0], v1 = acc[ai][bj][m][1];
                        u32x4 w; w.x = cvt_pk_bf16(v0[0], v0[1]); w.y = cvt_pk_bf16(v0[2], v0[3]); w.z = cvt_pk_bf16(v1[0], v1[1]); w.w = cvt_pk_bf16(v1[2], v1[3]);
                        *(u32x4*)(rowp + bj * HALF) = w; } } }
    }
};
struct EpiResid {
    static constexpr bool PERM = false;
    const float* base; float* C; int ldc;
    __device__ __forceinline__ void operator()(const f32x4 (&acc)[2][2][4][2], const Unit& u, int wr, int wc, int fr, int fq) const {
        const int row0 = u.arow0 + wr * 64 + fr, col0 = u.pn * BM + wc * 32 + 4 * fq;
#pragma unroll
        for (int ai = 0; ai < 2; ++ai) {
            f32x4 bv[4][2][2];
#pragma unroll
            for (int m = 0; m < 4; ++m) { const size_t off = (size_t)(row0 + ai * HALF + m * 16) * ldc + col0;
#pragma unroll
                for (int bj = 0; bj < 2; ++bj)
#pragma unroll
                    for (int n = 0; n < 2; ++n) bv[m][bj][n] = *(const f32x4*)(base + off + bj * HALF + n * 16); }
#pragma unroll
            for (int m = 0; m < 4; ++m) { const size_t off = (size_t)(row0 + ai * HALF + m * 16) * ldc + col0;
#pragma unroll
                for (int bj = 0; bj < 2; ++bj)
#pragma unroll
                    for (int n = 0; n < 2; ++n) *(f32x4*)(C + off + bj * HALF + n * 16) = bv[m][bj][n] + acc[ai][bj][m][n]; }
        }
    }
};
struct EpiAct {
    static constexpr bool PERM = true;
    bf16_t* O;
    __device__ __forceinline__ void operator()(const f32x4 (&acc)[2][2][4][2], const Unit& u, int wr, int wc, int fr, int fq) const {
        const int row0 = u.arow0 + wr * 64 + fr, col0 = u.pn * HALF + wc * 32 + 8 * fq;
#pragma unroll
        for (int ai = 0; ai < 2; ++ai)
#pragma unroll
            for (int m = 0; m < 4; ++m) { const int row = row0 + ai * HALF + m * 16;
                if (row < u.rowend) { float v[8];
#pragma unroll
                    for (int n = 0; n < 2; ++n)
#pragma unroll
                        for (int j = 0; j < 4; ++j) { const float gt = acc[ai][0][m][n][j], up = acc[ai][1][m][n][j]; v[n * 4 + j] = gt * __builtin_amdgcn_rcpf(1.f + __builtin_amdgcn_exp2f(-1.4426950408889634f * gt)) * up; }
                    u32x4 w; w.x = cvt_pk_bf16(v[0], v[1]); w.y = cvt_pk_bf16(v[2], v[3]); w.z = cvt_pk_bf16(v[4], v[5]); w.w = cvt_pk_bf16(v[6], v[7]);
                    *(u32x4*)(O + (size_t)row * 512 + col0) = w; } }
    }
};
struct GroupedOrder {
    const int* Loff; const int* Ttile; int nunits, G, c; const char* Bt; size_t estride, tstep;
    __device__ bool next(int i, Unit& u) const {
        const int L = (G == 256) ? ((i * 8 + (c & 7)) * 32 + (c >> 3)) : (i * G + c);
        if (L >= nunits) return false;
        const int tile = L >> 2; u.pn = L & 3;
        int e = 0; while (Ttile[e + 1] <= tile) ++e;
        u.arow0 = Loff[e] + (tile - Ttile[e]) * BM; u.rowend = Loff[e + 1]; u.B = Bt + (size_t)e * estride + (size_t)u.pn * tstep; return true;
    }
};

template <class Epi, class Sched, bool GATHER, bool ALIGN_EPI>
__device__ __forceinline__ void gemm_phase(PG8_LAS unsigned char* lds, const Gemm g, const Sched& S, const Epi& E) {
    const int tid = threadIdx.x, wid = __builtin_amdgcn_readfirstlane(tid >> 6), lane = tid & 63, wr = wid >> 2, wc = wid & 3, fr = lane & 15, fq = lane >> 4;
    const int K = g.K, nt = K / BK;
    int RA[2], CA[2]; unsigned voffB[2];
#pragma unroll
    for (int i = 0; i < 2; ++i) { int R, C; stage_rc(tid * 16 + i * 8192, R, C); const int Rb = Epi::PERM ? ((R & ~31) + perm32(R & 31)) : R;
        RA[i] = R; CA[i] = C; voffB[i] = (unsigned)(Rb * K + C) * 2u; }
    const size_t kstep = (size_t)(BK * 2);
    const size_t hstep = (size_t)HALF * K * 2;
    const unsigned ldsw = (unsigned)wid * 1024u;
    const int aoff = lds_byte(wr * 64 + fr, fq * 8), boff = lds_byte(wc * 32 + fr, fq * 8);
    const char* A0 = (const char*)g.A;
#define PG8_SA(b, h) (((b) * 2 + (h)) * HTB)
#define PG8_SB(b, h) ((4 + (b) * 2 + (h)) * HTB)
#define PG8_STAGE(bufoff, gbase, voff) do { _Pragma("unroll") for (int _i = 0; _i < 2; ++_i) \
        __builtin_amdgcn_global_load_lds((const unsigned*)((const char*)(gbase) + (voff)[_i]), (PG8_LAS unsigned*)(lds + (bufoff) + ldsw + _i * 8192), 16, 0, 0); } while (0)
#define PG8_LDA(dst, b, h) do { _Pragma("unroll") for (int m = 0; m < 4; ++m) _Pragma("unroll") for (int k = 0; k < 2; ++k) dst[m][k] = *(const PG8_LAS bf16x8*)(lds + PG8_SA(b, h) + aoff + m * 2048 + k * 1024); } while (0)
#define PG8_LDB(dst, b, h) do { _Pragma("unroll") for (int n = 0; n < 2; ++n) _Pragma("unroll") for (int k = 0; k < 2; ++k) dst[n][k] = *(const PG8_LAS bf16x8*)(lds + PG8_SB(b, h) + boff + n * 2048 + k * 1024); } while (0)
#define PG8_MMA(ai, bj, At, Bt) do { __builtin_amdgcn_s_setprio(1); _Pragma("unroll") for (int m = 0; m < 4; ++m) _Pragma("unroll") for (int n = 0; n < 2; ++n) _Pragma("unroll") for (int k = 0; k < 2; ++k) \
        acc[ai][bj][m][n] = __builtin_amdgcn_mfma_f32_16x16x32_bf16(Bt[n][k], At[m][k], acc[ai][bj][m][n], 0, 0, 0); __builtin_amdgcn_s_setprio(0); } while (0)
#define PG8_WAIT_V(n) asm volatile("s_waitcnt vmcnt(" #n ")" ::: "memory")
#define PG8_WAIT_L(n) asm volatile("s_waitcnt lgkmcnt(" #n ")" ::: "memory")
#define PG8_BAR __builtin_amdgcn_s_barrier()
#define PG8_SCHED __builtin_amdgcn_sched_barrier(0)
#define PG8_AOFF(dst, u) do { _Pragma("unroll") for (int _h = 0; _h < 2; ++_h) _Pragma("unroll") for (int _i = 0; _i < 2; ++_i) { int _r = (u).arow0 + _h * HALF + RA[_i]; _r = _r < (u).rowend ? _r : (u).rowend - 1; \
        if (GATHER) _r = g.gidx[_r]; dst[_h][_i] = (unsigned)(_r * K + CA[_i]) * 2u; } } while (0)
    Unit cur, nxt; int ui = 0;
    if (!S.next(0, cur)) return;
    f32x4 acc[2][2][4][2];
#pragma unroll
    for (int a = 0; a < 2; ++a)
#pragma unroll
        for (int b = 0; b < 2; ++b)
#pragma unroll
            for (int m = 0; m < 4; ++m)
#pragma unroll
                for (int n = 0; n < 2; ++n) acc[a][b][m][n] = (f32x4){0.f, 0.f, 0.f, 0.f};
    bf16x8 At[4][2], B0[2][2], B1[2][2];
    unsigned cvA[2][2], nvA[2][2];
    PG8_AOFF(cvA, cur);
    const char* cB = cur.B;
    PG8_STAGE(PG8_SB(0, 0), cB, voffB); PG8_STAGE(PG8_SB(0, 1), cB + hstep, voffB); PG8_STAGE(PG8_SA(0, 0), A0, cvA[0]); PG8_STAGE(PG8_SA(0, 1), A0, cvA[1]);
    if (wr == 1) PG8_BAR;
    PG8_WAIT_V(2); PG8_BAR;
    PG8_STAGE(PG8_SB(1, 0), cB + kstep, voffB); PG8_STAGE(PG8_SA(1, 0), A0 + kstep, cvA[0]); PG8_STAGE(PG8_SB(1, 1), cB + hstep + kstep, voffB);
    PG8_WAIT_V(6); PG8_BAR;
    for (;;) {
        const bool has_next = S.next(ui + 1, nxt);
        if (has_next) { PG8_AOFF(nvA, nxt); } else {
#pragma unroll
            for (int h = 0; h < 2; ++h)
#pragma unroll
                for (int i = 0; i < 2; ++i) nvA[h][i] = cvA[h][i]; }
        const char* nB = has_next ? nxt.B : cB;
        for (int t = 0; t < nt; t += 2) {
            const bool last = (t == nt - 2);
            const char* a1 = A0 + (size_t)(t + 1) * kstep;
            const char* a2 = last ? A0 : A0 + (size_t)(t + 2) * kstep; const char* b2 = last ? nB : cB + (size_t)(t + 2) * kstep;
            const char* a3 = a2 + kstep; const char* b3 = b2 + kstep;
            unsigned s2[2][2];
#pragma unroll
            for (int h = 0; h < 2; ++h)
#pragma unroll
                for (int i = 0; i < 2; ++i) s2[h][i] = last ? nvA[h][i] : cvA[h][i];
            PG8_LDB(B0, 0, 0); PG8_LDB(B1, 0, 1); PG8_SCHED; PG8_LDA(At, 0, 0); PG8_STAGE(PG8_SA(1, 1), a1, cvA[1]);
            PG8_WAIT_V(8); PG8_WAIT_L(0); PG8_BAR; PG8_MMA(0, 0, At, B0); PG8_MMA(0, 1, At, B1); PG8_BAR; PG8_SCHED;
            PG8_LDA(At, 0, 1); PG8_STAGE(PG8_SB(0, 0), b2, voffB); PG8_STAGE(PG8_SB(0, 1), b2 + hstep, voffB); PG8_STAGE(PG8_SA(0, 0), a2, s2[0]);
            PG8_WAIT_V(8); PG8_WAIT_L(0); PG8_BAR; PG8_MMA(1, 0, At, B0); PG8_MMA(1, 1, At, B1); PG8_BAR; PG8_SCHED;
            PG8_LDB(B0, 1, 0); PG8_LDB(B1, 1, 1); PG8_SCHED; PG8_LDA(At, 1, 0); PG8_STAGE(PG8_SA(0, 1), a2, s2[1]);
            PG8_WAIT_V(8); PG8_WAIT_L(0); PG8_BAR; PG8_MMA(0, 0, At, B0); PG8_MMA(0, 1, At, B1); PG8_BAR; PG8_SCHED;
            PG8_LDA(At, 1, 1); PG8_STAGE(PG8_SB(1, 0), b3, voffB); PG8_STAGE(PG8_SB(1, 1), b3 + hstep, voffB); PG8_STAGE(PG8_SA(1, 0), a3, s2[0]);
            PG8_WAIT_V(8); PG8_WAIT_L(0); PG8_BAR; PG8_MMA(1, 0, At, B0); PG8_MMA(1, 1, At, B1); PG8_BAR; PG8_SCHED;
        }
        if constexpr (ALIGN_EPI) { if (wr == 0) PG8_BAR; }
        E(acc, cur, wr, wc, fr, fq);
        if (!has_next) break;
#pragma unroll
        for (int a = 0; a < 2; ++a)
#pragma unroll
            for (int b = 0; b < 2; ++b)
#pragma unroll
                for (int m = 0; m < 4; ++m)
#pragma unroll
                    for (int n = 0; n < 2; ++n) acc[a][b][m][n] = (f32x4){0.f, 0.f, 0.f, 0.f};
        cur = nxt; cB = nB; ++ui;
#pragma unroll
        for (int h = 0; h < 2; ++h)
#pragma unroll
            for (int i = 0; i < 2; ++i) cvA[h][i] = nvA[h][i];
        if constexpr (ALIGN_EPI) { if (wr == 1) PG8_BAR; }
    }
    PG8_WAIT_V(0);
    if constexpr (!ALIGN_EPI) { if (wr == 0) PG8_BAR; }
    PG8_BAR;
#undef PG8_SA
#undef PG8_SB
#undef PG8_STAGE
#undef PG8_LDA
#undef PG8_LDB
#undef PG8_MMA
#undef PG8_WAIT_V
#undef PG8_WAIT_L
#undef PG8_BAR
#undef PG8_SCHED
#undef PG8_AOFF
}
}


namespace dn {
typedef short bf16x8 __attribute__((ext_vector_type(8)));
typedef float f32x4 __attribute__((ext_vector_type(4)));
typedef unsigned u32x4 __attribute__((ext_vector_type(4)));
typedef unsigned u32x2 __attribute__((ext_vector_type(2)));
__device__ __forceinline__ int perm_pos(int kl) { return 8 * ((kl >> 2) & 3) + 4 * (kl >> 4) + (kl & 3); }
__device__ __forceinline__ int perm_inv(int p) { return 16 * ((p >> 2) & 1) + 4 * (p >> 3) + (p & 3); }
typedef __bf16 bf16x2_t __attribute__((ext_vector_type(2)));
typedef float f32x2_t __attribute__((ext_vector_type(2)));
__device__ __forceinline__ unsigned pkbf(float lo, float hi) { const f32x2_t v = {lo, hi}; return __builtin_bit_cast(unsigned, __builtin_convertvector(v, bf16x2_t)); }
__device__ __forceinline__ float lo_f(unsigned u) { return __uint_as_float(u << 16); }
__device__ __forceinline__ float hi_f(unsigned u) { return __uint_as_float(u & 0xffff0000u); }
constexpr int P2_LT = 0, P2_G = 16384, P2_QB = 17408, P2_KB = P2_QB + 17408, P2_RU = P2_KB + 17408, P2_RW = P2_RU + 32768;
constexpr int ROWB = 272;

struct DnBufs { bf16_t* UT; bf16_t* WN; bf16_t* QD; bf16_t* KDT; bf16_t* AQK; float* GL; };

__device__ __forceinline__ float silu_fast(float a) { return a * __builtin_amdgcn_rcpf(1.f + __builtin_amdgcn_exp2f(-1.4426950408889634f * a)); }
__device__ __forceinline__ void prep(unsigned char* lds, int tid, int bid, int G, const bf16_t* proj, const float* bg, const float* dn_conv_w, const DnBufs B) {
    const int lane = tid & 63, wave = tid >> 6;
    float* RU = (float*)(lds + P2_RU); float* RW = (float*)(lds + P2_RW); float* LT = (float*)(lds + P2_LT); float* GS = (float*)(lds + P2_G);
    const int nitems = BATCH * NH * (SEQ / 64);
    const int r0 = wave * 8;
    unsigned xin[11][3]; float gin, bin;
#define DN_PREP_LOAD(item_) do { const int bh_ = (item_) >> 5, c_ = (item_) & 31, b_ = bh_ >> 2, h_ = bh_ & 3, t0_ = c_ * 64; \
        _Pragma("unroll") for (int rr = 0; rr < 11; ++rr) { const int t = t0_ + r0 + rr - 3; \
            _Pragma("unroll") for (int wh = 0; wh < 3; ++wh) { const unsigned v_ = *(const unsigned*)(proj + ((size_t)b_ * SEQ + (t >= 0 ? t : 0)) * NPB + C_Q + wh * 512 + h_ * 128 + 2 * lane); xin[rr][wh] = (t >= 0) ? v_ : 0u; } } \
        gin = bg[((size_t)b_ * SEQ + t0_ + lane) * 8 + 4 + h_]; bin = bg[((size_t)b_ * SEQ + t0_ + lane) * 8 + h_]; } while (0)
    for (int item = bid; item < nitems; item += G) {
        const int bh = item >> 5, h = bh & 3;
        DN_PREP_LOAD(item);
        float cw[3][4][2];
#pragma unroll
        for (int wh = 0; wh < 3; ++wh)
#pragma unroll
            for (int j = 0; j < 4; ++j) { const float2 w2 = *(const float2*)(dn_conv_w + j * 1536 + wh * 512 + h * 128 + 2 * lane); cw[wh][j][0] = w2.x; cw[wh][j][1] = w2.y; }
        float Gc = gin;
#pragma unroll
        for (int o = 1; o < 64; o <<= 1) { const float t = __shfl_up(Gc, o); if (lane >= o) Gc += t; }
        const float glast = __shfl(Gc, 63), eGl = __expf(Gc), bel = bin;
        if (wave == 0) { GS[lane] = Gc; GS[64 + lane] = eGl; GS[128 + lane] = bel; GS[192 + lane] = __expf(glast - Gc); if (lane == 0) B.GL[item] = glast; }
#pragma unroll
        for (int rr = 0; rr < 8; ++rr) {
            const int i = r0 + rr;
            float val[3][2];
#pragma unroll
            for (int wh = 0; wh < 3; ++wh) { float a0 = 0.f, a1 = 0.f;
#pragma unroll
                for (int j = 0; j < 4; ++j) { a0 += lo_f(xin[rr + j][wh]) * cw[wh][j][0]; a1 += hi_f(xin[rr + j][wh]) * cw[wh][j][1]; }
                val[wh][0] = silu_fast(a0); val[wh][1] = silu_fast(a1); }
            float sq = val[0][0] * val[0][0] + val[0][1] * val[0][1], sk = val[1][0] * val[1][0] + val[1][1] * val[1][1];
#pragma unroll
            for (int o = 1; o < 64; o <<= 1) { sq += __shfl_xor(sq, o); sk += __shfl_xor(sk, o); }
            const float fq = rsqrtf(sq + EPS) * 0.08838834764831845f, fk = rsqrtf(sk + EPS);
            const float eG = __shfl(eGl, i), be = __shfl(bel, i);
            const float q0 = val[0][0] * fq, q1 = val[0][1] * fq, k0 = val[1][0] * fk, k1 = val[1][1] * fk;
            *(unsigned*)(lds + P2_QB + i * ROWB + 4 * lane) = pkbf(q0, q1);
            *(unsigned*)(lds + P2_KB + i * ROWB + 4 * lane) = pkbf(k0, k1);
            const int kl = (2 * lane) & 31, pos = ((2 * lane) & ~31) + perm_pos(kl);
            *(unsigned*)(B.QD + ((size_t)item * 64 + i) * 128 + pos) = pkbf(q0 * eG, q1 * eG);
            *(float2*)(RW + i * 128 + 2 * lane) = make_float2(be * eG * k0, be * eG * k1);
            *(float2*)(RU + i * 128 + 2 * lane) = make_float2(be * val[2][0], be * val[2][1]);
        }
        __syncthreads();
        {
            const int g = lane >> 4, cl = lane & 15, mi = wave >> 1, nj0 = 2 * (wave & 1);
            bf16x8 ka[4], qa[4];
#pragma unroll
            for (int s_ = 0; s_ < 4; ++s_) { ka[s_] = *(const bf16x8*)(lds + P2_KB + (16 * mi + cl) * ROWB + (32 * s_ + 8 * g) * 2); qa[s_] = *(const bf16x8*)(lds + P2_QB + (16 * mi + cl) * ROWB + (32 * s_ + 8 * g) * 2); }
#pragma unroll
            for (int nn = 0; nn < 2; ++nn) {
                const int nj = nj0 + nn;
                f32x4 akk = {0.f, 0.f, 0.f, 0.f}, aqk = {0.f, 0.f, 0.f, 0.f};
#pragma unroll
                for (int s_ = 0; s_ < 4; ++s_) { const bf16x8 kb = *(const bf16x8*)(lds + P2_KB + (16 * nj + cl) * ROWB + (32 * s_ + 8 * g) * 2);
                    akk = __builtin_amdgcn_mfma_f32_16x16x32_bf16(ka[s_], kb, akk, 0, 0, 0); aqk = __builtin_amdgcn_mfma_f32_16x16x32_bf16(qa[s_], kb, aqk, 0, 0, 0); }
                const int j = 16 * nj + cl; const float Gj = GS[j];
                float lt[4];
                const int jpos = (j & ~31) + perm_pos(j & 31);
#pragma unroll
                for (int x_ = 0; x_ < 4; ++x_) { const int i = 16 * mi + 4 * g + x_; const float dec = __expf(fminf(GS[i] - Gj, 0.f));
                    lt[x_] = (i > j) ? GS[128 + i] * akk[x_] * dec : 0.f;
                    const float a = (i >= j) ? aqk[x_] * dec : 0.f;
                    B.AQK[((size_t)item * 64 + i) * 64 + jpos] = (bf16_t)(pkbf(a, 0.f) & 0xffffu); }
                *(float4*)(LT + j * 64 + 16 * mi + 4 * g) = make_float4(lt[0], lt[1], lt[2], lt[3]);
            }
        }
        __syncthreads();
        if (tid < 256) {
            const float* src = (tid < 128) ? (RU + tid) : (RW + (tid - 128));
            typedef __attribute__((address_space(3))) float lds_f32;
            const lds_f32* LTp = (const lds_f32*)(LT); asm volatile("" : "+v"(LTp));
            float acc[64];
#pragma unroll
            for (int i = 0; i < 64; ++i) acc[i] = src[i * 128];
#pragma unroll
            for (int j = 0; j < 63; ++j) {
                const float xj = acc[j];
#pragma unroll
                for (int q = (j + 1) >> 2; q < 16; ++q) {
                    const f32x4 l4 = *(const __attribute__((address_space(3))) f32x4*)(LTp + j * 64 + 4 * q);
                    if (4 * q + 0 > j) acc[4 * q + 0] -= l4.x * xj;
                    if (4 * q + 1 > j) acc[4 * q + 1] -= l4.y * xj;
                    if (4 * q + 2 > j) acc[4 * q + 2] -= l4.z * xj;
                    if (4 * q + 3 > j) acc[4 * q + 3] -= l4.w * xj;
                }
            }
            if (tid < 128) {
                u32x4* dst = (u32x4*)(B.UT + ((size_t)item * 128 + tid) * 64);
#pragma unroll
                for (int q = 0; q < 8; ++q) { u32x4 w; w.x = pkbf(acc[8 * q], acc[8 * q + 1]); w.y = pkbf(acc[8 * q + 2], acc[8 * q + 3]); w.z = pkbf(acc[8 * q + 4], acc[8 * q + 5]); w.w = pkbf(acc[8 * q + 6], acc[8 * q + 7]); dst[q] = w; }
            } else {
                const int dk = tid - 128, pos = (dk & ~31) + perm_pos(dk & 31);
                bf16_t* dst = B.WN + (size_t)item * 64 * 128 + pos;
#pragma unroll
                for (int i = 0; i < 64; ++i) dst[i * 128] = (bf16_t)(pkbf(-acc[i], 0.f) & 0xffffu);
            }
        } else if (tid < 384) {
            const int dk = tid - 256;
            u32x4* dst = (u32x4*)(B.KDT + ((size_t)item * 128 + dk) * 64);
#pragma unroll
            for (int q = 0; q < 8; ++q) { float v[8];
#pragma unroll
                for (int e = 0; e < 8; ++e) { const int p_ = 8 * q + e, i = (p_ & ~31) + perm_inv(p_ & 31); v[e] = bf2f(*(const bf16_t*)(lds + P2_KB + i * ROWB + 2 * dk)) * GS[192 + i]; }
                u32x4 w; w.x = pkbf(v[0], v[1]); w.y = pkbf(v[2], v[3]); w.z = pkbf(v[4], v[5]); w.w = pkbf(v[6], v[7]); dst[q] = w; }
        }
        __syncthreads();
    }
#undef DN_PREP_LOAD
}

constexpr int SROW = 288, SKROW = 160;
constexpr int SC_WN = 0, SC_QD = 64 * SROW, SC_KDT = 128 * SROW, SC_AQK = SC_KDT + 128 * SKROW, SC_BUF = SC_AQK + 64 * SKROW  ;
__device__ __forceinline__ void scan(unsigned char* lds, int tid, int bid, int G, const DnBufs B, bf16_t* ymix) {
    (void)ymix;
    const int lane = tid & 63, wave = __builtin_amdgcn_readfirstlane(tid >> 6), g = lane >> 4, cl = lane & 15;
#define DN_BAR() do { asm volatile("s_waitcnt lgkmcnt(0)" ::: "memory"); __builtin_amdgcn_s_barrier(); asm volatile("" ::: "memory"); } while (0)
    for (int unit = bid; unit < 2 * BATCH * NH; unit += G) {
        const int bh = unit >> 1;
        __syncthreads();
        if (wave < 4) {
            const int wdv = 4 * (unit & 1) + wave, dv = 16 * wdv + cl;
            f32x4 S[8]; bf16x8 Sb[4];
#pragma unroll
            for (int r = 0; r < 8; ++r) S[r] = (f32x4){0.f, 0.f, 0.f, 0.f};
#pragma unroll
            for (int s_ = 0; s_ < 4; ++s_) Sb[s_] = (bf16x8){0, 0, 0, 0, 0, 0, 0, 0};
            const float eglv = __expf(B.GL[bh * 32 + (lane & 31)]);
            u32x2 uA[4], uB[4];
            f32x4 vn[4];
#define DN_LOAD_U(upre, c_) do { const size_t it_ = (size_t)(bh * 32 + (c_)); \
            _Pragma("unroll") for (int m_ = 0; m_ < 4; ++m_) upre[m_] = *(const u32x2*)(B.UT + (it_ * 128 + dv) * 64 + 16 * m_ + 4 * g); } while (0)
#define DN_VN(upre) do { _Pragma("unroll") for (int m = 0; m < 4; ++m) vn[m] = (f32x4){lo_f(upre[m].x), hi_f(upre[m].x), lo_f(upre[m].y), hi_f(upre[m].y)}; } while (0)
#define DN_SB() __builtin_amdgcn_sched_barrier(0)
#define DN_LDW(f, off_, m0_) do { _Pragma("unroll") for (int m = 0; m < 2; ++m) _Pragma("unroll") for (int s_ = 0; s_ < 4; ++s_) f[m * 4 + s_] = *(const bf16x8*)(buf + (off_) + (16 * ((m0_) + m) + cl) * SROW + (32 * s_ + 8 * g) * 2); } while (0)
#define DN_LDK(f, off_, r0_) do { _Pragma("unroll") for (int r = 0; r < 4; ++r) _Pragma("unroll") for (int s_ = 0; s_ < 2; ++s_) f[r * 2 + s_] = *(const bf16x8*)(buf + (off_) + (16 * ((r0_) + r) + cl) * SKROW + (32 * s_ + 8 * g) * 2); } while (0)
#define DN_MMW(acc, m0_, f) do { _Pragma("unroll") for (int s_ = 0; s_ < 4; ++s_) _Pragma("unroll") for (int m = 0; m < 2; ++m) acc[(m0_) + m] = __builtin_amdgcn_mfma_f32_16x16x32_bf16(f[m * 4 + s_], Sb[s_], acc[(m0_) + m], 0, 0, 0); } while (0)
#define DN_MMK(acc, r0_, f) do { _Pragma("unroll") for (int s_ = 0; s_ < 2; ++s_) _Pragma("unroll") for (int r = 0; r < 4; ++r) acc[(r0_) + r] = __builtin_amdgcn_mfma_f32_16x16x32_bf16(f[r * 2 + s_], Vb[s_], acc[(r0_) + r], 0, 0, 0); } while (0)
#define DN_CHUNK(bufoff_, c_) do { \
            const unsigned char* buf = lds + (bufoff_); const int item = bh * 32 + (c_); \
            const float egl = __shfl(eglv, (c_)); \
            f32x4 o[4]; \
            _Pragma("unroll") for (int m = 0; m < 4; ++m) o[m] = (f32x4){0.f, 0.f, 0.f, 0.f}; \
            bf16x8 fA[8], fB[8]; \
            DN_LDW(fA, SC_WN, 0); DN_LDW(fB, SC_WN, 2); DN_SB(); \
            DN_MMW(vn, 0, fA); DN_SB(); DN_LDW(fA, SC_QD, 0); DN_SB(); \
            DN_MMW(vn, 2, fB); DN_SB(); DN_LDW(fB, SC_QD, 2); DN_SB(); \
            bf16x8 Vb[2]; \
            _Pragma("unroll") for (int s_ = 0; s_ < 2; ++s_) { u32x4 w; w.x = pkbf(vn[2 * s_][0], vn[2 * s_][1]); w.y = pkbf(vn[2 * s_][2], vn[2 * s_][3]); w.z = pkbf(vn[2 * s_ + 1][0], vn[2 * s_ + 1][1]); w.w = pkbf(vn[2 * s_ + 1][2], vn[2 * s_ + 1][3]); \
                Vb[s_] = __builtin_bit_cast(bf16x8, w); } \
            DN_MMW(o, 0, fA); DN_SB(); DN_LDK(fA, SC_KDT, 0); DN_SB(); \
            DN_MMW(o, 2, fB); DN_SB(); DN_LDK(fB, SC_KDT, 4); DN_SB(); \
            _Pragma("unroll") for (int r = 0; r < 8; ++r) S[r] = S[r] * egl; \
            DN_MMK(S, 0, fA); DN_SB(); DN_LDK(fA, SC_AQK, 0); DN_SB(); \
            DN_MMK(S, 4, fB); DN_SB(); \
            DN_MMK(o, 0, fA); DN_SB(); \
            _Pragma("unroll") for (int s_ = 0; s_ < 4; ++s_) { u32x4 w; w.x = pkbf(S[2 * s_][0], S[2 * s_][1]); w.y = pkbf(S[2 * s_][2], S[2 * s_][3]); w.z = pkbf(S[2 * s_ + 1][0], S[2 * s_ + 1][1]); w.w = pkbf(S[2 * s_ + 1][2], S[2 * s_ + 1][3]); \
                Sb[s_] = __builtin_bit_cast(bf16x8, w); } \
            { bf16_t* od_ = B.UT + ((size_t)item * 128 + 16 * wdv) * 64 + lane; \
              _Pragma("unroll") for (int m = 0; m < 4; ++m) _Pragma("unroll") for (int x_ = 0; x_ < 4; ++x_) od_[(m * 4 + x_) * 64] = (bf16_t)(pkbf(o[m][x_], 0.f) & 0xffffu); } \
        } while (0)
            DN_LOAD_U(uA, 0); DN_LOAD_U(uB, 1);
            DN_BAR();
            for (int c = 0; c < SEQ / 64; c += 2) {
                DN_VN(uA); if (c + 2 < SEQ / 64) DN_LOAD_U(uA, c + 2);
                DN_CHUNK(0, c);
                DN_BAR();
                DN_VN(uB); if (c + 3 < SEQ / 64) DN_LOAD_U(uB, c + 3);
                DN_CHUNK(SC_BUF, c + 1);
                DN_BAR();
            }
#undef DN_LOAD_U
#undef DN_VN
#undef DN_SB
#undef DN_LDW
#undef DN_LDK
#undef DN_MMW
#undef DN_MMK
#undef DN_CHUNK
        } else {
            const int lt = tid - 256;
            const int o_w = (lt >> 4) * SROW + (lt & 15) * 16, o_k = (lt >> 3) * SKROW + (lt & 7) * 16;
            u32x4 pA[14], pB[14];
#define DN_LOADP(pre, c_) do { const size_t it_ = (size_t)(bh * 32 + (c_)); \
            _Pragma("unroll") for (int q = 0; q < 4; ++q) { pre[q] = *(const u32x4*)(B.WN + it_ * 8192 + (size_t)(lt + 256 * q) * 8); pre[4 + q] = *(const u32x4*)(B.QD + it_ * 8192 + (size_t)(lt + 256 * q) * 8); \
                pre[8 + q] = *(const u32x4*)(B.KDT + it_ * 8192 + (size_t)(lt + 256 * q) * 8); } \
            _Pragma("unroll") for (int q = 0; q < 2; ++q) pre[12 + q] = *(const u32x4*)(B.AQK + it_ * 4096 + (size_t)(lt + 256 * q) * 8); } while (0)
#define DN_WRITEP(pre, bufoff_) do { unsigned char* d_ = lds + (bufoff_); \
            _Pragma("unroll") for (int q = 0; q < 4; ++q) { *(u32x4*)(d_ + SC_WN + o_w + q * 16 * SROW) = pre[q]; *(u32x4*)(d_ + SC_QD + o_w + q * 16 * SROW) = pre[4 + q]; *(u32x4*)(d_ + SC_KDT + o_k + q * 32 * SKROW) = pre[8 + q]; } \
            _Pragma("unroll") for (int q = 0; q < 2; ++q) *(u32x4*)(d_ + SC_AQK + o_k + q * 32 * SKROW) = pre[12 + q]; } while (0)
            DN_LOADP(pA, 0); DN_LOADP(pB, 1);
            DN_WRITEP(pA, 0); DN_LOADP(pA, 2);
            DN_BAR();
            for (int c = 0; c < SEQ / 64; c += 2) {
                DN_WRITEP(pB, SC_BUF); if (c + 3 < SEQ / 64) DN_LOADP(pB, c + 3);
                DN_BAR();
                if (c + 2 < SEQ / 64) { DN_WRITEP(pA, 0); if (c + 4 < SEQ / 64) DN_LOADP(pA, c + 4); }
                DN_BAR();
            }
#undef DN_LOADP
#undef DN_WRITEP
        }
        __syncthreads();
    }
#undef DN_BAR
}
}

__device__ __forceinline__ void transpose_item(const float* W, int ldw, int k0, int n0, bf16_t* WT, int ldk, int dst_row0, float* scr_f, int lane) {
    unsigned* scr = (unsigned*)scr_f;
    const int c4 = (lane & 7) * 4, rq = lane >> 3;
    float4 lo[4], hi[4];
#pragma unroll
    for (int i = 0; i < 4; ++i) { const float* src = W + (size_t)(k0 + 2 * (rq + 8 * i)) * ldw + n0 + c4; lo[i] = *(const float4*)src; hi[i] = *(const float4*)(src + ldw); }
#pragma unroll
    for (int i = 0; i < 4; ++i) { const int kp = rq + 8 * i; unsigned* d = scr + c4 * 36 + kp;
        d[0] = dn::pkbf(lo[i].x, hi[i].x); d[36] = dn::pkbf(lo[i].y, hi[i].y); d[72] = dn::pkbf(lo[i].z, hi[i].z); d[108] = dn::pkbf(lo[i].w, hi[i].w); }
    asm volatile("s_waitcnt lgkmcnt(0)" ::: "memory");
#pragma unroll
    for (int j = 0; j < 4; ++j) { const int n = rq + 8 * j; const uint4 o = *(const uint4*)(scr + n * 36 + 4 * (lane & 7));
        *(uint4*)(WT + (size_t)(dst_row0 + n) * ldk + k0 + 8 * (lane & 7)) = o; }
    asm volatile("s_waitcnt lgkmcnt(0)" ::: "memory");
}

#define XB_TMO      128
#define XB_XCNT(j)  (256  + 64 * (j))
#define XB_XSUB(j)  (1280 + 64 * (j))
#define XB_XGEN(j)  (2304 + 64 * (j))
#define XB_TOP      3328
#define XB_TOPGEN   3392
#define XCD_BAR_WORDS 3456
#define XB_SPIN_CAP (1u << 18)
#define XLAS __attribute__((address_space(3)))
__device__ __forceinline__ unsigned xb_ld(unsigned* p)              { return __hip_atomic_load(p, __ATOMIC_RELAXED, __HIP_MEMORY_SCOPE_AGENT); }
__device__ __forceinline__ unsigned xb_add(unsigned* p, unsigned v) { return __hip_atomic_fetch_add(p, v, __ATOMIC_RELAXED, __HIP_MEMORY_SCOPE_AGENT); }
__device__ __forceinline__ unsigned xb_xcc_id() { return (unsigned)__builtin_amdgcn_s_getreg((3 << 11) | 20) & 0xFu; }
#define XB_SPIN(cond, bar) do { unsigned _sp = 0; while (cond) { if (_sp < 32u) __builtin_amdgcn_s_sleep(1); else __builtin_amdgcn_s_sleep(24); \
    if ((++_sp & 255u) == 0u) { if (xb_ld(&(bar)[XB_TMO])) break; if (_sp > XB_SPIN_CAP) { atomicAdd(&(bar)[XB_TMO], 1u); break; } } } } while (0)
struct XcdBarrier { unsigned* bar; unsigned x; volatile XLAS unsigned* st; };
__device__ __forceinline__ XcdBarrier xcd_barrier_post(unsigned* bar, volatile XLAS unsigned* st) {
    XcdBarrier b; b.bar = bar; b.x = xb_xcc_id(); b.st = st;
    if (threadIdx.x == 0) (void)xb_add(&bar[XB_XCNT(b.x)], 1u);
    return b;
}
__device__ __forceinline__ void xcd_barrier_complete(unsigned* bar, unsigned x, unsigned& nloc, unsigned& nx) {
    const unsigned G = gridDim.x * gridDim.y * gridDim.z;
    unsigned sum, cnt, mine, sp = 0u;
    for (;;) {
        sum = 0u; cnt = 0u; mine = 0u;
#pragma unroll
        for (unsigned j = 0; j < 16; ++j) { const unsigned c = xb_ld(&bar[XB_XCNT(j)]); sum += c; cnt += (c > 0u) ? 1u : 0u; mine = (j == x) ? c : mine; }
        if (sum == G) break;
        __builtin_amdgcn_s_sleep(1);
        if ((++sp & 255u) == 0u) { if (xb_ld(&bar[XB_TMO])) break; if (sp > XB_SPIN_CAP) { atomicAdd(&bar[XB_TMO], 1u); break; } }
    }
    nloc = mine > 0u ? mine : 1u; nx = cnt > 0u ? cnt : 1u;
}
__device__ __forceinline__ void xcd_barrier(const XcdBarrier& b) {
    asm volatile("s_waitcnt vmcnt(0)" ::: "memory");
    __syncthreads();
    if (threadIdx.x == 0) {
        unsigned* bar = b.bar;
        __builtin_amdgcn_s_waitcnt(0);
        unsigned nloc = b.st[0], nx = b.st[1];
        if (nloc == 0u) { xcd_barrier_complete(bar, b.x, nloc, nx); b.st[0] = nloc; b.st[1] = nx; }
        const unsigned old = xb_add(&bar[XB_XSUB(b.x)], 1u);
        const unsigned gen = old / nloc;
        if (old + 1u == (gen + 1u) * nloc) {
            __builtin_amdgcn_fence(__ATOMIC_RELEASE, "agent");
            asm volatile("s_waitcnt vmcnt(0)" ::: "memory");
            const unsigned og = xb_add(&bar[XB_TOP], 1u);
            const unsigned tg = og / nx;
            if (og + 1u == (tg + 1u) * nx) xb_add(&bar[XB_TOPGEN], 1u);
            else XB_SPIN(xb_ld(&bar[XB_TOPGEN]) == tg, bar);
            __builtin_amdgcn_fence(__ATOMIC_ACQUIRE, "agent");
            xb_add(&bar[XB_XGEN(b.x)], 1u);
            asm volatile("s_waitcnt vmcnt(0)" ::: "memory");
        } else {
            XB_SPIN(xb_ld(&bar[XB_XGEN(b.x)]) == gen, bar);
            __builtin_amdgcn_fence(__ATOMIC_ACQUIRE, "agent");
            asm volatile("s_waitcnt vmcnt(0)" ::: "memory");
        }
    }
    __syncthreads();
}

__global__ void __launch_bounds__(NT, 2) fwd_kernel(Params p) {
    extern __shared__ __attribute__((aligned(16))) unsigned char lds_raw[];
    float* lds = (float*)lds_raw;
    int tid = threadIdx.x, lane = tid & 63, wave = tid >> 6;
    const int G = gridDim.x, bid = blockIdx.x;
    int gw = bid * 8 + wave; const int NGW = G * 8;
#define FRESH() do { tid = threadIdx.x; asm volatile("" : "+v"(tid)); lane = tid & 63; wave = tid >> 6; gw = bid * 8 + wave; } while (0)
#define GRID_SYNC() do { \
        const __attribute__((address_space(4))) Params* Pb_ = (const __attribute__((address_space(4))) Params*)__builtin_amdgcn_kernarg_segment_ptr(); asm volatile("" : "+s"(Pb_)); \
        XcdBarrier xb_; xb_.bar = (unsigned*)(Pb_->ws + WS_BAR); xb_.x = xb_xcc_id(); xb_.st = (volatile XLAS unsigned*)((XLAS unsigned char*)lds_raw + LDS_BYTES - 64); xcd_barrier(xb_); } while (0)
#define SEAM() } GRID_SYNC(); FRESH(); { LOADP();

#define LOADP() \
    const __attribute__((address_space(4))) Params* P_ = (const __attribute__((address_space(4))) Params*)__builtin_amdgcn_kernarg_segment_ptr(); asm volatile("" : "+s"(P_)); \
    const float* x = P_->in[0]; const float* mix_g = P_->in[1]; const float* w_in = P_->in[2]; const float* conv_a_w = P_->in[3]; \
    const float* conv_a_g = P_->in[4]; const float* dn_conv_w = P_->in[5]; const float* dn_a_log = P_->in[6]; const float* dn_dt_bias = P_->in[7]; \
    const float* dn_norm_g = P_->in[8]; const float* w_out = P_->in[9]; const float* ffn_g = P_->in[10]; const float* r_group_w = P_->in[11]; \
    const float* r_exp_w = P_->in[12]; const float* w_gate = P_->in[13]; const float* w_up = P_->in[14]; const float* w_down = P_->in[15]; \
    const float* final_g = P_->in[16]; unsigned char* ws = P_->ws; float* outp = P_->out; \
    int* cnt = (int*)(ws + WS_CTL); float* rstd2 = (float*)(ws + WS_RSTD2); \
    int* tok_e = (int*)(ws + WS_TOKE); float* tok_g = (float*)(ws + WS_TOKG); int* tok_p = (int*)(ws + WS_TOKP); int* slot_tok = (int*)(ws + WS_SLOTTOK); \
    float* bg = (float*)(ws + WS_BG); bf16_t* win_t = (bf16_t*)(ws + WS_WIN); bf16_t* wout_t = (bf16_t*)(ws + WS_WOUT); \
    bf16_t* proj = (bf16_t*)(ws + WS_PROJ); bf16_t* hb = (bf16_t*)(ws + WS_HB); bf16_t* ymix = (bf16_t*)(ws + WS_YMIX); \
    bf16_t* act = (bf16_t*)(ws + WS_ACT); bf16_t* yexp = (bf16_t*)(ws + WS_YEXP); bf16_t* h2b = (bf16_t*)(ws + WS_H2B); \
    bf16_t* wgu_t = (bf16_t*)(ws + WS_WGU); bf16_t* wd_t = (bf16_t*)(ws + WS_WD); float* x1 = outp; \
    dn::DnBufs DB{(bf16_t*)outp, (bf16_t*)outp + (size_t)8 * 1024 * 1024, (bf16_t*)outp + (size_t)16 * 1024 * 1024, (bf16_t*)outp + (size_t)24 * 1024 * 1024, (bf16_t*)(ws + WS_AQK), (float*)(ws + WS_GL)}; \
    (void)x; (void)mix_g; (void)w_in; (void)conv_a_w; (void)conv_a_g; (void)dn_conv_w; (void)dn_a_log; (void)dn_dt_bias; (void)dn_norm_g; (void)w_out; (void)ffn_g; (void)r_group_w; (void)r_exp_w; \
    (void)w_gate; (void)w_up; (void)w_down; (void)final_g; (void)cnt; (void)rstd2; (void)tok_e; (void)tok_g; (void)tok_p; (void)slot_tok; (void)bg; (void)win_t; (void)wout_t; (void)proj; (void)hb; (void)ymix; \
    (void)act; (void)yexp; (void)h2b; (void)wgu_t; (void)wd_t; (void)x1; (void)DB
    {
        volatile XLAS unsigned* xst_ = (volatile XLAS unsigned*)((XLAS unsigned char*)lds_raw + LDS_BYTES - 64);
        if (tid == 0) { xst_[0] = 0u; xst_[1] = 0u; }
        __syncthreads();
        (void)xcd_barrier_post((unsigned*)(p.ws + WS_BAR), xst_);
    }
#define MIXA_ROWS(first_, stride_) do { typedef unsigned u32x4_t __attribute__((ext_vector_type(4))); const int c0 = lane * 8; \
        for (int r0_ = (first_); r0_ < NTOK; r0_ += 2 * (stride_)) { \
            u32x4_t ahv[2][3], acv[2][3], abv[2]; float mk[2][3]; int rr_[2]; \
            _Pragma("unroll") for (int t = 0; t < 2; ++t) { const int r = (r0_ + t * (stride_) < NTOK) ? r0_ + t * (stride_) : r0_; rr_[t] = r; const int sq = r % SEQ; const bf16_t* pr = proj + (size_t)r * NPB; \
                _Pragma("unroll") for (int j = 0; j < 3; ++j) { const bool ok = sq + j - 2 >= 0; const bf16_t* pj = pr + (ok ? (ptrdiff_t)(j - 2) * NPB : 0); mk[t][j] = ok ? 1.f : 0.f; \
                    ahv[t][j] = *(const u32x4_t*)(pj + C_AH + c0); acv[t][j] = *(const u32x4_t*)(pj + C_AC + c0); } \
                abv[t] = *(const u32x4_t*)(pr + C_AB + c0); } \
            _Pragma("unroll") for (int t = 0; t < 2; ++t) { if (t == 1 && r0_ + (stride_) >= NTOK) break; const int r = rr_[t]; \
                float conv[8]; _Pragma("unroll") for (int i = 0; i < 8; ++i) conv[i] = 0.f; \
                _Pragma("unroll") for (int j = 0; j < 3; ++j) { const u32x4_t ah = ahv[t][j], ac = acv[t][j]; const float m_ = mk[t][j]; \
                    float4 w0 = *(const float4*)(conv_a_w + j * 512 + c0), w1 = *(const float4*)(conv_a_w + j * 512 + c0 + 4); \
                    w0.x *= m_; w0.y *= m_; w0.z *= m_; w0.w *= m_; w1.x *= m_; w1.y *= m_; w1.z *= m_; w1.w *= m_; \
                    conv[0] += dn::lo_f(ah.x) * dn::lo_f(ac.x) * w0.x; conv[1] += dn::hi_f(ah.x) * dn::hi_f(ac.x) * w0.y; conv[2] += dn::lo_f(ah.y) * dn::lo_f(ac.y) * w0.z; conv[3] += dn::hi_f(ah.y) * dn::hi_f(ac.y) * w0.w; \
                    conv[4] += dn::lo_f(ah.z) * dn::lo_f(ac.z) * w1.x; conv[5] += dn::hi_f(ah.z) * dn::hi_f(ac.z) * w1.y; conv[6] += dn::lo_f(ah.w) * dn::lo_f(ac.w) * w1.z; conv[7] += dn::hi_f(ah.w) * dn::hi_f(ac.w) * w1.w; } \
                const u32x4_t ab = abv[t]; \
                float yv[8] = {dn::lo_f(ab.x) * conv[0], dn::hi_f(ab.x) * conv[1], dn::lo_f(ab.y) * conv[2], dn::hi_f(ab.y) * conv[3], dn::lo_f(ab.z) * conv[4], dn::hi_f(ab.z) * conv[5], dn::lo_f(ab.w) * conv[6], dn::hi_f(ab.w) * conv[7]}; \
                float ss = 0.f; _Pragma("unroll") for (int i = 0; i < 8; ++i) ss += yv[i] * yv[i]; \
                ss += __shfl_xor(ss, 1); ss += __shfl_xor(ss, 2); ss += __shfl_xor(ss, 4); \
                const float rs = rsqrtf(ss * (1.f / 64.f) + EPS); \
                const float4 g0 = *(const float4*)(conv_a_g + c0), g1 = *(const float4*)(conv_a_g + c0 + 4); \
                u32x4_t w; w.x = dn::pkbf(yv[0] * rs * g0.x, yv[1] * rs * g0.y); w.y = dn::pkbf(yv[2] * rs * g0.z, yv[3] * rs * g0.w); w.z = dn::pkbf(yv[4] * rs * g1.x, yv[5] * rs * g1.y); w.w = dn::pkbf(yv[6] * rs * g1.z, yv[7] * rs * g1.w); \
                *(u32x4_t*)(ymix + (size_t)r * DM + c0) = w; } } } while (0)
    int* Loff = (int*)(lds_raw + LDS_TAB);
    int* Ltile = Loff + 64;
    {
    LOADP();
    REP(0) {
    {
        float* scr = lds + wave * (64 * 33);
        constexpr int I_IN = (DM / 64) * (NPB / 32), I_OUT = (DM / 64) * (DM / 32);
        constexpr int I_G = NE * 16 * 16, I_D = NE * 8 * 32;
        for (int it = gw; it < I_IN + I_OUT; it += NGW) {
            int r = it;
            if (r < I_IN) { const int kb = r / (NPB / 32), nb = r % (NPB / 32); transpose_item(w_in, NPROJ, kb * 64, nb * 32, win_t, DM, nb * 32, scr, lane); continue; } r -= I_IN;
            { const int kb = r / (DM / 32), nb = r % (DM / 32); transpose_item(w_out, DM, kb * 64, nb * 32, wout_t, DM, nb * 32, scr, lane); }
        }
        float wx[4][4][8];
#pragma unroll
        for (int j = 0; j < 4; ++j)
#pragma unroll
            for (int i = 0; i < 4; ++i) { const float* wr_ = w_in + (size_t)(4 * lane + 256 * j + i) * NPROJ + NPB; const float4 w0 = *(const float4*)wr_, w1 = *(const float4*)(wr_ + 4);
                wx[j][i][0] = w0.x; wx[j][i][1] = w0.y; wx[j][i][2] = w0.z; wx[j][i][3] = w0.w; wx[j][i][4] = w1.x; wx[j][i][5] = w1.y; wx[j][i][6] = w1.z; wx[j][i][7] = w1.w; }
        const int hsel = (lane >> 3) & 3; const bool is_alpha = lane >= 32;
        const float aneg = -expf(dn_a_log[hsel]), dtb = dn_dt_bias[hsel];
        float4 vnx[4];
        if (gw < NTOK) {
#pragma unroll
            for (int j = 0; j < 4; ++j) vnx[j] = ((const float4*)(x + (size_t)gw * DM) + lane)[64 * j]; }
        for (int r = gw; r < NTOK; r += NGW) {
            float4 v[4]; float s = 0.f;
#pragma unroll
            for (int j = 0; j < 4; ++j) { v[j] = vnx[j]; s += v[j].x * v[j].x + v[j].y * v[j].y + v[j].z * v[j].z + v[j].w * v[j].w; }
            if (r + NGW < NTOK) {
#pragma unroll
                for (int j = 0; j < 4; ++j) vnx[j] = ((const float4*)(x + (size_t)(r + NGW) * DM) + lane)[64 * j]; }
            const float rs = rsqrtf(wave_sum(s) * (1.f / DM) + EPS);
            float dots[8];
#pragma unroll
            for (int c = 0; c < 8; ++c) dots[c] = 0.f;
            unsigned long long* o8 = (unsigned long long*)(hb + (size_t)r * DM) + lane;
#pragma unroll
            for (int j = 0; j < 4; ++j) { const float4 g = ((const float4*)mix_g)[lane + 64 * j];
                v[j].x *= rs * g.x; v[j].y *= rs * g.y; v[j].z *= rs * g.z; v[j].w *= rs * g.w;
                o8[64 * j] = (unsigned long long)pk2(v[j].x, v[j].y) | ((unsigned long long)pk2(v[j].z, v[j].w) << 32);
                const float hv[4] = {v[j].x, v[j].y, v[j].z, v[j].w};
#pragma unroll
                for (int i = 0; i < 4; ++i)
#pragma unroll
                    for (int c = 0; c < 8; ++c) dots[c] += hv[i] * wx[j][i][c]; }
            const float tot = reduce8_tr(dots, lane);
            if ((lane & 7) == 0) bg[(size_t)r * 8 + (lane >> 3)] = is_alpha ? aneg * softplus_f(tot + dtb) : sigmoid_f(tot);
        }
    }
    }
    SEAM()
    REP(1) {
        pg8::Gemm g{hb, DM, nullptr}; pg8::DenseOrder S; S.init(NTOK, NPB, DM, win_t, G, bid);
        pg8::EpiBf16 E{proj, NPB};
        pg8::gemm_phase<pg8::EpiBf16, pg8::DenseOrder, false, true>((PG8_LAS unsigned char*)lds_raw, g, S, E);
    }
    SEAM()
    REP(3) dn::prep(lds_raw, tid, bid, G, proj, bg, dn_conv_w, DB);
    SEAM()
    REP(4) {
    constexpr int NSU = 2 * BATCH * NH;
    if (bid >= NSU || G <= NSU) {
        float* scr = lds + wave * (64 * 33);
        constexpr int I_G = NE * 16 * 16, I_D = NE * 8 * 32;
        const int nw = (G <= NSU) ? NGW : (G - NSU) * 8, w0 = (G <= NSU) ? gw : gw - NSU * 8;
        for (int it = w0; it < 2 * I_G + I_D; it += nw) {
            int r = it;
            if (r < 2 * I_G) { const int up = r >= I_G; if (up) r -= I_G; const int e = r >> 8, kb = (r >> 4) & 15, nb = r & 15, n0 = nb * 32;
                transpose_item((up ? w_up : w_gate) + (size_t)e * DM * FF, FF, kb * 64, n0, wgu_t + (size_t)e * DM * DM, DM, (n0 >> 7) * 256 + (n0 & 127) + (up ? 128 : 0), scr, lane); continue; } r -= 2 * I_G;
            { const int e = r >> 8, kb = (r >> 5) & 7, nb = r & 31; transpose_item(w_down + (size_t)e * FF * DM, DM, kb * 64, nb * 32, wd_t + (size_t)e * DM * FF, FF, nb * 32, scr, lane); }
        }
        if (G > NSU) MIXA_ROWS(w0, nw);
    }
    if (bid < NSU || G <= NSU) dn::scan(lds_raw, tid, bid, G, DB, ymix);
    }
    SEAM()
    {
        typedef unsigned u32x4_t __attribute__((ext_vector_type(4)));
        const int c0 = lane * 8;
        if (G <= 2 * BATCH * NH) MIXA_ROWS(gw, NGW);
        for (int r0_ = gw; r0_ < NTOK; r0_ += 4 * NGW) {
            u32x4_t ovv[4], zvv[4]; int rr_[4];
#pragma unroll
            for (int t = 0; t < 4; ++t) {
                const int r = (r0_ + t * NGW < NTOK) ? r0_ + t * NGW : r0_; rr_[t] = r;
                zvv[t] = *(const u32x4_t*)(proj + (size_t)r * NPB + C_Z + c0);
                const int oi_ = r & 63, oitem_ = ((r / SEQ) * NH + (c0 >> 7)) * (SEQ / 64) + ((r % SEQ) >> 6);
                ovv[t] = *(const u32x4_t*)(DB.UT + ((size_t)oitem_ * 128 + (c0 & 112)) * 64 + (((oi_ >> 4) * 4 + (oi_ & 3)) * 4 + ((oi_ >> 2) & 3)) * 16 + (c0 & 15));
            }
#pragma unroll
            for (int t = 0; t < 4; ++t) {
                if (t > 0 && r0_ + t * NGW >= NTOK) break;
                const int r = rr_[t];
                const u32x4_t ov = ovv[t], zv = zvv[t];
                float o[8] = {dn::lo_f(ov.x), dn::hi_f(ov.x), dn::lo_f(ov.y), dn::hi_f(ov.y), dn::lo_f(ov.z), dn::hi_f(ov.z), dn::lo_f(ov.w), dn::hi_f(ov.w)};
                const float z[8] = {dn::lo_f(zv.x), dn::hi_f(zv.x), dn::lo_f(zv.y), dn::hi_f(zv.y), dn::lo_f(zv.z), dn::hi_f(zv.z), dn::lo_f(zv.w), dn::hi_f(zv.w)};
                float ss = 0.f;
#pragma unroll
                for (int i = 0; i < 8; ++i) ss += o[i] * o[i];
                ss += __shfl_xor(ss, 1); ss += __shfl_xor(ss, 2); ss += __shfl_xor(ss, 4); ss += __shfl_xor(ss, 8);
                const float rs = rsqrtf(ss * (1.f / 128.f) + EPS);
                const float4 g0 = *(const float4*)(dn_norm_g + (c0 & 127)), g1 = *(const float4*)(dn_norm_g + (c0 & 127) + 4);
                const float gv[8] = {g0.x, g0.y, g0.z, g0.w, g1.x, g1.y, g1.z, g1.w};
#pragma unroll
                for (int i = 0; i < 8; ++i) o[i] = o[i] * rs * gv[i] * dn::silu_fast(z[i]);
                u32x4_t w; w.x = dn::pkbf(o[0], o[1]); w.y = dn::pkbf(o[2], o[3]); w.z = dn::pkbf(o[4], o[5]); w.w = dn::pkbf(o[6], o[7]);
                *(u32x4_t*)(ymix + (size_t)r * DM + 512 + c0) = w;
            }
        }
    }
    SEAM()
    REP(5) {
        pg8::Gemm g{ymix, DM, nullptr}; pg8::DenseOrder S; S.init(NTOK, DM, DM, wout_t, G, bid);
        pg8::EpiResid E{x, x1, DM};
        pg8::gemm_phase<pg8::EpiResid, pg8::DenseOrder, false, false>((PG8_LAS unsigned char*)lds_raw, g, S, E);
    }
    SEAM()
    {
        {
            const float4* src = (const float4*)r_exp_w; float4* dst = (float4*)lds_raw;
            for (int i = tid; i < DM * 8; i += NT) { const int k = i >> 3, sl = i & 7; dst[k * 8 + (sl ^ (k & 7))] = src[i]; }
        }
        float4 wg[16];
#pragma unroll
        for (int j = 0; j < 16; ++j) wg[j] = *(const float4*)(r_group_w + (size_t)(lane + 64 * j) * 4);
        float gf[16];
#pragma unroll
        for (int j = 0; j < 16; ++j) gf[j] = ffn_g[lane + 64 * j];
        int* lcnt = (int*)(lds_raw + LDS_TAB + 2048);
        if (tid < NE) lcnt[tid] = 0;
        __syncthreads();
        float hnx[16];
        if (gw < NTOK) {
#pragma unroll
            for (int j = 0; j < 16; ++j) hnx[j] = x1[(size_t)gw * DM + lane + 64 * j]; }
        for (int r = gw; r < NTOK; r += NGW) {
            float hv[16]; float s = 0.f;
#pragma unroll
            for (int j = 0; j < 16; ++j) { hv[j] = hnx[j]; s += hv[j] * hv[j]; }
            if (r + NGW < NTOK) {
#pragma unroll
                for (int j = 0; j < 16; ++j) hnx[j] = x1[(size_t)(r + NGW) * DM + lane + 64 * j]; }
            const float rs = rsqrtf(wave_sum(s) * (1.f / DM) + EPS);
            float gl4[4] = {0.f, 0.f, 0.f, 0.f};
#pragma unroll
            for (int j = 0; j < 16; ++j) { hv[j] *= rs * gf[j]; h2b[(size_t)r * DM + lane + 64 * j] = (bf16_t)f2bf(hv[j]);
                gl4[0] += hv[j] * wg[j].x; gl4[1] += hv[j] * wg[j].y; gl4[2] += hv[j] * wg[j].z; gl4[3] += hv[j] * wg[j].w; }
            const float gt = reduce4_tr(gl4, lane);
            const float gl[4] = {lane_bcast(gt, 0), lane_bcast(gt, 16), lane_bcast(gt, 32), lane_bcast(gt, 48)};
            int gi = 0; float gm = gl[0];
#pragma unroll
            for (int g = 1; g < 4; ++g) if (gl[g] > gm) { gm = gl[g]; gi = g; }
            float gs = 0.f;
#pragma unroll
            for (int g = 0; g < 4; ++g) gs += expf(gl[g] - gm);
            const float gprob = 1.f / gs;
            float ed[8] = {0.f, 0.f, 0.f, 0.f, 0.f, 0.f, 0.f, 0.f};
#pragma unroll
            for (int j = 0; j < 16; ++j) { const int k = lane + 64 * j; const float4* row = (const float4*)lds_raw + k * 8;
                const float4 w0 = row[(2 * gi) ^ (k & 7)], w1 = row[(2 * gi + 1) ^ (k & 7)];
                ed[0] += hv[j] * w0.x; ed[1] += hv[j] * w0.y; ed[2] += hv[j] * w0.z; ed[3] += hv[j] * w0.w; ed[4] += hv[j] * w1.x; ed[5] += hv[j] * w1.y; ed[6] += hv[j] * w1.z; ed[7] += hv[j] * w1.w; }
            const float et = reduce8_tr(ed, lane);
            float el[8];
#pragma unroll
            for (int e = 0; e < 8; ++e) el[e] = lane_bcast(et, 8 * e);
            int i1 = 0; float m1 = el[0];
#pragma unroll
            for (int e = 1; e < 8; ++e) if (el[e] > m1) { m1 = el[e]; i1 = e; }
            int i2 = -1; float m2 = -INFINITY;
#pragma unroll
            for (int e = 0; e < 8; ++e) if (e != i1 && el[e] > m2) { m2 = el[e]; i2 = e; }
            const float p2 = expf(m2 - m1), inv = 1.f / (1.f + p2);
            if (lane == 0) {
                const int e1 = gi * 8 + i1, e2 = gi * 8 + i2;
                tok_e[2 * r] = e1; tok_e[2 * r + 1] = e2;
                tok_g[2 * r] = gprob * inv; tok_g[2 * r + 1] = gprob * p2 * inv;
                tok_p[2 * r] = atomicAdd(&lcnt[e1], 1); tok_p[2 * r + 1] = atomicAdd(&lcnt[e2], 1);
            }
        }
        __syncthreads();
        if (tid < NE) ((int*)(ws + WS_CNTB))[bid * NE + tid] = lcnt[tid];
    }
    SEAM()
    {
        const int* cntb = (const int*)(ws + WS_CNTB);
        int* red = (int*)(lds_raw + LDS_TAB + 4096);
        int* Lbase = (int*)(lds_raw + LDS_TAB + 2048);
        { const int e = tid & 31, part = tid >> 5; int sall = 0, sbef = 0;
          for (int b_ = part; b_ < G; b_ += 16) { const int v = cntb[b_ * NE + e]; sall += v; sbef += (b_ < bid) ? v : 0; }
          red[part * 32 + e] = sall; red[512 + part * 32 + e] = sbef; }
        __syncthreads();
        if (tid < NE) { int a = 0, b_ = 0; for (int q = 0; q < 16; ++q) { a += red[q * 32 + tid]; b_ += red[512 + q * 32 + tid]; } red[1024 + tid] = a; Lbase[tid] = b_; }
        __syncthreads();
        if (tid == 0) { int o = 0, tl = 0; for (int e = 0; e < NE; ++e) { Loff[e] = o; Ltile[e] = tl; const int c = red[1024 + e]; o += c; tl += (c + 255) / 256; } Loff[NE] = o; Ltile[NE] = tl; }
        __syncthreads();
        for (int q = tid; q < 16 * (NTOK / (8 * G) + 1); q += NT) {
            const int w = (q >> 1) & 7, k = q >> 4, r = bid * 8 + w + NGW * k, i = 2 * r + (q & 1);
            if (r < NTOK) { const int e = tok_e[i]; const int sl = Loff[e] + Lbase[e] + tok_p[i]; slot_tok[sl] = r; tok_p[i] = sl; }
        }
    }
    SEAM()
    REP(7) {
        pg8::Gemm g{h2b, DM, slot_tok};
        pg8::GroupedOrder S{Loff, Ltile, Ltile[NE] * 4, G, bid, (const char*)wgu_t, (size_t)DM * DM * 2, (size_t)256 * DM * 2};
        pg8::EpiAct E{act};
        pg8::gemm_phase<pg8::EpiAct, pg8::GroupedOrder, true, true>((PG8_LAS unsigned char*)lds_raw, g, S, E);
    }
    SEAM()
    REP(8) {
        pg8::Gemm g{act, FF, nullptr};
        pg8::GroupedOrder S{Loff, Ltile, Ltile[NE] * 4, G, bid, (const char*)wd_t, (size_t)DM * FF * 2, (size_t)256 * FF * 2};
        pg8::EpiBf16 E{yexp, DM};
        pg8::gemm_phase<pg8::EpiBf16, pg8::GroupedOrder, false, true>((PG8_LAS unsigned char*)lds_raw, g, S, E);
    }
    SEAM()
    {
        const int nmine = (NTOK - gw + NGW - 1) / NGW;
        const float4* fg = (const float4*)final_g + lane;
        float4 gfin[4];
#pragma unroll
        for (int j = 0; j < 4; ++j) gfin[j] = fg[64 * j];
        for (int k0 = 0; k0 < nmine; k0 += 16) {
            const int kk = k0 + (lane & 15), rr = gw + NGW * (kk < nmine ? kk : k0);
            const int2 sv = *(const int2*)(tok_p + 2 * rr); const float2 gv = *(const float2*)(tok_g + 2 * rr);
            for (int k = k0; k < nmine && k < k0 + 16; k += 4) {
                int rT[4]; bool has[4]; int s0[4], s1[4]; float g0[4], g1[4];
#pragma unroll
                for (int t = 0; t < 4; ++t) { has[t] = k + t < nmine; const int l_ = has[t] ? k + t - k0 : k - k0; rT[t] = gw + NGW * (has[t] ? k + t : k);
                    s0[t] = __shfl(sv.x, l_); s1[t] = __shfl(sv.y, l_); g0[t] = __shfl(gv.x, l_); g1[t] = __shfl(gv.y, l_); }
                float4 xv[4][4]; uint2 ya[4][4], yb[4][4];
#pragma unroll
                for (int t = 0; t < 4; ++t)
#pragma unroll
                    for (int j = 0; j < 4; ++j) { xv[t][j] = ((const float4*)(x1 + (size_t)rT[t] * DM) + lane)[64 * j]; ya[t][j] = ((const uint2*)(yexp + (size_t)s0[t] * DM) + lane)[64 * j]; yb[t][j] = ((const uint2*)(yexp + (size_t)s1[t] * DM) + lane)[64 * j]; }
                float ssum[4];
#pragma unroll
                for (int t = 0; t < 4; ++t) { float a_ = 0.f;
#pragma unroll
                    for (int j = 0; j < 4; ++j) {
                        xv[t][j] = make_float4(xv[t][j].x + g0[t] * dn::lo_f(ya[t][j].x) + g1[t] * dn::lo_f(yb[t][j].x), xv[t][j].y + g0[t] * dn::hi_f(ya[t][j].x) + g1[t] * dn::hi_f(yb[t][j].x),
                                               xv[t][j].z + g0[t] * dn::lo_f(ya[t][j].y) + g1[t] * dn::lo_f(yb[t][j].y), xv[t][j].w + g0[t] * dn::hi_f(ya[t][j].y) + g1[t] * dn::hi_f(yb[t][j].y));
                        a_ += xv[t][j].x * xv[t][j].x + xv[t][j].y * xv[t][j].y + xv[t][j].z * xv[t][j].z + xv[t][j].w * xv[t][j].w; }
                    ssum[t] = a_; }
#pragma unroll
                for (int o = 1; o < 64; o <<= 1) {
#pragma unroll
                    for (int t = 0; t < 4; ++t) ssum[t] += __shfl_xor(ssum[t], o); }
#pragma unroll
                for (int t = 0; t < 4; ++t) { if (has[t]) { const float rs = rsqrtf(ssum[t] * (1.f / DM) + EPS); float4* od = (float4*)(outp + (size_t)rT[t] * DM) + lane;
#pragma unroll
                    for (int j = 0; j < 4; ++j) od[64 * j] = make_float4(xv[t][j].x * rs * gfin[j].x, xv[t][j].y * rs * gfin[j].y, xv[t][j].z * rs * gfin[j].z, xv[t][j].w * rs * gfin[j].w); } }
            }
        }
    }
    }
}

extern "C" void kernel_launch(void* const* d_in, const int* in_sizes, int n_in, void* d_out, int out_size, void* d_ws, size_t ws_size, hipStream_t stream) {
    static int grid_blocks = 0;
    if (!grid_blocks) {
        int dev = 0, cus = 0, per_cu = 0;
        (void)hipGetDevice(&dev);
        (void)hipDeviceGetAttribute(&cus, hipDeviceAttributeMultiprocessorCount, dev);
        (void)hipFuncSetAttribute((const void*)fwd_kernel, hipFuncAttributeMaxDynamicSharedMemorySize, LDS_BYTES);
        (void)hipOccupancyMaxActiveBlocksPerMultiprocessor(&per_cu, (const void*)fwd_kernel, NT, LDS_BYTES);
        if (per_cu < 1) per_cu = 1;
        if (per_cu > 1 && 2 * LDS_BYTES > 160 * 1024) per_cu = 1;
        grid_blocks = cus * per_cu;
        fprintf(stderr, "kernel_launch: cus %d per_cu %d grid %d ws_size %zu\n", cus, per_cu, grid_blocks, ws_size);
    }
    (void)hipMemsetAsync((char*)d_ws + WS_CTL, 0, CTL_ZERO_BYTES, stream);
    Params p{};
    for (int i = 0; i < 17; ++i) p.in[i] = (const float*)d_in[i];
    p.out = (float*)d_out; p.ws = (unsigned char*)d_ws;
    hipLaunchKernelGGL(fwd_kernel, dim3(grid_blocks), dim3(NT), LDS_BYTES, stream, p);
    hipError_t e = hipPeekAtLastError();
    if (e != hipSuccess) fprintf(stderr, "launch failed: %s (grid %d)\n", hipGetErrorString(e), grid_blocks);
}
```

```cpp
#include <hip/hip_runtime.h>
#include <cstdio>
#include <cstdint>

constexpr int BATCH = 8, SEQ = 2048, DM = 1024, NTOK = BATCH * SEQ;
constexpr int NH = 4, HD = 128, NPROJ = 3592, NPB = 3584;
constexpr int C_AH = 0, C_AB = 512, C_AC = 1024, C_Q = 1536, C_K = 2048, C_V = 2560, C_Z = 3072;
constexpr int NE = 32, FF = 512;
constexpr float EPS = 1e-6f;
constexpr int NT = 512;
#ifndef REP_PHASE
#define REP_PHASE -1
#endif
#define REP(k) for (int rep_ = 0; rep_ < ((REP_PHASE == (k)) ? 2 : 1); ++rep_)
constexpr int LDS_BYTES = 144 * 1024;
constexpr int LDS_TAB = 131072;

typedef unsigned short bf16_t;
constexpr size_t MiB = 1u << 20;
constexpr size_t WS_CTL = 0;
constexpr size_t WS_BAR = 65536;
constexpr size_t CTL_ZERO_BYTES = 131072;
constexpr size_t WS_RSTD2 = 1 * MiB;
constexpr size_t WS_TOKE = WS_RSTD2 + 65536;
constexpr size_t WS_TOKG = WS_TOKE + 131072;
constexpr size_t WS_TOKP = WS_TOKG + 131072;
constexpr size_t WS_SLOTTOK = WS_TOKP + 131072;
constexpr size_t WS_GL = WS_SLOTTOK + 131072;
constexpr size_t WS_CNTB = WS_GL + 8192;
constexpr size_t WS_BG = 2 * MiB;
constexpr size_t WS_WIN = 3 * MiB;
constexpr size_t WS_WOUT = 10 * MiB;
constexpr size_t WS_WGU = 12 * MiB;
constexpr size_t WS_WD = 76 * MiB;
constexpr size_t WS_PROJ = 108 * MiB;
constexpr size_t WS_HB = 220 * MiB;
constexpr size_t WS_YMIX = 220 * MiB;
constexpr size_t WS_AQK = 252 * MiB;
constexpr size_t WS_H2B = 108 * MiB;
constexpr size_t WS_ACT = 140 * MiB;
constexpr size_t WS_YEXP = 173 * MiB;

struct Params { const float* in[17]; float* out; unsigned char* ws; };

__device__ __forceinline__ float wave_sum(float v) {
#pragma unroll
    for (int o = 1; o < 64; o <<= 1) v += __shfl_xor(v, o);
    return v;
}
__device__ __forceinline__ float silu_f(float x) { return x / (1.f + expf(-x)); }
__device__ __forceinline__ float sigmoid_f(float x) { return 1.f / (1.f + expf(-x)); }
__device__ __forceinline__ float softplus_f(float x) { return fmaxf(x, 0.f) + log1pf(expf(-fabsf(x))); }
__device__ __forceinline__ float bf2f(bf16_t h) { return __uint_as_float((unsigned)h << 16); }
__device__ __forceinline__ unsigned f2bf(float f) { unsigned u = __float_as_uint(f); return (u + 0x7fffu + ((u >> 16) & 1u)) >> 16; }
__device__ __forceinline__ unsigned pk2(float lo, float hi) { return f2bf(lo) | (f2bf(hi) << 16); }


__device__ __forceinline__ float reduce8_tr(const float (&v)[8], int lane) {
    float a[4], b[2];
#pragma unroll
    for (int i = 0; i < 4; ++i) { const bool hi = lane & 32; const float send = hi ? v[i] : v[i + 4], keep = hi ? v[i + 4] : v[i]; a[i] = keep + __shfl_xor(send, 32); }
#pragma unroll
    for (int i = 0; i < 2; ++i) { const bool hi = lane & 16; const float send = hi ? a[i] : a[i + 2], keep = hi ? a[i + 2] : a[i]; b[i] = keep + __shfl_xor(send, 16); }
    const bool hi = lane & 8; const float send = hi ? b[0] : b[1], keep = hi ? b[1] : b[0];
    float c = keep + __shfl_xor(send, 8);
    c += __shfl_xor(c, 4); c += __shfl_xor(c, 2); c += __shfl_xor(c, 1);
    return c;
}
__device__ __forceinline__ float reduce4_tr(const float (&v)[4], int lane) {
    float a[2];
#pragma unroll
    for (int i = 0; i < 2; ++i) { const bool hi = lane & 32; const float send = hi ? v[i] : v[i + 2], keep = hi ? v[i + 2] : v[i]; a[i] = keep + __shfl_xor(send, 32); }
    const bool hi = lane & 16; const float send = hi ? a[0] : a[1], keep = hi ? a[1] : a[0];
    float c = keep + __shfl_xor(send, 16);
    c += __shfl_xor(c, 8); c += __shfl_xor(c, 4); c += __shfl_xor(c, 2); c += __shfl_xor(c, 1);
    return c;
}
__device__ __forceinline__ float lane_bcast(float v, int src) { return __int_as_float(__builtin_amdgcn_readlane(__float_as_int(v), src)); }

namespace pg8 {
#define PG8_LAS __attribute__((address_space(3)))
typedef short bf16x8 __attribute__((ext_vector_type(8)));
typedef float f32x4 __attribute__((ext_vector_type(4)));
typedef unsigned u32x4 __attribute__((ext_vector_type(4)));
constexpr int BM = 256, BK = 64, HALF = 128, HTB = HALF * BK * 2, STAGE_BYTES = 8 * HTB, NXCD = 8, WGM = 8;

__host__ __device__ __forceinline__ int lds_byte(int r, int c) { const int st = (r >> 4) * 2 + (c >> 5), rr = r & 15, cc = c & 31, ob = rr * 64 + cc * 2; return st * 1024 + (ob ^ (((ob >> 9) & 1) << 5)); }
__host__ __device__ __forceinline__ void stage_rc(int b, int& R, int& C) { const int st = b / 1024, sb = b % 1024, swz = sb ^ (((sb >> 9) & 1) << 5); R = (st >> 1) * 16 + swz / 64; C = (st & 1) * 32 + (swz % 64) / 2; }
__host__ __device__ __forceinline__ int perm32(int rho) { const int n = rho >> 4, i = rho & 15; return 8 * (i >> 2) + 4 * n + (i & 3); }

struct Unit { int arow0, rowend, pn, half; const char* B; };
struct Gemm { const bf16_t* A; int K; const int* gidx; };

struct DenseOrder {
    int nM, nN, nwg, G, c, M, nfull, tail; const char* Bt; size_t tstep;
    __device__ void init(int M_, int N, int K, const bf16_t* Bt_, int G_, int c_) { M = M_; nM = M / BM; nN = N / BM; nwg = nM * nN; G = G_; c = c_; Bt = (const char*)Bt_; tstep = (size_t)BM * K * 2;
        nfull = (nwg / G) * G; tail = nwg - nfull; if (2 * tail > G) { nfull = nwg; tail = 0; } }
    __device__ bool next(int i, Unit& u) const {
        const long L = (long)i * G + c; int wgid, hs = -1;
        if (L < nfull) wgid = (int)L;
        else { const long hu = L - nfull; if (hu >= 2 * tail) return false; wgid = nfull + (int)(hu % tail); hs = (int)(hu / tail); }
        { const int q = nwg / NXCD, r = nwg % NXCD, xcd = wgid % NXCD, off = wgid / NXCD; wgid = (xcd < r ? xcd * (q + 1) : r * (q + 1) + (xcd - r) * q) + off; }
        const int nig = WGM * nN, gid = wgid / nig, fm = gid * WGM, gsz = (nM - fm) < WGM ? (nM - fm) : WGM;
        const int pm = fm + ((wgid % nig) % gsz); u.pn = (wgid % nig) / gsz; u.B = Bt + (size_t)u.pn * tstep;
        if (hs < 0) { u.arow0 = pm * BM; u.rowend = M; u.half = 0; } else { u.arow0 = pm * BM + HALF * hs; u.rowend = u.arow0 + HALF; u.half = 1; }
        return true;
    }
};

typedef __bf16 bf16x2_t __attribute__((ext_vector_type(2)));
typedef float f32x2_t __attribute__((ext_vector_type(2)));
__device__ __forceinline__ unsigned cvt_pk_bf16(float lo, float hi) { const f32x2_t v = {lo, hi}; return __builtin_bit_cast(unsigned, __builtin_convertvector(v, bf16x2_t)); }

struct EpiBf16 {
    static constexpr bool PERM = true;
    bf16_t* O; int ldc;
    __device__ __forceinline__ void operator()(const f32x4 (&acc)[2][2][4][2], const Unit& u, int wr, int wc, int fr, int fq) const {
        const int row0 = u.arow0 + wr * 64 + fr, col0 = u.pn * BM + wc * 32 + 8 * fq;
#pragma unroll
        for (int ai = 0; ai < 2; ++ai)
#pragma unroll
            for (int m = 0; m < 4; ++m) { const int row = row0 + ai * HALF + m * 16; bf16_t* rowp = O + (size_t)row * ldc + col0;
                if (row < u.rowend) {
#pragma unroll
                    for (int bj = 0; bj < 2; ++bj) { const f32x4 v0 = acc[ai][bj][m][0], v1 = acc[ai][bj][m][1];
                        u32x4 w; w.x = cvt_pk_bf16(v0[0], v0[1]); w.y = cvt_pk_bf16(v0[2], v0[3]); w.z = cvt_pk_bf16(v1[0], v1[1]); w.w = cvt_pk_bf16(v1[2], v1[3]);
                        *(u32x4*)(rowp + bj * HALF) = w; } } }
    }
};
struct EpiResid {
    static constexpr bool PERM = false;
    const float* base; float* C; int ldc;
    __device__ __forceinline__ void operator()(const f32x4 (&acc)[2][2][4][2], const Unit& u, int wr, int wc, int fr, int fq) const {
        const int row0 = u.arow0 + wr * 64 + fr, col0 = u.pn * BM + wc * 32 + 4 * fq;
#pragma unroll
        for (int ai = 0; ai < 2; ++ai) {
            f32x4 bv[4][2][2];
#pragma unroll
            for (int m = 0; m < 4; ++m) { const size_t off = (size_t)(row0 + ai * HALF + m * 16) * ldc + col0;
#pragma unroll
                for (int bj = 0; bj < 2; ++bj)
#pragma unroll
                    for (int n = 0; n < 2; ++n) bv[m][bj][n] = *(const f32x4*)(base + off + bj * HALF + n * 16); }
#pragma unroll
            for (int m = 0; m < 4; ++m) { const size_t off = (size_t)(row0 + ai * HALF + m * 16) * ldc + col0;
#pragma unroll
                for (int bj = 0; bj < 2; ++bj)
#pragma unroll
                    for (int n = 0; n < 2; ++n) *(f32x4*)(C + off + bj * HALF + n * 16) = bv[m][bj][n] + acc[ai][bj][m][n]; }
        }
    }
};
struct EpiAct {
    static constexpr bool PERM = true;
    bf16_t* O;
    __device__ __forceinline__ void operator()(const f32x4 (&acc)[2][2][4][2], const Unit& u, int wr, int wc, int fr, int fq) const {
        const int row0 = u.arow0 + wr * 64 + fr, col0 = u.pn * HALF + wc * 32 + 8 * fq;
#pragma unroll
        for (int ai = 0; ai < 2; ++ai)
#pragma unroll
            for (int m = 0; m < 4; ++m) { const int row = row0 + ai * HALF + m * 16;
                if (row < u.rowend) { float v[8];
#pragma unroll
                    for (int n = 0; n < 2; ++n)
#pragma unroll
                        for (int j = 0; j < 4; ++j) { const float gt = acc[ai][0][m][n][j], up = acc[ai][1][m][n][j]; v[n * 4 + j] = gt * __builtin_amdgcn_rcpf(1.f + __builtin_amdgcn_exp2f(-1.4426950408889634f * gt)) * up; }
                    u32x4 w; w.x = cvt_pk_bf16(v[0], v[1]); w.y = cvt_pk_bf16(v[2], v[3]); w.z = cvt_pk_bf16(v[4], v[5]); w.w = cvt_pk_bf16(v[6], v[7]);
                    *(u32x4*)(O + (size_t)row * 512 + col0) = w; } }
    }
};
struct GroupedOrder {
    const int* Loff; const int* Ttile; const int* Lend; const int* LsmE; int nfullu, nunits, G, c; const char* Bt; size_t estride, tstep;
    __device__ bool next(int i, Unit& u) const {
        const int L = (G == 256) ? ((i * 8 + (c & 7)) * 32 + (c >> 3)) : (i * G + c);
        if (L >= nunits) return false;
        u.pn = L & 3;
        if (L < nfullu) { const int tile = L >> 2; int e = 0; while (Ttile[e + 1] <= tile) ++e;
            u.arow0 = Loff[e] + (tile - Ttile[e]) * BM; u.rowend = Lend[e]; u.half = 0; u.B = Bt + (size_t)e * estride + (size_t)u.pn * tstep; }
        else { const int e = LsmE[(L - nfullu) >> 2]; u.arow0 = Lend[e]; u.rowend = Loff[e + 1]; u.half = 1; u.B = Bt + (size_t)e * estride + (size_t)u.pn * tstep; }
        return true;
    }
};

template <class Epi, class Sched, bool GATHER, bool ALIGN_EPI>
__device__ __forceinline__ void gemm_phase(PG8_LAS unsigned char* lds, const Gemm g, const Sched& S, const Epi& E) {
    const int tid = threadIdx.x, wid = __builtin_amdgcn_readfirstlane(tid >> 6), lane = tid & 63, wr = wid >> 2, wc = wid & 3, fr = lane & 15, fq = lane >> 4;
    const int K = g.K, nt = K / BK;
    int RA[2], CA[2]; unsigned voffB[2];
#pragma unroll
    for (int i = 0; i < 2; ++i) { int R, C; stage_rc(tid * 16 + i * 8192, R, C); const int Rb = Epi::PERM ? ((R & ~31) + perm32(R & 31)) : R;
        RA[i] = R; CA[i] = C; voffB[i] = (unsigned)(Rb * K + C) * 2u; }
    const size_t kstep = (size_t)(BK * 2);
    const size_t hstep = (size_t)HALF * K * 2;
    const unsigned ldsw = (unsigned)wid * 1024u;
    const int aoff = lds_byte(wr * 64 + fr, fq * 8), boff = lds_byte(wc * 32 + fr, fq * 8);
    const char* A0 = (const char*)g.A;
#define PG8_SA(b, h) (((b) * 2 + (h)) * HTB)
#define PG8_SB(b, h) ((4 + (b) * 2 + (h)) * HTB)
#define PG8_STAGE(bufoff, gbase, voff) do { _Pragma("unroll") for (int _i = 0; _i < 2; ++_i) \
        __builtin_amdgcn_global_load_lds((const unsigned*)((const char*)(gbase) + (voff)[_i]), (PG8_LAS unsigned*)(lds + (bufoff) + ldsw + _i * 8192), 16, 0, 0); } while (0)
#define PG8_LDA(dst, b, h) do { _Pragma("unroll") for (int m = 0; m < 4; ++m) _Pragma("unroll") for (int k = 0; k < 2; ++k) dst[m][k] = *(const PG8_LAS bf16x8*)(lds + PG8_SA(b, h) + aoff + m * 2048 + k * 1024); } while (0)
#define PG8_LDB(dst, b, h) do { _Pragma("unroll") for (int n = 0; n < 2; ++n) _Pragma("unroll") for (int k = 0; k < 2; ++k) dst[n][k] = *(const PG8_LAS bf16x8*)(lds + PG8_SB(b, h) + boff + n * 2048 + k * 1024); } while (0)
#define PG8_MMA(ai, bj, At, Bt) do { __builtin_amdgcn_s_setprio(1); _Pragma("unroll") for (int m = 0; m < 4; ++m) _Pragma("unroll") for (int n = 0; n < 2; ++n) _Pragma("unroll") for (int k = 0; k < 2; ++k) \
        acc[ai][bj][m][n] = __builtin_amdgcn_mfma_f32_16x16x32_bf16(Bt[n][k], At[m][k], acc[ai][bj][m][n], 0, 0, 0); __builtin_amdgcn_s_setprio(0); } while (0)
#define PG8_WAIT_V(n) asm volatile("s_waitcnt vmcnt(" #n ")" ::: "memory")
#define PG8_WAIT_L(n) asm volatile("s_waitcnt lgkmcnt(" #n ")" ::: "memory")
#define PG8_BAR __builtin_amdgcn_s_barrier()
#define PG8_SCHED __builtin_amdgcn_sched_barrier(0)
#define PG8_AOFF(dst, u) do { _Pragma("unroll") for (int _h = 0; _h < 2; ++_h) _Pragma("unroll") for (int _i = 0; _i < 2; ++_i) { int _r = (u).arow0 + _h * HALF + RA[_i]; _r = _r < (u).rowend ? _r : (u).rowend - 1; \
        if (GATHER) _r = g.gidx[_r]; dst[_h][_i] = (unsigned)(_r * K + CA[_i]) * 2u; } } while (0)
    Unit cur, nxt; int ui = 0;
    if (!S.next(0, cur)) return;
    f32x4 acc[2][2][4][2];
#pragma unroll
    for (int a = 0; a < 2; ++a)
#pragma unroll
        for (int b = 0; b < 2; ++b)
#pragma unroll
            for (int m = 0; m < 4; ++m)
#pragma unroll
                for (int n = 0; n < 2; ++n) acc[a][b][m][n] = (f32x4){0.f, 0.f, 0.f, 0.f};
    bf16x8 At[4][2], B0[2][2], B1[2][2];
    unsigned cvA[2][2], nvA[2][2];
    PG8_AOFF(cvA, cur);
    const char* cB = cur.B;
    PG8_STAGE(PG8_SB(0, 0), cB, voffB); PG8_STAGE(PG8_SB(0, 1), cB + hstep, voffB); PG8_STAGE(PG8_SA(0, 0), A0, cvA[0]); PG8_STAGE(PG8_SA(0, 1), A0, cvA[1]);
    if (wr == 1) PG8_BAR;
    PG8_WAIT_V(2); PG8_BAR;
    PG8_STAGE(PG8_SB(1, 0), cB + kstep, voffB); PG8_STAGE(PG8_SA(1, 0), A0 + kstep, cvA[0]); PG8_STAGE(PG8_SB(1, 1), cB + hstep + kstep, voffB);
    PG8_WAIT_V(6); PG8_BAR;
    for (;;) {
        const bool has_next = S.next(ui + 1, nxt);
        if (has_next) { PG8_AOFF(nvA, nxt); } else {
#pragma unroll
            for (int h = 0; h < 2; ++h)
#pragma unroll
                for (int i = 0; i < 2; ++i) nvA[h][i] = cvA[h][i]; }
        const char* nB = has_next ? nxt.B : cB;
        for (int t = 0; t < nt; t += 2) {
            const bool last = (t == nt - 2);
            const char* a1 = A0 + (size_t)(t + 1) * kstep;
            const char* a2 = last ? A0 : A0 + (size_t)(t + 2) * kstep; const char* b2 = last ? nB : cB + (size_t)(t + 2) * kstep;
            const char* a3 = a2 + kstep; const char* b3 = b2 + kstep;
            unsigned s2[2][2];
#pragma unroll
            for (int h = 0; h < 2; ++h)
#pragma unroll
                for (int i = 0; i < 2; ++i) s2[h][i] = last ? nvA[h][i] : cvA[h][i];
            PG8_LDB(B0, 0, 0); PG8_LDB(B1, 0, 1); PG8_SCHED; PG8_LDA(At, 0, 0); PG8_STAGE(PG8_SA(1, 1), a1, cvA[1]);
            PG8_WAIT_V(8); PG8_WAIT_L(0); PG8_BAR; PG8_MMA(0, 0, At, B0); PG8_MMA(0, 1, At, B1); PG8_BAR; PG8_SCHED;
            PG8_LDA(At, 0, 1); PG8_STAGE(PG8_SB(0, 0), b2, voffB); PG8_STAGE(PG8_SB(0, 1), b2 + hstep, voffB); PG8_STAGE(PG8_SA(0, 0), a2, s2[0]);
            PG8_WAIT_V(8); PG8_WAIT_L(0); PG8_BAR; if (!cur.half) { PG8_MMA(1, 0, At, B0); PG8_MMA(1, 1, At, B1); } PG8_BAR; PG8_SCHED;
            PG8_LDB(B0, 1, 0); PG8_LDB(B1, 1, 1); PG8_SCHED; PG8_LDA(At, 1, 0); PG8_STAGE(PG8_SA(0, 1), a2, s2[1]);
            PG8_WAIT_V(8); PG8_WAIT_L(0); PG8_BAR; PG8_MMA(0, 0, At, B0); PG8_MMA(0, 1, At, B1); PG8_BAR; PG8_SCHED;
            PG8_LDA(At, 1, 1); PG8_STAGE(PG8_SB(1, 0), b3, voffB); PG8_STAGE(PG8_SB(1, 1), b3 + hstep, voffB); PG8_STAGE(PG8_SA(1, 0), a3, s2[0]);
            PG8_WAIT_V(8); PG8_WAIT_L(0); PG8_BAR; if (!cur.half) { PG8_MMA(1, 0, At, B0); PG8_MMA(1, 1, At, B1); } PG8_BAR; PG8_SCHED;
        }
        if constexpr (ALIGN_EPI) { if (wr == 0) PG8_BAR; }
        E(acc, cur, wr, wc, fr, fq);
        if (!has_next) break;
#pragma unroll
        for (int a = 0; a < 2; ++a)
#pragma unroll
            for (int b = 0; b < 2; ++b)
#pragma unroll
                for (int m = 0; m < 4; ++m)
#pragma unroll
                    for (int n = 0; n < 2; ++n) acc[a][b][m][n] = (f32x4){0.f, 0.f, 0.f, 0.f};
        cur = nxt; cB = nB; ++ui;
#pragma unroll
        for (int h = 0; h < 2; ++h)
#pragma unroll
            for (int i = 0; i < 2; ++i) cvA[h][i] = nvA[h][i];
        if constexpr (ALIGN_EPI) { if (wr == 1) PG8_BAR; }
    }
    PG8_WAIT_V(0);
    if constexpr (!ALIGN_EPI) { if (wr == 0) PG8_BAR; }
    PG8_BAR;
#undef PG8_SA
#undef PG8_SB
#undef PG8_STAGE
#undef PG8_LDA
#undef PG8_LDB
#undef PG8_MMA
#undef PG8_WAIT_V
#undef PG8_WAIT_L
#undef PG8_BAR
#undef PG8_SCHED
#undef PG8_AOFF
}
}


namespace dn {
typedef short bf16x8 __attribute__((ext_vector_type(8)));
typedef float f32x4 __attribute__((ext_vector_type(4)));
typedef unsigned u32x4 __attribute__((ext_vector_type(4)));
typedef unsigned u32x2 __attribute__((ext_vector_type(2)));
__device__ __forceinline__ int perm_pos(int kl) { return 8 * ((kl >> 2) & 3) + 4 * (kl >> 4) + (kl & 3); }
__device__ __forceinline__ int perm_inv(int p) { return 16 * ((p >> 2) & 1) + 4 * (p >> 3) + (p & 3); }
typedef __bf16 bf16x2_t __attribute__((ext_vector_type(2)));
typedef float f32x2_t __attribute__((ext_vector_type(2)));
__device__ __forceinline__ unsigned pkbf(float lo, float hi) { const f32x2_t v = {lo, hi}; return __builtin_bit_cast(unsigned, __builtin_convertvector(v, bf16x2_t)); }
__device__ __forceinline__ float lo_f(unsigned u) { return __uint_as_float(u << 16); }
__device__ __forceinline__ float hi_f(unsigned u) { return __uint_as_float(u & 0xffff0000u); }
constexpr int P2_LT = 0, P2_G = 16384, P2_QB = 17408, P2_KB = P2_QB + 17408, P2_RU = P2_KB + 17408, P2_RW = P2_RU + 32768;
constexpr int ROWB = 272;

struct DnBufs { bf16_t* UT; bf16_t* WN; bf16_t* QD; bf16_t* KDT; bf16_t* AQK; float* GL; };

__device__ __forceinline__ float silu_fast(float a) { return a * __builtin_amdgcn_rcpf(1.f + __builtin_amdgcn_exp2f(-1.4426950408889634f * a)); }
__device__ __forceinline__ void prep(unsigned char* lds, int tid, int bid, int G, const bf16_t* proj, const float* bg, const float* dn_conv_w, const DnBufs B) {
    const int lane = tid & 63, wave = tid >> 6;
    float* RU = (float*)(lds + P2_RU); float* RW = (float*)(lds + P2_RW); float* LT = (float*)(lds + P2_LT); float* GS = (float*)(lds + P2_G);
    const int nitems = BATCH * NH * (SEQ / 64);
    const int r0 = wave * 8;
    unsigned xin[11][3]; float gin, bin;
#define DN_PREP_LOAD(item_) do { const int bh_ = (item_) >> 5, c_ = (item_) & 31, b_ = bh_ >> 2, h_ = bh_ & 3, t0_ = c_ * 64; \
        _Pragma("unroll") for (int rr = 0; rr < 11; ++rr) { const int t = t0_ + r0 + rr - 3; \
            _Pragma("unroll") for (int wh = 0; wh < 3; ++wh) { const unsigned v_ = *(const unsigned*)(proj + ((size_t)b_ * SEQ + (t >= 0 ? t : 0)) * NPB + C_Q + wh * 512 + h_ * 128 + 2 * lane); xin[rr][wh] = (t >= 0) ? v_ : 0u; } } \
        gin = bg[((size_t)b_ * SEQ + t0_ + lane) * 8 + 4 + h_]; bin = bg[((size_t)b_ * SEQ + t0_ + lane) * 8 + h_]; } while (0)
    for (int item = bid; item < nitems; item += G) {
        const int bh = item >> 5, h = bh & 3;
        DN_PREP_LOAD(item);
        float cw[3][4][2];
#pragma unroll
        for (int wh = 0; wh < 3; ++wh)
#pragma unroll
            for (int j = 0; j < 4; ++j) { const float2 w2 = *(const float2*)(dn_conv_w + j * 1536 + wh * 512 + h * 128 + 2 * lane); cw[wh][j][0] = w2.x; cw[wh][j][1] = w2.y; }
        float Gc = gin;
#pragma unroll
        for (int o = 1; o < 64; o <<= 1) { const float t = __shfl_up(Gc, o); if (lane >= o) Gc += t; }
        const float glast = __shfl(Gc, 63), eGl = __expf(Gc), bel = bin;
        if (wave == 0) { GS[lane] = Gc; GS[64 + lane] = eGl; GS[128 + lane] = bel; GS[192 + lane] = __expf(glast - Gc); if (lane == 0) B.GL[item] = glast; }
#pragma unroll
        for (int rr = 0; rr < 8; ++rr) {
            const int i = r0 + rr;
            float val[3][2];
#pragma unroll
            for (int wh = 0; wh < 3; ++wh) { float a0 = 0.f, a1 = 0.f;
#pragma unroll
                for (int j = 0; j < 4; ++j) { a0 += lo_f(xin[rr + j][wh]) * cw[wh][j][0]; a1 += hi_f(xin[rr + j][wh]) * cw[wh][j][1]; }
                val[wh][0] = silu_fast(a0); val[wh][1] = silu_fast(a1); }
            float sq = val[0][0] * val[0][0] + val[0][1] * val[0][1], sk = val[1][0] * val[1][0] + val[1][1] * val[1][1];
#pragma unroll
            for (int o = 1; o < 64; o <<= 1) { sq += __shfl_xor(sq, o); sk += __shfl_xor(sk, o); }
            const float fq = rsqrtf(sq + EPS) * 0.08838834764831845f, fk = rsqrtf(sk + EPS);
            const float eG = __shfl(eGl, i), be = __shfl(bel, i);
            const float q0 = val[0][0] * fq, q1 = val[0][1] * fq, k0 = val[1][0] * fk, k1 = val[1][1] * fk;
            *(unsigned*)(lds + P2_QB + i * ROWB + 4 * lane) = pkbf(q0, q1);
            *(unsigned*)(lds + P2_KB + i * ROWB + 4 * lane) = pkbf(k0, k1);
            const int kl = (2 * lane) & 31, pos = ((2 * lane) & ~31) + perm_pos(kl);
            *(unsigned*)(B.QD + ((size_t)item * 64 + i) * 128 + pos) = pkbf(q0 * eG, q1 * eG);
            *(float2*)(RW + i * 128 + 2 * lane) = make_float2(be * eG * k0, be * eG * k1);
            *(float2*)(RU + i * 128 + 2 * lane) = make_float2(be * val[2][0], be * val[2][1]);
        }
        __syncthreads();
        {
            const int g = lane >> 4, cl = lane & 15, mi = wave >> 1, nj0 = 2 * (wave & 1);
            bf16x8 ka[4], qa[4];
#pragma unroll
            for (int s_ = 0; s_ < 4; ++s_) { ka[s_] = *(const bf16x8*)(lds + P2_KB + (16 * mi + cl) * ROWB + (32 * s_ + 8 * g) * 2); qa[s_] = *(const bf16x8*)(lds + P2_QB + (16 * mi + cl) * ROWB + (32 * s_ + 8 * g) * 2); }
#pragma unroll
            for (int nn = 0; nn < 2; ++nn) {
                const int nj = nj0 + nn;
                f32x4 akk = {0.f, 0.f, 0.f, 0.f}, aqk = {0.f, 0.f, 0.f, 0.f};
#pragma unroll
                for (int s_ = 0; s_ < 4; ++s_) { const bf16x8 kb = *(const bf16x8*)(lds + P2_KB + (16 * nj + cl) * ROWB + (32 * s_ + 8 * g) * 2);
                    akk = __builtin_amdgcn_mfma_f32_16x16x32_bf16(ka[s_], kb, akk, 0, 0, 0); aqk = __builtin_amdgcn_mfma_f32_16x16x32_bf16(qa[s_], kb, aqk, 0, 0, 0); }
                const int j = 16 * nj + cl; const float Gj = GS[j];
                float lt[4];
                const int jpos = (j & ~31) + perm_pos(j & 31);
#pragma unroll
                for (int x_ = 0; x_ < 4; ++x_) { const int i = 16 * mi + 4 * g + x_; const float dec = __expf(fminf(GS[i] - Gj, 0.f));
                    lt[x_] = (i > j) ? GS[128 + i] * akk[x_] * dec : 0.f;
                    const float a = (i >= j) ? aqk[x_] * dec : 0.f;
                    B.AQK[((size_t)item * 64 + i) * 64 + jpos] = (bf16_t)(pkbf(a, 0.f) & 0xffffu); }
                *(float4*)(LT + j * 64 + 16 * mi + 4 * g) = make_float4(lt[0], lt[1], lt[2], lt[3]);
            }
        }
        __syncthreads();
        if (tid < 256) {
            const float* src = (tid < 128) ? (RU + tid) : (RW + (tid - 128));
            typedef __attribute__((address_space(3))) float lds_f32;
            const lds_f32* LTp = (const lds_f32*)(LT); asm volatile("" : "+v"(LTp));
            float acc[64];
#pragma unroll
            for (int i = 0; i < 64; ++i) acc[i] = src[i * 128];
#pragma unroll
            for (int j = 0; j < 63; ++j) {
                const float xj = acc[j];
#pragma unroll
                for (int q = (j + 1) >> 2; q < 16; ++q) {
                    const f32x4 l4 = *(const __attribute__((address_space(3))) f32x4*)(LTp + j * 64 + 4 * q);
                    if (4 * q + 0 > j) acc[4 * q + 0] -= l4.x * xj;
                    if (4 * q + 1 > j) acc[4 * q + 1] -= l4.y * xj;
                    if (4 * q + 2 > j) acc[4 * q + 2] -= l4.z * xj;
                    if (4 * q + 3 > j) acc[4 * q + 3] -= l4.w * xj;
                }
            }
            if (tid < 128) {
                u32x4* dst = (u32x4*)(B.UT + ((size_t)item * 128 + tid) * 64);
#pragma unroll
                for (int q = 0; q < 8; ++q) { u32x4 w; w.x = pkbf(acc[8 * q], acc[8 * q + 1]); w.y = pkbf(acc[8 * q + 2], acc[8 * q + 3]); w.z = pkbf(acc[8 * q + 4], acc[8 * q + 5]); w.w = pkbf(acc[8 * q + 6], acc[8 * q + 7]); dst[q] = w; }
            } else {
                const int dk = tid - 128, pos = (dk & ~31) + perm_pos(dk & 31);
                bf16_t* dst = B.WN + (size_t)item * 64 * 128 + pos;
#pragma unroll
                for (int i = 0; i < 64; ++i) dst[i * 128] = (bf16_t)(pkbf(-acc[i], 0.f) & 0xffffu);
            }
        } else if (tid < 384) {
            const int dk = tid - 256;
            u32x4* dst = (u32x4*)(B.KDT + ((size_t)item * 128 + dk) * 64);
#pragma unroll
            for (int q = 0; q < 8; ++q) { float v[8];
#pragma unroll
                for (int e = 0; e < 8; ++e) { const int p_ = 8 * q + e, i = (p_ & ~31) + perm_inv(p_ & 31); v[e] = bf2f(*(const bf16_t*)(lds + P2_KB + i * ROWB + 2 * dk)) * GS[192 + i]; }
                u32x4 w; w.x = pkbf(v[0], v[1]); w.y = pkbf(v[2], v[3]); w.z = pkbf(v[4], v[5]); w.w = pkbf(v[6], v[7]); dst[q] = w; }
        }
        __syncthreads();
    }
#undef DN_PREP_LOAD
}

constexpr int SROW = 288, SKROW = 160;
constexpr int SC_WN = 0, SC_QD = 64 * SROW, SC_KDT = 128 * SROW, SC_AQK = SC_KDT + 128 * SKROW, SC_BUF = SC_AQK + 64 * SKROW  ;
__device__ __forceinline__ void scan(unsigned char* lds, int tid, int bid, int G, const DnBufs B, bf16_t* ymix) {
    (void)ymix;
    const int lane = tid & 63, wave = __builtin_amdgcn_readfirstlane(tid >> 6), g = lane >> 4, cl = lane & 15;
#define DN_BAR() do { asm volatile("s_waitcnt lgkmcnt(0)" ::: "memory"); __builtin_amdgcn_s_barrier(); asm volatile("" ::: "memory"); } while (0)
    for (int unit = bid; unit < 2 * BATCH * NH; unit += G) {
        const int bh = unit >> 1;
        __syncthreads();
        if (wave < 4) {
            const int wdv = 4 * (unit & 1) + wave, dv = 16 * wdv + cl;
            f32x4 S[8]; bf16x8 Sb[4];
#pragma unroll
            for (int r = 0; r < 8; ++r) S[r] = (f32x4){0.f, 0.f, 0.f, 0.f};
#pragma unroll
            for (int s_ = 0; s_ < 4; ++s_) Sb[s_] = (bf16x8){0, 0, 0, 0, 0, 0, 0, 0};
            const float eglv = __expf(B.GL[bh * 32 + (lane & 31)]);
            u32x2 uA[4], uB[4];
            f32x4 vn[4];
#define DN_LOAD_U(upre, c_) do { const size_t it_ = (size_t)(bh * 32 + (c_)); \
            _Pragma("unroll") for (int m_ = 0; m_ < 4; ++m_) upre[m_] = *(const u32x2*)(B.UT + (it_ * 128 + dv) * 64 + 16 * m_ + 4 * g); } while (0)
#define DN_VN(upre) do { _Pragma("unroll") for (int m = 0; m < 4; ++m) vn[m] = (f32x4){lo_f(upre[m].x), hi_f(upre[m].x), lo_f(upre[m].y), hi_f(upre[m].y)}; } while (0)
#define DN_SB() __builtin_amdgcn_sched_barrier(0)
#define DN_LDW(f, off_, m0_) do { _Pragma("unroll") for (int m = 0; m < 2; ++m) _Pragma("unroll") for (int s_ = 0; s_ < 4; ++s_) f[m * 4 + s_] = *(const bf16x8*)(buf + (off_) + (16 * ((m0_) + m) + cl) * SROW + (32 * s_ + 8 * g) * 2); } while (0)
#define DN_LDK(f, off_, r0_) do { _Pragma("unroll") for (int r = 0; r < 4; ++r) _Pragma("unroll") for (int s_ = 0; s_ < 2; ++s_) f[r * 2 + s_] = *(const bf16x8*)(buf + (off_) + (16 * ((r0_) + r) + cl) * SKROW + (32 * s_ + 8 * g) * 2); } while (0)
#define DN_MMW(acc, m0_, f) do { _Pragma("unroll") for (int s_ = 0; s_ < 4; ++s_) _Pragma("unroll") for (int m = 0; m < 2; ++m) acc[(m0_) + m] = __builtin_amdgcn_mfma_f32_16x16x32_bf16(f[m * 4 + s_], Sb[s_], acc[(m0_) + m], 0, 0, 0); } while (0)
#define DN_MMK(acc, r0_, f) do { _Pragma("unroll") for (int s_ = 0; s_ < 2; ++s_) _Pragma("unroll") for (int r = 0; r < 4; ++r) acc[(r0_) + r] = __builtin_amdgcn_mfma_f32_16x16x32_bf16(f[r * 2 + s_], Vb[s_], acc[(r0_) + r], 0, 0, 0); } while (0)
#define DN_CHUNK(bufoff_, c_) do { \
            const unsigned char* buf = lds + (bufoff_); const int item = bh * 32 + (c_); \
            const float egl = __shfl(eglv, (c_)); \
            f32x4 o[4]; \
            _Pragma("unroll") for (int m = 0; m < 4; ++m) o[m] = (f32x4){0.f, 0.f, 0.f, 0.f}; \
            bf16x8 fA[8], fB[8]; \
            DN_LDW(fA, SC_WN, 0); DN_LDW(fB, SC_WN, 2); DN_SB(); \
            DN_MMW(vn, 0, fA); DN_SB(); DN_LDW(fA, SC_QD, 0); DN_SB(); \
            DN_MMW(vn, 2, fB); DN_SB(); DN_LDW(fB, SC_QD, 2); DN_SB(); \
            bf16x8 Vb[2]; \
            _Pragma("unroll") for (int s_ = 0; s_ < 2; ++s_) { u32x4 w; w.x = pkbf(vn[2 * s_][0], vn[2 * s_][1]); w.y = pkbf(vn[2 * s_][2], vn[2 * s_][3]); w.z = pkbf(vn[2 * s_ + 1][0], vn[2 * s_ + 1][1]); w.w = pkbf(vn[2 * s_ + 1][2], vn[2 * s_ + 1][3]); \
                Vb[s_] = __builtin_bit_cast(bf16x8, w); } \
            DN_MMW(o, 0, fA); DN_SB(); DN_LDK(fA, SC_KDT, 0); DN_SB(); \
            DN_MMW(o, 2, fB); DN_SB(); DN_LDK(fB, SC_KDT, 4); DN_SB(); \
            _Pragma("unroll") for (int r = 0; r < 8; ++r) S[r] = S[r] * egl; \
            DN_MMK(S, 0, fA); DN_SB(); DN_LDK(fA, SC_AQK, 0); DN_SB(); \
            DN_MMK(S, 4, fB); DN_SB(); \
            DN_MMK(o, 0, fA); DN_SB(); \
            _Pragma("unroll") for (int s_ = 0; s_ < 4; ++s_) { u32x4 w; w.x = pkbf(S[2 * s_][0], S[2 * s_][1]); w.y = pkbf(S[2 * s_][2], S[2 * s_][3]); w.z = pkbf(S[2 * s_ + 1][0], S[2 * s_ + 1][1]); w.w = pkbf(S[2 * s_ + 1][2], S[2 * s_ + 1][3]); \
                Sb[s_] = __builtin_bit_cast(bf16x8, w); } \
            { bf16_t* od_ = B.UT + ((size_t)item * 128 + 16 * wdv) * 64 + lane; \
              _Pragma("unroll") for (int m = 0; m < 4; ++m) _Pragma("unroll") for (int x_ = 0; x_ < 4; ++x_) od_[(m * 4 + x_) * 64] = (bf16_t)(pkbf(o[m][x_], 0.f) & 0xffffu); } \
        } while (0)
            DN_LOAD_U(uA, 0); DN_LOAD_U(uB, 1);
            DN_BAR();
            for (int c = 0; c < SEQ / 64; c += 2) {
                DN_VN(uA); if (c + 2 < SEQ / 64) DN_LOAD_U(uA, c + 2);
                DN_CHUNK(0, c);
                DN_BAR();
                DN_VN(uB); if (c + 3 < SEQ / 64) DN_LOAD_U(uB, c + 3);
                DN_CHUNK(SC_BUF, c + 1);
                DN_BAR();
            }
#undef DN_LOAD_U
#undef DN_VN
#undef DN_SB
#undef DN_LDW
#undef DN_LDK
#undef DN_MMW
#undef DN_MMK
#undef DN_CHUNK
        } else {
            const int lt = tid - 256;
            const int o_w = (lt >> 4) * SROW + (lt & 15) * 16, o_k = (lt >> 3) * SKROW + (lt & 7) * 16;
            u32x4 p0[14], p1[14], p2[14];
#define DN_LOADP(pre, c_) do { const size_t it_ = (size_t)(bh * 32 + (c_)); \
            _Pragma("unroll") for (int q = 0; q < 4; ++q) { pre[q] = *(const u32x4*)(B.WN + it_ * 8192 + (size_t)(lt + 256 * q) * 8); pre[4 + q] = *(const u32x4*)(B.QD + it_ * 8192 + (size_t)(lt + 256 * q) * 8); \
                pre[8 + q] = *(const u32x4*)(B.KDT + it_ * 8192 + (size_t)(lt + 256 * q) * 8); } \
            _Pragma("unroll") for (int q = 0; q < 2; ++q) pre[12 + q] = *(const u32x4*)(B.AQK + it_ * 4096 + (size_t)(lt + 256 * q) * 8); } while (0)
#define DN_WRITEP(pre, bufoff_) do { unsigned char* d_ = lds + (bufoff_); \
            _Pragma("unroll") for (int q = 0; q < 4; ++q) { *(u32x4*)(d_ + SC_WN + o_w + q * 16 * SROW) = pre[q]; *(u32x4*)(d_ + SC_QD + o_w + q * 16 * SROW) = pre[4 + q]; *(u32x4*)(d_ + SC_KDT + o_k + q * 32 * SKROW) = pre[8 + q]; } \
            _Pragma("unroll") for (int q = 0; q < 2; ++q) *(u32x4*)(d_ + SC_AQK + o_k + q * 32 * SKROW) = pre[12 + q]; } while (0)
            DN_LOADP(p0, 0); DN_LOADP(p1, 1); DN_LOADP(p2, 2);
            DN_WRITEP(p0, 0);
            DN_BAR();
            DN_LOADP(p0, 3);
#define DN_STEP(j_, set_, bufoff_) do { const int cc_ = c + (j_); if (cc_ < SEQ / 64) { if (cc_ + 1 < SEQ / 64) DN_WRITEP(set_, bufoff_); DN_BAR(); if (cc_ + 4 < SEQ / 64) DN_LOADP(set_, cc_ + 4); } } while (0)
            for (int c = 0; c < SEQ / 64; c += 6) {
                DN_STEP(0, p1, SC_BUF); DN_STEP(1, p2, 0); DN_STEP(2, p0, SC_BUF); DN_STEP(3, p1, 0); DN_STEP(4, p2, SC_BUF); DN_STEP(5, p0, 0);
            }
#undef DN_STEP
#undef DN_LOADP
#undef DN_WRITEP
        }
        __syncthreads();
    }
#undef DN_BAR
}
}

__device__ __forceinline__ void transpose_item(const float* W, int ldw, int k0, int n0, bf16_t* WT, int ldk, int dst_row0, float* scr_f, int lane) {
    unsigned* scr = (unsigned*)scr_f;
    const int c4 = (lane & 7) * 4, rq = lane >> 3;
    float4 lo[4], hi[4];
#pragma unroll
    for (int i = 0; i < 4; ++i) { const float* src = W + (size_t)(k0 + 2 * (rq + 8 * i)) * ldw + n0 + c4; lo[i] = *(const float4*)src; hi[i] = *(const float4*)(src + ldw); }
#pragma unroll
    for (int i = 0; i < 4; ++i) { const int kp = rq + 8 * i; unsigned* d = scr + c4 * 36 + kp;
        d[0] = dn::pkbf(lo[i].x, hi[i].x); d[36] = dn::pkbf(lo[i].y, hi[i].y); d[72] = dn::pkbf(lo[i].z, hi[i].z); d[108] = dn::pkbf(lo[i].w, hi[i].w); }
    asm volatile("s_waitcnt lgkmcnt(0)" ::: "memory");
#pragma unroll
    for (int j = 0; j < 4; ++j) { const int n = rq + 8 * j; const uint4 o = *(const uint4*)(scr + n * 36 + 4 * (lane & 7));
        *(uint4*)(WT + (size_t)(dst_row0 + n) * ldk + k0 + 8 * (lane & 7)) = o; }
    asm volatile("s_waitcnt lgkmcnt(0)" ::: "memory");
}

#define XB_TMO      128
#define XB_XCNT(j)  (256  + 64 * (j))
#define XB_XSUB(j)  (1280 + 64 * (j))
#define XB_XGEN(j)  (2304 + 64 * (j))
#define XB_TOP      3328
#define XB_TOPGEN   3392
#define XCD_BAR_WORDS 3456
#define XB_SPIN_CAP (1u << 18)
#define XLAS __attribute__((address_space(3)))
__device__ __forceinline__ unsigned xb_ld(unsigned* p)              { return __hip_atomic_load(p, __ATOMIC_RELAXED, __HIP_MEMORY_SCOPE_AGENT); }
__device__ __forceinline__ unsigned xb_add(unsigned* p, unsigned v) { return __hip_atomic_fetch_add(p, v, __ATOMIC_RELAXED, __HIP_MEMORY_SCOPE_AGENT); }
__device__ __forceinline__ unsigned xb_xcc_id() { return (unsigned)__builtin_amdgcn_s_getreg((3 << 11) | 20) & 0xFu; }
#define XB_SPIN(cond, bar) do { unsigned _sp = 0; while (cond) { if (_sp < 32u) __builtin_amdgcn_s_sleep(1); else __builtin_amdgcn_s_sleep(24); \
    if ((++_sp & 255u) == 0u) { if (xb_ld(&(bar)[XB_TMO])) break; if (_sp > XB_SPIN_CAP) { atomicAdd(&(bar)[XB_TMO], 1u); break; } } } } while (0)
struct XcdBarrier { unsigned* bar; unsigned x; volatile XLAS unsigned* st; };
__device__ __forceinline__ XcdBarrier xcd_barrier_post(unsigned* bar, volatile XLAS unsigned* st) {
    XcdBarrier b; b.bar = bar; b.x = xb_xcc_id(); b.st = st;
    if (threadIdx.x == 0) (void)xb_add(&bar[XB_XCNT(b.x)], 1u);
    return b;
}
__device__ __forceinline__ void xcd_barrier_complete(unsigned* bar, unsigned x, unsigned& nloc, unsigned& nx) {
    const unsigned G = gridDim.x * gridDim.y * gridDim.z;
    unsigned sum, cnt, mine, sp = 0u;
    for (;;) {
        sum = 0u; cnt = 0u; mine = 0u;
#pragma unroll
        for (unsigned j = 0; j < 16; ++j) { const unsigned c = xb_ld(&bar[XB_XCNT(j)]); sum += c; cnt += (c > 0u) ? 1u : 0u; mine = (j == x) ? c : mine; }
        if (sum == G) break;
        __builtin_amdgcn_s_sleep(1);
        if ((++sp & 255u) == 0u) { if (xb_ld(&bar[XB_TMO])) break; if (sp > XB_SPIN_CAP) { atomicAdd(&bar[XB_TMO], 1u); break; } }
    }
    nloc = mine > 0u ? mine : 1u; nx = cnt > 0u ? cnt : 1u;
}
__device__ __forceinline__ void xcd_barrier(const XcdBarrier& b) {
    asm volatile("s_waitcnt vmcnt(0)" ::: "memory");
    __syncthreads();
    if (threadIdx.x == 0) {
        unsigned* bar = b.bar;
        __builtin_amdgcn_s_waitcnt(0);
        unsigned nloc = b.st[0], nx = b.st[1];
        if (nloc == 0u) { xcd_barrier_complete(bar, b.x, nloc, nx); b.st[0] = nloc; b.st[1] = nx; }
        const unsigned old = xb_add(&bar[XB_XSUB(b.x)], 1u);
        const unsigned gen = old / nloc;
        if (old + 1u == (gen + 1u) * nloc) {
            __builtin_amdgcn_fence(__ATOMIC_RELEASE, "agent");
            asm volatile("s_waitcnt vmcnt(0)" ::: "memory");
            const unsigned og = xb_add(&bar[XB_TOP], 1u);
            const unsigned tg = og / nx;
            if (og + 1u == (tg + 1u) * nx) xb_add(&bar[XB_TOPGEN], 1u);
            else XB_SPIN(xb_ld(&bar[XB_TOPGEN]) == tg, bar);
            __builtin_amdgcn_fence(__ATOMIC_ACQUIRE, "agent");
            xb_add(&bar[XB_XGEN(b.x)], 1u);
            asm volatile("s_waitcnt vmcnt(0)" ::: "memory");
        } else {
            XB_SPIN(xb_ld(&bar[XB_XGEN(b.x)]) == gen, bar);
            __builtin_amdgcn_fence(__ATOMIC_ACQUIRE, "agent");
            asm volatile("s_waitcnt vmcnt(0)" ::: "memory");
        }
    }
    __syncthreads();
}

__global__ void __launch_bounds__(NT, 2) fwd_kernel(Params p) {
    extern __shared__ __attribute__((aligned(16))) unsigned char lds_raw[];
    float* lds = (float*)lds_raw;
    int tid = threadIdx.x, lane = tid & 63, wave = tid >> 6;
    const int G = gridDim.x, bid = blockIdx.x;
    int gw = bid * 8 + wave; const int NGW = G * 8;
#define FRESH() do { tid = threadIdx.x; asm volatile("" : "+v"(tid)); lane = tid & 63; wave = tid >> 6; gw = bid * 8 + wave; } while (0)
#define GRID_SYNC() do { \
        const __attribute__((address_space(4))) Params* Pb_ = (const __attribute__((address_space(4))) Params*)__builtin_amdgcn_kernarg_segment_ptr(); asm volatile("" : "+s"(Pb_)); \
        XcdBarrier xb_; xb_.bar = (unsigned*)(Pb_->ws + WS_BAR); xb_.x = xb_xcc_id(); xb_.st = (volatile XLAS unsigned*)((XLAS unsigned char*)lds_raw + LDS_BYTES - 64); xcd_barrier(xb_); } while (0)
#define SEAM() } GRID_SYNC(); FRESH(); { LOADP();

#define LOADP() \
    const __attribute__((address_space(4))) Params* P_ = (const __attribute__((address_space(4))) Params*)__builtin_amdgcn_kernarg_segment_ptr(); asm volatile("" : "+s"(P_)); \
    const float* x = P_->in[0]; const float* mix_g = P_->in[1]; const float* w_in = P_->in[2]; const float* conv_a_w = P_->in[3]; \
    const float* conv_a_g = P_->in[4]; const float* dn_conv_w = P_->in[5]; const float* dn_a_log = P_->in[6]; const float* dn_dt_bias = P_->in[7]; \
    const float* dn_norm_g = P_->in[8]; const float* w_out = P_->in[9]; const float* ffn_g = P_->in[10]; const float* r_group_w = P_->in[11]; \
    const float* r_exp_w = P_->in[12]; const float* w_gate = P_->in[13]; const float* w_up = P_->in[14]; const float* w_down = P_->in[15]; \
    const float* final_g = P_->in[16]; unsigned char* ws = P_->ws; float* outp = P_->out; \
    int* cnt = (int*)(ws + WS_CTL); float* rstd2 = (float*)(ws + WS_RSTD2); \
    int* tok_e = (int*)(ws + WS_TOKE); float* tok_g = (float*)(ws + WS_TOKG); int* tok_p = (int*)(ws + WS_TOKP); int* slot_tok = (int*)(ws + WS_SLOTTOK); \
    float* bg = (float*)(ws + WS_BG); bf16_t* win_t = (bf16_t*)(ws + WS_WIN); bf16_t* wout_t = (bf16_t*)(ws + WS_WOUT); \
    bf16_t* proj = (bf16_t*)(ws + WS_PROJ); bf16_t* hb = (bf16_t*)(ws + WS_HB); bf16_t* ymix = (bf16_t*)(ws + WS_YMIX); \
    bf16_t* act = (bf16_t*)(ws + WS_ACT); bf16_t* yexp = (bf16_t*)(ws + WS_YEXP); bf16_t* h2b = (bf16_t*)(ws + WS_H2B); \
    bf16_t* wgu_t = (bf16_t*)(ws + WS_WGU); bf16_t* wd_t = (bf16_t*)(ws + WS_WD); float* x1 = outp; \
    dn::DnBufs DB{(bf16_t*)outp, (bf16_t*)outp + (size_t)8 * 1024 * 1024, (bf16_t*)outp + (size_t)16 * 1024 * 1024, (bf16_t*)outp + (size_t)24 * 1024 * 1024, (bf16_t*)(ws + WS_AQK), (float*)(ws + WS_GL)}; \
    (void)x; (void)mix_g; (void)w_in; (void)conv_a_w; (void)conv_a_g; (void)dn_conv_w; (void)dn_a_log; (void)dn_dt_bias; (void)dn_norm_g; (void)w_out; (void)ffn_g; (void)r_group_w; (void)r_exp_w; \
    (void)w_gate; (void)w_up; (void)w_down; (void)final_g; (void)cnt; (void)rstd2; (void)tok_e; (void)tok_g; (void)tok_p; (void)slot_tok; (void)bg; (void)win_t; (void)wout_t; (void)proj; (void)hb; (void)ymix; \
    (void)act; (void)yexp; (void)h2b; (void)wgu_t; (void)wd_t; (void)x1; (void)DB
    {
        volatile XLAS unsigned* xst_ = (volatile XLAS unsigned*)((XLAS unsigned char*)lds_raw + LDS_BYTES - 64);
        if (tid == 0) { xst_[0] = 0u; xst_[1] = 0u; }
        __syncthreads();
        (void)xcd_barrier_post((unsigned*)(p.ws + WS_BAR), xst_);
    }
#define MIXA_ROWS(first_, stride_) do { typedef unsigned u32x4_t __attribute__((ext_vector_type(4))); const int c0 = lane * 8; \
        for (int r0_ = (first_); r0_ < NTOK; r0_ += 2 * (stride_)) { \
            u32x4_t ahv[2][3], acv[2][3], abv[2]; float mk[2][3]; int rr_[2]; \
            _Pragma("unroll") for (int t = 0; t < 2; ++t) { const int r = (r0_ + t * (stride_) < NTOK) ? r0_ + t * (stride_) : r0_; rr_[t] = r; const int sq = r % SEQ; const bf16_t* pr = proj + (size_t)r * NPB; \
                _Pragma("unroll") for (int j = 0; j < 3; ++j) { const bool ok = sq + j - 2 >= 0; const bf16_t* pj = pr + (ok ? (ptrdiff_t)(j - 2) * NPB : 0); mk[t][j] = ok ? 1.f : 0.f; \
                    ahv[t][j] = *(const u32x4_t*)(pj + C_AH + c0); acv[t][j] = *(const u32x4_t*)(pj + C_AC + c0); } \
                abv[t] = *(const u32x4_t*)(pr + C_AB + c0); } \
            _Pragma("unroll") for (int t = 0; t < 2; ++t) { if (t == 1 && r0_ + (stride_) >= NTOK) break; const int r = rr_[t]; \
                float conv[8]; _Pragma("unroll") for (int i = 0; i < 8; ++i) conv[i] = 0.f; \
                _Pragma("unroll") for (int j = 0; j < 3; ++j) { const u32x4_t ah = ahv[t][j], ac = acv[t][j]; const float m_ = mk[t][j]; \
                    float4 w0 = *(const float4*)(conv_a_w + j * 512 + c0), w1 = *(const float4*)(conv_a_w + j * 512 + c0 + 4); \
                    w0.x *= m_; w0.y *= m_; w0.z *= m_; w0.w *= m_; w1.x *= m_; w1.y *= m_; w1.z *= m_; w1.w *= m_; \
                    conv[0] += dn::lo_f(ah.x) * dn::lo_f(ac.x) * w0.x; conv[1] += dn::hi_f(ah.x) * dn::hi_f(ac.x) * w0.y; conv[2] += dn::lo_f(ah.y) * dn::lo_f(ac.y) * w0.z; conv[3] += dn::hi_f(ah.y) * dn::hi_f(ac.y) * w0.w; \
                    conv[4] += dn::lo_f(ah.z) * dn::lo_f(ac.z) * w1.x; conv[5] += dn::hi_f(ah.z) * dn::hi_f(ac.z) * w1.y; conv[6] += dn::lo_f(ah.w) * dn::lo_f(ac.w) * w1.z; conv[7] += dn::hi_f(ah.w) * dn::hi_f(ac.w) * w1.w; } \
                const u32x4_t ab = abv[t]; \
                float yv[8] = {dn::lo_f(ab.x) * conv[0], dn::hi_f(ab.x) * conv[1], dn::lo_f(ab.y) * conv[2], dn::hi_f(ab.y) * conv[3], dn::lo_f(ab.z) * conv[4], dn::hi_f(ab.z) * conv[5], dn::lo_f(ab.w) * conv[6], dn::hi_f(ab.w) * conv[7]}; \
                float ss = 0.f; _Pragma("unroll") for (int i = 0; i < 8; ++i) ss += yv[i] * yv[i]; \
                ss += __shfl_xor(ss, 1); ss += __shfl_xor(ss, 2); ss += __shfl_xor(ss, 4); \
                const float rs = rsqrtf(ss * (1.f / 64.f) + EPS); \
                const float4 g0 = *(const float4*)(conv_a_g + c0), g1 = *(const float4*)(conv_a_g + c0 + 4); \
                u32x4_t w; w.x = dn::pkbf(yv[0] * rs * g0.x, yv[1] * rs * g0.y); w.y = dn::pkbf(yv[2] * rs * g0.z, yv[3] * rs * g0.w); w.z = dn::pkbf(yv[4] * rs * g1.x, yv[5] * rs * g1.y); w.w = dn::pkbf(yv[6] * rs * g1.z, yv[7] * rs * g1.w); \
                *(u32x4_t*)(ymix + (size_t)r * DM + c0) = w; } } } while (0)
    int* Loff = (int*)(lds_raw + LDS_TAB);
    int* Ltile = Loff + 64;
    int* Lend = Loff + 128;
    int* LsmE = Loff + 192;
    {
    LOADP();
    REP(0) {
    {
        float* scr = lds + wave * (64 * 33);
        constexpr int I_IN = (DM / 64) * (NPB / 32), I_OUT = (DM / 64) * (DM / 32);
        constexpr int I_G = NE * 16 * 16, I_D = NE * 8 * 32;
        for (int it = gw; it < I_IN + I_OUT; it += NGW) {
            int r = it;
            if (r < I_IN) { const int kb = r / (NPB / 32), nb = r % (NPB / 32); transpose_item(w_in, NPROJ, kb * 64, nb * 32, win_t, DM, nb * 32, scr, lane); continue; } r -= I_IN;
            { const int kb = r / (DM / 32), nb = r % (DM / 32); transpose_item(w_out, DM, kb * 64, nb * 32, wout_t, DM, nb * 32, scr, lane); }
        }
        float wx[4][4][8];
#pragma unroll
        for (int j = 0; j < 4; ++j)
#pragma unroll
            for (int i = 0; i < 4; ++i) { const float* wr_ = w_in + (size_t)(4 * lane + 256 * j + i) * NPROJ + NPB; const float4 w0 = *(const float4*)wr_, w1 = *(const float4*)(wr_ + 4);
                wx[j][i][0] = w0.x; wx[j][i][1] = w0.y; wx[j][i][2] = w0.z; wx[j][i][3] = w0.w; wx[j][i][4] = w1.x; wx[j][i][5] = w1.y; wx[j][i][6] = w1.z; wx[j][i][7] = w1.w; }
        const int hsel = (lane >> 3) & 3; const bool is_alpha = lane >= 32;
        const float aneg = -expf(dn_a_log[hsel]), dtb = dn_dt_bias[hsel];
        float4 vnx[4];
        if (gw < NTOK) {
#pragma unroll
            for (int j = 0; j < 4; ++j) vnx[j] = ((const float4*)(x + (size_t)gw * DM) + lane)[64 * j]; }
        for (int r = gw; r < NTOK; r += NGW) {
            float4 v[4]; float s = 0.f;
#pragma unroll
            for (int j = 0; j < 4; ++j) { v[j] = vnx[j]; s += v[j].x * v[j].x + v[j].y * v[j].y + v[j].z * v[j].z + v[j].w * v[j].w; }
            if (r + NGW < NTOK) {
#pragma unroll
                for (int j = 0; j < 4; ++j) vnx[j] = ((const float4*)(x + (size_t)(r + NGW) * DM) + lane)[64 * j]; }
            const float rs = rsqrtf(wave_sum(s) * (1.f / DM) + EPS);
            float dots[8];
#pragma unroll
            for (int c = 0; c < 8; ++c) dots[c] = 0.f;
            unsigned long long* o8 = (unsigned long long*)(hb + (size_t)r * DM) + lane;
#pragma unroll
            for (int j = 0; j < 4; ++j) { const float4 g = ((const float4*)mix_g)[lane + 64 * j];
                v[j].x *= rs * g.x; v[j].y *= rs * g.y; v[j].z *= rs * g.z; v[j].w *= rs * g.w;
                o8[64 * j] = (unsigned long long)pk2(v[j].x, v[j].y) | ((unsigned long long)pk2(v[j].z, v[j].w) << 32);
                const float hv[4] = {v[j].x, v[j].y, v[j].z, v[j].w};
#pragma unroll
                for (int i = 0; i < 4; ++i)
#pragma unroll
                    for (int c = 0; c < 8; ++c) dots[c] += hv[i] * wx[j][i][c]; }
            const float tot = reduce8_tr(dots, lane);
            if ((lane & 7) == 0) bg[(size_t)r * 8 + (lane >> 3)] = is_alpha ? aneg * softplus_f(tot + dtb) : sigmoid_f(tot);
        }
    }
    }
    SEAM()
    REP(1) {
        pg8::Gemm g{hb, DM, nullptr}; pg8::DenseOrder S; S.init(NTOK, NPB, DM, win_t, G, bid);
        pg8::EpiBf16 E{proj, NPB};
        pg8::gemm_phase<pg8::EpiBf16, pg8::DenseOrder, false, true>((PG8_LAS unsigned char*)lds_raw, g, S, E);
    }
    SEAM()
    REP(3) dn::prep(lds_raw, tid, bid, G, proj, bg, dn_conv_w, DB);
    SEAM()
    REP(4) {
    constexpr int NSU = 2 * BATCH * NH;
    if (bid >= NSU || G <= NSU) {
        float* scr = lds + wave * (64 * 33);
        constexpr int I_G = NE * 16 * 16, I_D = NE * 8 * 32;
        const int nw = (G <= NSU) ? NGW : (G - NSU) * 8, w0 = (G <= NSU) ? gw : gw - NSU * 8;
        for (int it = w0; it < 2 * I_G + I_D; it += nw) {
            int r = it;
            if (r < 2 * I_G) { const int up = r >= I_G; if (up) r -= I_G; const int e = r >> 8, kb = (r >> 4) & 15, nb = r & 15, n0 = nb * 32;
                transpose_item((up ? w_up : w_gate) + (size_t)e * DM * FF, FF, kb * 64, n0, wgu_t + (size_t)e * DM * DM, DM, (n0 >> 7) * 256 + (n0 & 127) + (up ? 128 : 0), scr, lane); continue; } r -= 2 * I_G;
            { const int e = r >> 8, kb = (r >> 5) & 7, nb = r & 31; transpose_item(w_down + (size_t)e * FF * DM, DM, kb * 64, nb * 32, wd_t + (size_t)e * DM * FF, FF, nb * 32, scr, lane); }
        }
        if (G > NSU) MIXA_ROWS(w0, nw);
    }
    if (bid < NSU || G <= NSU) dn::scan(lds_raw, tid, bid, G, DB, ymix);
    }
    SEAM()
    {
        typedef unsigned u32x4_t __attribute__((ext_vector_type(4)));
        const int c0 = lane * 8;
        if (G <= 2 * BATCH * NH) MIXA_ROWS(gw, NGW);
        for (int r0_ = gw; r0_ < NTOK; r0_ += 4 * NGW) {
            u32x4_t ovv[4], zvv[4]; int rr_[4];
#pragma unroll
            for (int t = 0; t < 4; ++t) {
                const int r = (r0_ + t * NGW < NTOK) ? r0_ + t * NGW : r0_; rr_[t] = r;
                zvv[t] = *(const u32x4_t*)(proj + (size_t)r * NPB + C_Z + c0);
                const int oi_ = r & 63, oitem_ = ((r / SEQ) * NH + (c0 >> 7)) * (SEQ / 64) + ((r % SEQ) >> 6);
                ovv[t] = *(const u32x4_t*)(DB.UT + ((size_t)oitem_ * 128 + (c0 & 112)) * 64 + (((oi_ >> 4) * 4 + (oi_ & 3)) * 4 + ((oi_ >> 2) & 3)) * 16 + (c0 & 15));
            }
#pragma unroll
            for (int t = 0; t < 4; ++t) {
                if (t > 0 && r0_ + t * NGW >= NTOK) break;
                const int r = rr_[t];
                const u32x4_t ov = ovv[t], zv = zvv[t];
                float o[8] = {dn::lo_f(ov.x), dn::hi_f(ov.x), dn::lo_f(ov.y), dn::hi_f(ov.y), dn::lo_f(ov.z), dn::hi_f(ov.z), dn::lo_f(ov.w), dn::hi_f(ov.w)};
                const float z[8] = {dn::lo_f(zv.x), dn::hi_f(zv.x), dn::lo_f(zv.y), dn::hi_f(zv.y), dn::lo_f(zv.z), dn::hi_f(zv.z), dn::lo_f(zv.w), dn::hi_f(zv.w)};
                float ss = 0.f;
#pragma unroll
                for (int i = 0; i < 8; ++i) ss += o[i] * o[i];
                ss += __shfl_xor(ss, 1); ss += __shfl_xor(ss, 2); ss += __shfl_xor(ss, 4); ss += __shfl_xor(ss, 8);
                const float rs = rsqrtf(ss * (1.f / 128.f) + EPS);
                const float4 g0 = *(const float4*)(dn_norm_g + (c0 & 127)), g1 = *(const float4*)(dn_norm_g + (c0 & 127) + 4);
                const float gv[8] = {g0.x, g0.y, g0.z, g0.w, g1.x, g1.y, g1.z, g1.w};
#pragma unroll
                for (int i = 0; i < 8; ++i) o[i] = o[i] * rs * gv[i] * dn::silu_fast(z[i]);
                u32x4_t w; w.x = dn::pkbf(o[0], o[1]); w.y = dn::pkbf(o[2], o[3]); w.z = dn::pkbf(o[4], o[5]); w.w = dn::pkbf(o[6], o[7]);
                *(u32x4_t*)(ymix + (size_t)r * DM + 512 + c0) = w;
            }
        }
    }
    SEAM()
    REP(5) {
        pg8::Gemm g{ymix, DM, nullptr}; pg8::DenseOrder S; S.init(NTOK, DM, DM, wout_t, G, bid);
        pg8::EpiResid E{x, x1, DM};
        pg8::gemm_phase<pg8::EpiResid, pg8::DenseOrder, false, false>((PG8_LAS unsigned char*)lds_raw, g, S, E);
    }
    SEAM()
    {
        {
            const float4* src = (const float4*)r_exp_w; float4* dst = (float4*)lds_raw;
            for (int i = tid; i < DM * 8; i += NT) { const int k = i >> 3, sl = i & 7; dst[k * 8 + (sl ^ (k & 7))] = src[i]; }
        }
        float4 wg[16];
#pragma unroll
        for (int j = 0; j < 16; ++j) wg[j] = *(const float4*)(r_group_w + (size_t)(lane + 64 * j) * 4);
        float gf[16];
#pragma unroll
        for (int j = 0; j < 16; ++j) gf[j] = ffn_g[lane + 64 * j];
        int* lcnt = (int*)(lds_raw + LDS_TAB + 2048);
        if (tid < NE) lcnt[tid] = 0;
        __syncthreads();
        float hnx[16];
        if (gw < NTOK) {
#pragma unroll
            for (int j = 0; j < 16; ++j) hnx[j] = x1[(size_t)gw * DM + lane + 64 * j]; }
        for (int r = gw; r < NTOK; r += NGW) {
            float hv[16]; float s = 0.f;
#pragma unroll
            for (int j = 0; j < 16; ++j) { hv[j] = hnx[j]; s += hv[j] * hv[j]; }
            if (r + NGW < NTOK) {
#pragma unroll
                for (int j = 0; j < 16; ++j) hnx[j] = x1[(size_t)(r + NGW) * DM + lane + 64 * j]; }
            const float rs = rsqrtf(wave_sum(s) * (1.f / DM) + EPS);
            float gl4[4] = {0.f, 0.f, 0.f, 0.f};
#pragma unroll
            for (int j = 0; j < 16; ++j) { hv[j] *= rs * gf[j]; h2b[(size_t)r * DM + lane + 64 * j] = (bf16_t)f2bf(hv[j]);
                gl4[0] += hv[j] * wg[j].x; gl4[1] += hv[j] * wg[j].y; gl4[2] += hv[j] * wg[j].z; gl4[3] += hv[j] * wg[j].w; }
            const float gt = reduce4_tr(gl4, lane);
            const float gl[4] = {lane_bcast(gt, 0), lane_bcast(gt, 16), lane_bcast(gt, 32), lane_bcast(gt, 48)};
            int gi = 0; float gm = gl[0];
#pragma unroll
            for (int g = 1; g < 4; ++g) if (gl[g] > gm) { gm = gl[g]; gi = g; }
            float gs = 0.f;
#pragma unroll
            for (int g = 0; g < 4; ++g) gs += expf(gl[g] - gm);
            const float gprob = 1.f / gs;
            float ed[8] = {0.f, 0.f, 0.f, 0.f, 0.f, 0.f, 0.f, 0.f};
#pragma unroll
            for (int j = 0; j < 16; ++j) { const int k = lane + 64 * j; const float4* row = (const float4*)lds_raw + k * 8;
                const float4 w0 = row[(2 * gi) ^ (k & 7)], w1 = row[(2 * gi + 1) ^ (k & 7)];
                ed[0] += hv[j] * w0.x; ed[1] += hv[j] * w0.y; ed[2] += hv[j] * w0.z; ed[3] += hv[j] * w0.w; ed[4] += hv[j] * w1.x; ed[5] += hv[j] * w1.y; ed[6] += hv[j] * w1.z; ed[7] += hv[j] * w1.w; }
            const float et = reduce8_tr(ed, lane);
            float el[8];
#pragma unroll
            for (int e = 0; e < 8; ++e) el[e] = lane_bcast(et, 8 * e);
            int i1 = 0; float m1 = el[0];
#pragma unroll
            for (int e = 1; e < 8; ++e) if (el[e] > m1) { m1 = el[e]; i1 = e; }
            int i2 = -1; float m2 = -INFINITY;
#pragma unroll
            for (int e = 0; e < 8; ++e) if (e != i1 && el[e] > m2) { m2 = el[e]; i2 = e; }
            const float p2 = expf(m2 - m1), inv = 1.f / (1.f + p2);
            if (lane == 0) {
                const int e1 = gi * 8 + i1, e2 = gi * 8 + i2;
                tok_e[2 * r] = e1; tok_e[2 * r + 1] = e2;
                tok_g[2 * r] = gprob * inv; tok_g[2 * r + 1] = gprob * p2 * inv;
                tok_p[2 * r] = atomicAdd(&lcnt[e1], 1); tok_p[2 * r + 1] = atomicAdd(&lcnt[e2], 1);
            }
        }
        __syncthreads();
        if (tid < NE) ((int*)(ws + WS_CNTB))[bid * NE + tid] = lcnt[tid];
    }
    SEAM()
    {
        const int* cntb = (const int*)(ws + WS_CNTB);
        int* red = (int*)(lds_raw + LDS_TAB + 4096);
        int* Lbase = (int*)(lds_raw + LDS_TAB + 2048);
        { const int e = tid & 31, part = tid >> 5; int sall = 0, sbef = 0;
          for (int b_ = part; b_ < G; b_ += 16) { const int v = cntb[b_ * NE + e]; sall += v; sbef += (b_ < bid) ? v : 0; }
          red[part * 32 + e] = sall; red[512 + part * 32 + e] = sbef; }
        __syncthreads();
        if (tid < NE) { int a = 0, b_ = 0; for (int q = 0; q < 16; ++q) { a += red[q * 32 + tid]; b_ += red[512 + q * 32 + tid]; } red[1024 + tid] = a; Lbase[tid] = b_; }
        __syncthreads();
        if (tid == 0) { int o = 0, tl = 0, ns = 0;
            for (int e = 0; e < NE; ++e) { Loff[e] = o; Ltile[e] = tl; const int c = red[1024 + e], full = c >> 8, rem = c & 255;
                if (rem > 128 || rem == 0) { tl += full + (rem ? 1 : 0); Lend[e] = o + c; }
                else { tl += full; Lend[e] = o + 256 * full; LsmE[ns++] = e; }
                o += c; }
            Loff[NE] = o; Ltile[NE] = tl; LsmE[63] = ns; }
        __syncthreads();
        for (int q = tid; q < 16 * (NTOK / (8 * G) + 1); q += NT) {
            const int w = (q >> 1) & 7, k = q >> 4, r = bid * 8 + w + NGW * k, i = 2 * r + (q & 1);
            if (r < NTOK) { const int e = tok_e[i]; const int sl = Loff[e] + Lbase[e] + tok_p[i]; slot_tok[sl] = r; tok_p[i] = sl; }
        }
    }
    SEAM()
    REP(7) {
        pg8::Gemm g{h2b, DM, slot_tok};
        pg8::GroupedOrder S{Loff, Ltile, Lend, LsmE, Ltile[NE] * 4, (Ltile[NE] + LsmE[63]) * 4, G, bid, (const char*)wgu_t, (size_t)DM * DM * 2, (size_t)256 * DM * 2};
        pg8::EpiAct E{act};
        pg8::gemm_phase<pg8::EpiAct, pg8::GroupedOrder, true, true>((PG8_LAS unsigned char*)lds_raw, g, S, E);
    }
    SEAM()
    REP(8) {
        pg8::Gemm g{act, FF, nullptr};
        pg8::GroupedOrder S{Loff, Ltile, Lend, LsmE, Ltile[NE] * 4, (Ltile[NE] + LsmE[63]) * 4, G, bid, (const char*)wd_t, (size_t)DM * FF * 2, (size_t)256 * FF * 2};
        pg8::EpiBf16 E{yexp, DM};
        pg8::gemm_phase<pg8::EpiBf16, pg8::GroupedOrder, false, true>((PG8_LAS unsigned char*)lds_raw, g, S, E);
    }
    SEAM()
    {
        const int nmine = (NTOK - gw + NGW - 1) / NGW;
        const float4* fg = (const float4*)final_g + lane;
        float4 gfin[4];
#pragma unroll
        for (int j = 0; j < 4; ++j) gfin[j] = fg[64 * j];
        for (int k0 = 0; k0 < nmine; k0 += 16) {
            const int kk = k0 + (lane & 15), rr = gw + NGW * (kk < nmine ? kk : k0);
            const int2 sv = *(const int2*)(tok_p + 2 * rr); const float2 gv = *(const float2*)(tok_g + 2 * rr);
            for (int k = k0; k < nmine && k < k0 + 16; k += 4) {
                int rT[4]; bool has[4]; int s0[4], s1[4]; float g0[4], g1[4];
#pragma unroll
                for (int t = 0; t < 4; ++t) { has[t] = k + t < nmine; const int l_ = has[t] ? k + t - k0 : k - k0; rT[t] = gw + NGW * (has[t] ? k + t : k);
                    s0[t] = __shfl(sv.x, l_); s1[t] = __shfl(sv.y, l_); g0[t] = __shfl(gv.x, l_); g1[t] = __shfl(gv.y, l_); }
                float4 xv[4][4]; uint2 ya[4][4], yb[4][4];
#pragma unroll
                for (int t = 0; t < 4; ++t)
#pragma unroll
                    for (int j = 0; j < 4; ++j) { xv[t][j] = ((const float4*)(x1 + (size_t)rT[t] * DM) + lane)[64 * j]; ya[t][j] = ((const uint2*)(yexp + (size_t)s0[t] * DM) + lane)[64 * j]; yb[t][j] = ((const uint2*)(yexp + (size_t)s1[t] * DM) + lane)[64 * j]; }
                float ssum[4];
#pragma unroll
                for (int t = 0; t < 4; ++t) { float a_ = 0.f;
#pragma unroll
                    for (int j = 0; j < 4; ++j) {
                        xv[t][j] = make_float4(xv[t][j].x + g0[t] * dn::lo_f(ya[t][j].x) + g1[t] * dn::lo_f(yb[t][j].x), xv[t][j].y + g0[t] * dn::hi_f(ya[t][j].x) + g1[t] * dn::hi_f(yb[t][j].x),
                                               xv[t][j].z + g0[t] * dn::lo_f(ya[t][j].y) + g1[t] * dn::lo_f(yb[t][j].y), xv[t][j].w + g0[t] * dn::hi_f(ya[t][j].y) + g1[t] * dn::hi_f(yb[t][j].y));
                        a_ += xv[t][j].x * xv[t][j].x + xv[t][j].y * xv[t][j].y + xv[t][j].z * xv[t][j].z + xv[t][j].w * xv[t][j].w; }
                    ssum[t] = a_; }
#pragma unroll
                for (int o = 1; o < 64; o <<= 1) {
#pragma unroll
                    for (int t = 0; t < 4; ++t) ssum[t] += __shfl_xor(ssum[t], o); }
#pragma unroll
                for (int t = 0; t < 4; ++t) { if (has[t]) { const float rs = rsqrtf(ssum[t] * (1.f / DM) + EPS); float4* od = (float4*)(outp + (size_t)rT[t] * DM) + lane;
#pragma unroll
                    for (int j = 0; j < 4; ++j) od[64 * j] = make_float4(xv[t][j].x * rs * gfin[j].x, xv[t][j].y * rs * gfin[j].y, xv[t][j].z * rs * gfin[j].z, xv[t][j].w * rs * gfin[j].w); } }
            }
        }
    }
    }
}

extern "C" void kernel_launch(void* const* d_in, const int* in_sizes, int n_in, void* d_out, int out_size, void* d_ws, size_t ws_size, hipStream_t stream) {
    static int grid_blocks = 0;
    if (!grid_blocks) {
        int dev = 0, cus = 0, per_cu = 0;
        (void)hipGetDevice(&dev);
        (void)hipDeviceGetAttribute(&cus, hipDeviceAttributeMultiprocessorCount, dev);
        (void)hipFuncSetAttribute((const void*)fwd_kernel, hipFuncAttributeMaxDynamicSharedMemorySize, LDS_BYTES);
        (void)hipOccupancyMaxActiveBlocksPerMultiprocessor(&per_cu, (const void*)fwd_kernel, NT, LDS_BYTES);
        if (per_cu < 1) per_cu = 1;
        if (per_cu > 1 && 2 * LDS_BYTES > 160 * 1024) per_cu = 1;
        grid_blocks = cus * per_cu;
        fprintf(stderr, "kernel_launch: cus %d per_cu %d grid %d ws_size %zu\n", cus, per_cu, grid_blocks, ws_size);
    }
    (void)hipMemsetAsync((char*)d_ws + WS_CTL, 0, CTL_ZERO_BYTES, stream);
    Params p{};
    for (int i = 0; i < 17; ++i) p.in[i] = (const float*)d_in[i];
    p.out = (float*)d_out; p.ws = (unsigned char*)d_ws;
    hipLaunchKernelGGL(fwd_kernel, dim3(grid_blocks), dim3(NT), LDS_BYTES, stream, p);
    hipError_t e = hipPeekAtLastError();
    if (e != hipSuccess) fprintf(stderr, "launch failed: %s (grid %d)\n", hipGetErrorString(e), grid_blocks);
}
```

```cpp
#include <hip/hip_runtime.h>
#include <cstdio>
#include <cstdint>

constexpr int BATCH = 8, SEQ = 2048, DM = 1024, NTOK = BATCH * SEQ;
constexpr int NH = 4, HD = 128, NPROJ = 3592, NPB = 3584;
constexpr int C_AH = 0, C_AB = 512, C_AC = 1024, C_Q = 1536, C_K = 2048, C_V = 2560, C_Z = 3072;
constexpr int NE = 32, FF = 512;
constexpr float EPS = 1e-6f;
constexpr int NT = 512;
#ifndef REP_PHASE
#define REP_PHASE -1
#endif
#define REP(k) for (int rep_ = 0; rep_ < ((REP_PHASE == (k)) ? 2 : 1); ++rep_)
constexpr int LDS_BYTES = 144 * 1024;
constexpr int LDS_TAB = 131072;

typedef unsigned short bf16_t;
constexpr size_t MiB = 1u << 20;
constexpr size_t WS_CTL = 0;
constexpr size_t WS_BAR = 65536;
constexpr size_t CTL_ZERO_BYTES = 131072;
constexpr size_t WS_RSTD2 = 1 * MiB;
constexpr size_t WS_TOKE = WS_RSTD2 + 65536;
constexpr size_t WS_TOKG = WS_TOKE + 131072;
constexpr size_t WS_TOKP = WS_TOKG + 131072;
constexpr size_t WS_SLOTTOK = WS_TOKP + 131072;
constexpr size_t WS_GL = WS_SLOTTOK + 131072;
constexpr size_t WS_CNTB = WS_GL + 8192;
constexpr size_t WS_BG = 2 * MiB;
constexpr size_t WS_WIN = 3 * MiB;
constexpr size_t WS_WOUT = 10 * MiB;
constexpr size_t WS_WGU = 12 * MiB;
constexpr size_t WS_WD = 76 * MiB;
constexpr size_t WS_PROJ = 108 * MiB;
constexpr size_t WS_HB = 220 * MiB;
constexpr size_t WS_YMIX = 220 * MiB;
constexpr size_t WS_AQK = 252 * MiB;
constexpr size_t WS_H2B = 108 * MiB;
constexpr size_t WS_ACT = 140 * MiB;
constexpr size_t WS_YEXP = 173 * MiB;

struct Params { const float* in[17]; float* out; unsigned char* ws; };

__device__ __forceinline__ float wave_sum(float v) {
#pragma unroll
    for (int o = 1; o < 64; o <<= 1) v += __shfl_xor(v, o);
    return v;
}
__device__ __forceinline__ float silu_f(float x) { return x / (1.f + expf(-x)); }
__device__ __forceinline__ float sigmoid_f(float x) { return 1.f / (1.f + expf(-x)); }
__device__ __forceinline__ float softplus_f(float x) { return fmaxf(x, 0.f) + log1pf(expf(-fabsf(x))); }
__device__ __forceinline__ float bf2f(bf16_t h) { return __uint_as_float((unsigned)h << 16); }
__device__ __forceinline__ unsigned f2bf(float f) { unsigned u = __float_as_uint(f); return (u + 0x7fffu + ((u >> 16) & 1u)) >> 16; }
__device__ __forceinline__ unsigned pk2(float lo, float hi) { return f2bf(lo) | (f2bf(hi) << 16); }


__device__ __forceinline__ float reduce8_tr(const float (&v)[8], int lane) {
    float a[4], b[2];
#pragma unroll
    for (int i = 0; i < 4; ++i) { const bool hi = lane & 32; const float send = hi ? v[i] : v[i + 4], keep = hi ? v[i + 4] : v[i]; a[i] = keep + __shfl_xor(send, 32); }
#pragma unroll
    for (int i = 0; i < 2; ++i) { const bool hi = lane & 16; const float send = hi ? a[i] : a[i + 2], keep = hi ? a[i + 2] : a[i]; b[i] = keep + __shfl_xor(send, 16); }
    const bool hi = lane & 8; const float send = hi ? b[0] : b[1], keep = hi ? b[1] : b[0];
    float c = keep + __shfl_xor(send, 8);
    c += __shfl_xor(c, 4); c += __shfl_xor(c, 2); c += __shfl_xor(c, 1);
    return c;
}
__device__ __forceinline__ float reduce4_tr(const float (&v)[4], int lane) {
    float a[2];
#pragma unroll
    for (int i = 0; i < 2; ++i) { const bool hi = lane & 32; const float send = hi ? v[i] : v[i + 2], keep = hi ? v[i + 2] : v[i]; a[i] = keep + __shfl_xor(send, 32); }
    const bool hi = lane & 16; const float send = hi ? a[0] : a[1], keep = hi ? a[1] : a[0];
    float c = keep + __shfl_xor(send, 16);
    c += __shfl_xor(c, 8); c += __shfl_xor(c, 4); c += __shfl_xor(c, 2); c += __shfl_xor(c, 1);
    return c;
}
__device__ __forceinline__ float lane_bcast(float v, int src) { return __int_as_float(__builtin_amdgcn_readlane(__float_as_int(v), src)); }

namespace pg8 {
#define PG8_LAS __attribute__((address_space(3)))
typedef short bf16x8 __attribute__((ext_vector_type(8)));
typedef float f32x4 __attribute__((ext_vector_type(4)));
typedef unsigned u32x4 __attribute__((ext_vector_type(4)));
constexpr int BM = 256, BK = 64, HALF = 128, HTB = HALF * BK * 2, STAGE_BYTES = 8 * HTB, NXCD = 8, WGM = 8;

__host__ __device__ __forceinline__ int lds_byte(int r, int c) { const int st = (r >> 4) * 2 + (c >> 5), rr = r & 15, cc = c & 31, ob = rr * 64 + cc * 2; return st * 1024 + (ob ^ (((ob >> 9) & 1) << 5)); }
__host__ __device__ __forceinline__ void stage_rc(int b, int& R, int& C) { const int st = b / 1024, sb = b % 1024, swz = sb ^ (((sb >> 9) & 1) << 5); R = (st >> 1) * 16 + swz / 64; C = (st & 1) * 32 + (swz % 64) / 2; }
__host__ __device__ __forceinline__ int perm32(int rho) { const int n = rho >> 4, i = rho & 15; return 8 * (i >> 2) + 4 * n + (i & 3); }

struct Unit { int arow0, rowend, pn, half; const char* B; };
struct Gemm { const bf16_t* A; int K; const int* gidx; };

struct DenseOrder {
    int nM, nN, nwg, G, c, M, nfull, tail; const char* Bt; size_t tstep;
    __device__ void init(int M_, int N, int K, const bf16_t* Bt_, int G_, int c_) { M = M_; nM = M / BM; nN = N / BM; nwg = nM * nN; G = G_; c = c_; Bt = (const char*)Bt_; tstep = (size_t)BM * K * 2;
        nfull = (nwg / G) * G; tail = nwg - nfull; if (2 * tail > G) { nfull = nwg; tail = 0; } }
    __device__ bool next(int i, Unit& u) const {
        const long L = (long)i * G + c; int wgid, hs = -1;
        if (L < nfull) wgid = (int)L;
        else { const long hu = L - nfull; if (hu >= 2 * tail) return false; wgid = nfull + (int)(hu % tail); hs = (int)(hu / tail); }
        { const int q = nwg / NXCD, r = nwg % NXCD, xcd = wgid % NXCD, off = wgid / NXCD; wgid = (xcd < r ? xcd * (q + 1) : r * (q + 1) + (xcd - r) * q) + off; }
        const int nig = WGM * nN, gid = wgid / nig, fm = gid * WGM, gsz = (nM - fm) < WGM ? (nM - fm) : WGM;
        const int pm = fm + ((wgid % nig) % gsz); u.pn = (wgid % nig) / gsz; u.B = Bt + (size_t)u.pn * tstep;
        if (hs < 0) { u.arow0 = pm * BM; u.rowend = M; u.half = 0; } else { u.arow0 = pm * BM + HALF * hs; u.rowend = u.arow0 + HALF; u.half = 1; }
        return true;
    }
};

typedef __bf16 bf16x2_t __attribute__((ext_vector_type(2)));
typedef float f32x2_t __attribute__((ext_vector_type(2)));
__device__ __forceinline__ unsigned cvt_pk_bf16(float lo, float hi) { const f32x2_t v = {lo, hi}; return __builtin_bit_cast(unsigned, __builtin_convertvector(v, bf16x2_t)); }

struct EpiBf16 {
    static constexpr bool PERM = true;
    bf16_t* O; int ldc;
    __device__ __forceinline__ void operator()(const f32x4 (&acc)[2][2][4][2], const Unit& u, int wr, int wc, int fr, int fq) const {
        const int row0 = u.arow0 + wr * 64 + fr, col0 = u.pn * BM + wc * 32 + 8 * fq;
#pragma unroll
        for (int ai = 0; ai < 2; ++ai)
#pragma unroll
            for (int m = 0; m < 4; ++m) { const int row = row0 + ai * HALF + m * 16; bf16_t* rowp = O + (size_t)row * ldc + col0;
                if (row < u.rowend) {
#pragma unroll
                    for (int bj = 0; bj < 2; ++bj) { const f32x4 v0 = acc[ai][bj][m][0], v1 = acc[ai][bj][m][1];
                        u32x4 w; w.x = cvt_pk_bf16(v0[0], v0[1]); w.y = cvt_pk_bf16(v0[2], v0[3]); w.z = cvt_pk_bf16(v1[0], v1[1]); w.w = cvt_pk_bf16(v1[2], v1[3]);
                        *(u32x4*)(rowp + bj * HALF) = w; } } }
    }
};
struct EpiResid {
    static constexpr bool PERM = false;
    const float* base; float* C; int ldc;
    __device__ __forceinline__ void operator()(const f32x4 (&acc)[2][2][4][2], const Unit& u, int wr, int wc, int fr, int fq) const {
        const int row0 = u.arow0 + wr * 64 + fr, col0 = u.pn * BM + wc * 32 + 4 * fq;
#pragma unroll
        for (int ai = 0; ai < 2; ++ai) {
            f32x4 bv[4][2][2];
#pragma unroll
            for (int m = 0; m < 4; ++m) { const size_t off = (size_t)(row0 + ai * HALF + m * 16) * ldc + col0;
#pragma unroll
                for (int bj = 0; bj < 2; ++bj)
#pragma unroll
                    for (int n = 0; n < 2; ++n) bv[m][bj][n] = *(const f32x4*)(base + off + bj * HALF + n * 16); }
#pragma unroll
            for (int m = 0; m < 4; ++m) { const size_t off = (size_t)(row0 + ai * HALF + m * 16) * ldc + col0;
#pragma unroll
                for (int bj = 0; bj < 2; ++bj)
#pragma unroll
                    for (int n = 0; n < 2; ++n) *(f32x4*)(C + off + bj * HALF + n * 16) = bv[m][bj][n] + acc[ai][bj][m][n]; }
        }
    }
};
struct EpiAct {
    static constexpr bool PERM = true;
    bf16_t* O;
    __device__ __forceinline__ void operator()(const f32x4 (&acc)[2][2][4][2], const Unit& u, int wr, int wc, int fr, int fq) const {
        const int row0 = u.arow0 + wr * 64 + fr, col0 = u.pn * HALF + wc * 32 + 8 * fq;
#pragma unroll
        for (int ai = 0; ai < 2; ++ai)
#pragma unroll
            for (int m = 0; m < 4; ++m) { const int row = row0 + ai * HALF + m * 16;
                if (row < u.rowend) { float v[8];
#pragma unroll
                    for (int n = 0; n < 2; ++n)
#pragma unroll
                        for (int j = 0; j < 4; ++j) { const float gt = acc[ai][0][m][n][j], up = acc[ai][1][m][n][j]; v[n * 4 + j] = gt * __builtin_amdgcn_rcpf(1.f + __builtin_amdgcn_exp2f(-1.4426950408889634f * gt)) * up; }
                    u32x4 w; w.x = cvt_pk_bf16(v[0], v[1]); w.y = cvt_pk_bf16(v[2], v[3]); w.z = cvt_pk_bf16(v[4], v[5]); w.w = cvt_pk_bf16(v[6], v[7]);
                    *(u32x4*)(O + (size_t)row * 512 + col0) = w; } }
    }
};
struct GroupedOrder {
    const int* Loff; const int* Ttile; const int* Lend; const int* LsmE; int nfullu, nunits, G, c; const char* Bt; size_t estride, tstep;
    __device__ bool next(int i, Unit& u) const {
        const int L = (G == 256) ? ((i * 8 + (c & 7)) * 32 + (c >> 3)) : (i * G + c);
        if (L >= nunits) return false;
        u.pn = L & 3;
        if (L < nfullu) { const int tile = L >> 2; int e = 0; while (Ttile[e + 1] <= tile) ++e;
            u.arow0 = Loff[e] + (tile - Ttile[e]) * BM; u.rowend = Lend[e]; u.half = 0; u.B = Bt + (size_t)e * estride + (size_t)u.pn * tstep; }
        else { const int e = LsmE[(L - nfullu) >> 2]; u.arow0 = Lend[e]; u.rowend = Loff[e + 1]; u.half = 1; u.B = Bt + (size_t)e * estride + (size_t)u.pn * tstep; }
        return true;
    }
};

template <class Epi, class Sched, bool GATHER, bool ALIGN_EPI>
__device__ __forceinline__ void gemm_phase(PG8_LAS unsigned char* lds, const Gemm g, const Sched& S, const Epi& E) {
    const int tid = threadIdx.x, wid = __builtin_amdgcn_readfirstlane(tid >> 6), lane = tid & 63, wr = wid >> 2, wc = wid & 3, fr = lane & 15, fq = lane >> 4;
    const int K = g.K, nt = K / BK;
    int RA[2], CA[2]; unsigned voffB[2];
#pragma unroll
    for (int i = 0; i < 2; ++i) { int R, C; stage_rc(tid * 16 + i * 8192, R, C); const int Rb = Epi::PERM ? ((R & ~31) + perm32(R & 31)) : R;
        RA[i] = R; CA[i] = C; voffB[i] = (unsigned)(Rb * K + C) * 2u; }
    const size_t kstep = (size_t)(BK * 2);
    const size_t hstep = (size_t)HALF * K * 2;
    const unsigned ldsw = (unsigned)wid * 1024u;
    const int aoff = lds_byte(wr * 64 + fr, fq * 8), boff = lds_byte(wc * 32 + fr, fq * 8);
    const char* A0 = (const char*)g.A;
#define PG8_SA(b, h) (((b) * 2 + (h)) * HTB)
#define PG8_SB(b, h) ((4 + (b) * 2 + (h)) * HTB)
#define PG8_STAGE(bufoff, gbase, voff) do { _Pragma("unroll") for (int _i = 0; _i < 2; ++_i) \
        __builtin_amdgcn_global_load_lds((const unsigned*)((const char*)(gbase) + (voff)[_i]), (PG8_LAS unsigned*)(lds + (bufoff) + ldsw + _i * 8192), 16, 0, 0); } while (0)
#define PG8_LDA(dst, b, h) do { _Pragma("unroll") for (int m = 0; m < 4; ++m) _Pragma("unroll") for (int k = 0; k < 2; ++k) dst[m][k] = *(const PG8_LAS bf16x8*)(lds + PG8_SA(b, h) + aoff + m * 2048 + k * 1024); } while (0)
#define PG8_LDB(dst, b, h) do { _Pragma("unroll") for (int n = 0; n < 2; ++n) _Pragma("unroll") for (int k = 0; k < 2; ++k) dst[n][k] = *(const PG8_LAS bf16x8*)(lds + PG8_SB(b, h) + boff + n * 2048 + k * 1024); } while (0)
#define PG8_MMA(ai, bj, At, Bt) do { __builtin_amdgcn_s_setprio(1); _Pragma("unroll") for (int m = 0; m < 4; ++m) _Pragma("unroll") for (int n = 0; n < 2; ++n) _Pragma("unroll") for (int k = 0; k < 2; ++k) \
        acc[ai][bj][m][n] = __builtin_amdgcn_mfma_f32_16x16x32_bf16(Bt[n][k], At[m][k], acc[ai][bj][m][n], 0, 0, 0); __builtin_amdgcn_s_setprio(0); } while (0)
#define PG8_WAIT_V(n) asm volatile("s_waitcnt vmcnt(" #n ")" ::: "memory")
#define PG8_WAIT_L(n) asm volatile("s_waitcnt lgkmcnt(" #n ")" ::: "memory")
#define PG8_BAR __builtin_amdgcn_s_barrier()
#define PG8_SCHED __builtin_amdgcn_sched_barrier(0)
#define PG8_AOFF(dst, u) do { _Pragma("unroll") for (int _h = 0; _h < 2; ++_h) _Pragma("unroll") for (int _i = 0; _i < 2; ++_i) { int _r = (u).arow0 + _h * HALF + RA[_i]; _r = _r < (u).rowend ? _r : (u).rowend - 1; \
        if (GATHER) _r = g.gidx[_r]; dst[_h][_i] = (unsigned)(_r * K + CA[_i]) * 2u; } } while (0)
    Unit cur, nxt; int ui = 0;
    if (!S.next(0, cur)) return;
    f32x4 acc[2][2][4][2];
#pragma unroll
    for (int a = 0; a < 2; ++a)
#pragma unroll
        for (int b = 0; b < 2; ++b)
#pragma unroll
            for (int m = 0; m < 4; ++m)
#pragma unroll
                for (int n = 0; n < 2; ++n) acc[a][b][m][n] = (f32x4){0.f, 0.f, 0.f, 0.f};
    bf16x8 At[4][2], B0[2][2], B1[2][2];
    unsigned cvA[2][2], nvA[2][2];
    PG8_AOFF(cvA, cur);
    const char* cB = cur.B;
    PG8_STAGE(PG8_SB(0, 0), cB, voffB); PG8_STAGE(PG8_SB(0, 1), cB + hstep, voffB); PG8_STAGE(PG8_SA(0, 0), A0, cvA[0]); PG8_STAGE(PG8_SA(0, 1), A0, cvA[1]);
    if (wr == 1) PG8_BAR;
    PG8_WAIT_V(2); PG8_BAR;
    PG8_STAGE(PG8_SB(1, 0), cB + kstep, voffB); PG8_STAGE(PG8_SA(1, 0), A0 + kstep, cvA[0]); PG8_STAGE(PG8_SB(1, 1), cB + hstep + kstep, voffB);
    PG8_WAIT_V(6); PG8_BAR;
    for (;;) {
        const bool has_next = S.next(ui + 1, nxt);
        if (has_next) { PG8_AOFF(nvA, nxt); } else {
#pragma unroll
            for (int h = 0; h < 2; ++h)
#pragma unroll
                for (int i = 0; i < 2; ++i) nvA[h][i] = cvA[h][i]; }
        const char* nB = has_next ? nxt.B : cB;
        for (int t = 0; t < nt; t += 2) {
            const bool last = (t == nt - 2);
            const char* a1 = A0 + (size_t)(t + 1) * kstep;
            const char* a2 = last ? A0 : A0 + (size_t)(t + 2) * kstep; const char* b2 = last ? nB : cB + (size_t)(t + 2) * kstep;
            const char* a3 = a2 + kstep; const char* b3 = b2 + kstep;
            unsigned s2[2][2];
#pragma unroll
            for (int h = 0; h < 2; ++h)
#pragma unroll
                for (int i = 0; i < 2; ++i) s2[h][i] = last ? nvA[h][i] : cvA[h][i];
            PG8_LDB(B0, 0, 0); PG8_LDB(B1, 0, 1); PG8_SCHED; PG8_LDA(At, 0, 0); PG8_STAGE(PG8_SA(1, 1), a1, cvA[1]);
            PG8_WAIT_V(8); PG8_WAIT_L(0); PG8_BAR; PG8_MMA(0, 0, At, B0); PG8_MMA(0, 1, At, B1); PG8_BAR; PG8_SCHED;
            PG8_LDA(At, 0, 1); PG8_STAGE(PG8_SB(0, 0), b2, voffB); PG8_STAGE(PG8_SB(0, 1), b2 + hstep, voffB); PG8_STAGE(PG8_SA(0, 0), a2, s2[0]);
            PG8_WAIT_V(8); PG8_WAIT_L(0); PG8_BAR; if (!cur.half) { PG8_MMA(1, 0, At, B0); PG8_MMA(1, 1, At, B1); } PG8_BAR; PG8_SCHED;
            PG8_LDB(B0, 1, 0); PG8_LDB(B1, 1, 1); PG8_SCHED; PG8_LDA(At, 1, 0); PG8_STAGE(PG8_SA(0, 1), a2, s2[1]);
            PG8_WAIT_V(8); PG8_WAIT_L(0); PG8_BAR; PG8_MMA(0, 0, At, B0); PG8_MMA(0, 1, At, B1); PG8_BAR; PG8_SCHED;
            PG8_LDA(At, 1, 1); PG8_STAGE(PG8_SB(1, 0), b3, voffB); PG8_STAGE(PG8_SB(1, 1), b3 + hstep, voffB); PG8_STAGE(PG8_SA(1, 0), a3, s2[0]);
            PG8_WAIT_V(8); PG8_WAIT_L(0); PG8_BAR; if (!cur.half) { PG8_MMA(1, 0, At, B0); PG8_MMA(1, 1, At, B1); } PG8_BAR; PG8_SCHED;
        }
        if constexpr (ALIGN_EPI) { if (wr == 0) PG8_BAR; }
        E(acc, cur, wr, wc, fr, fq);
        if (!has_next) break;
#pragma unroll
        for (int a = 0; a < 2; ++a)
#pragma unroll
            for (int b = 0; b < 2; ++b)
#pragma unroll
                for (int m = 0; m < 4; ++m)
#pragma unroll
                    for (int n = 0; n < 2; ++n) acc[a][b][m][n] = (f32x4){0.f, 0.f, 0.f, 0.f};
        cur = nxt; cB = nB; ++ui;
#pragma unroll
        for (int h = 0; h < 2; ++h)
#pragma unroll
            for (int i = 0; i < 2; ++i) cvA[h][i] = nvA[h][i];
        if constexpr (ALIGN_EPI) { if (wr == 1) PG8_BAR; }
    }
    PG8_WAIT_V(0);
    if constexpr (!ALIGN_EPI) { if (wr == 0) PG8_BAR; }
    PG8_BAR;
#undef PG8_SA
#undef PG8_SB
#undef PG8_STAGE
#undef PG8_LDA
#undef PG8_LDB
#undef PG8_MMA
#undef PG8_WAIT_V
#undef PG8_WAIT_L
#undef PG8_BAR
#undef PG8_SCHED
#undef PG8_AOFF
}
}


namespace dn {
typedef short bf16x8 __attribute__((ext_vector_type(8)));
typedef float f32x4 __attribute__((ext_vector_type(4)));
typedef unsigned u32x4 __attribute__((ext_vector_type(4)));
typedef unsigned u32x2 __attribute__((ext_vector_type(2)));
__device__ __forceinline__ int perm_pos(int kl) { return 8 * ((kl >> 2) & 3) + 4 * (kl >> 4) + (kl & 3); }
__device__ __forceinline__ int perm_inv(int p) { return 16 * ((p >> 2) & 1) + 4 * (p >> 3) + (p & 3); }
typedef __bf16 bf16x2_t __attribute__((ext_vector_type(2)));
typedef float f32x2_t __attribute__((ext_vector_type(2)));
__device__ __forceinline__ unsigned pkbf(float lo, float hi) { const f32x2_t v = {lo, hi}; return __builtin_bit_cast(unsigned, __builtin_convertvector(v, bf16x2_t)); }
__device__ __forceinline__ float lo_f(unsigned u) { return __uint_as_float(u << 16); }
__device__ __forceinline__ float hi_f(unsigned u) { return __uint_as_float(u & 0xffff0000u); }
constexpr int P2_LT = 0, P2_G = 16384, P2_QB = 17408, P2_KB = P2_QB + 17408, P2_RU = P2_KB + 17408, P2_RW = P2_RU + 32768;
constexpr int ROWB = 272;

struct DnBufs { bf16_t* UT; bf16_t* WN; bf16_t* QD; bf16_t* KDT; bf16_t* AQK; float* GL; };

__device__ __forceinline__ float silu_fast(float a) { return a * __builtin_amdgcn_rcpf(1.f + __builtin_amdgcn_exp2f(-1.4426950408889634f * a)); }
constexpr int P2_END = P2_RW + 32768;
template <class Hook>
__device__ __forceinline__ void prep(unsigned char* lds, int tid, int bid, int G, const bf16_t* proj, const float* bg, const float* dn_conv_w, const DnBufs B, Hook hook) {
    const int lane = tid & 63, wave = tid >> 6;
    float* RU = (float*)(lds + P2_RU); float* RW = (float*)(lds + P2_RW); float* LT = (float*)(lds + P2_LT); float* GS = (float*)(lds + P2_G);
    const int nitems = BATCH * NH * (SEQ / 64);
    const int r0 = wave * 8;
    unsigned xin[11][3]; float gin, bin;
#define DN_PREP_LOAD(item_) do { const int bh_ = (item_) >> 5, c_ = (item_) & 31, b_ = bh_ >> 2, h_ = bh_ & 3, t0_ = c_ * 64; \
        _Pragma("unroll") for (int rr = 0; rr < 11; ++rr) { const int t = t0_ + r0 + rr - 3; \
            _Pragma("unroll") for (int wh = 0; wh < 3; ++wh) { const unsigned v_ = *(const unsigned*)(proj + ((size_t)b_ * SEQ + (t >= 0 ? t : 0)) * NPB + C_Q + wh * 512 + h_ * 128 + 2 * lane); xin[rr][wh] = (t >= 0) ? v_ : 0u; } } \
        gin = bg[((size_t)b_ * SEQ + t0_ + lane) * 8 + 4 + h_]; bin = bg[((size_t)b_ * SEQ + t0_ + lane) * 8 + h_]; } while (0)
    for (int item = bid; item < nitems; item += G) {
        const int bh = item >> 5, h = bh & 3;
        DN_PREP_LOAD(item);
        float cw[3][4][2];
#pragma unroll
        for (int wh = 0; wh < 3; ++wh)
#pragma unroll
            for (int j = 0; j < 4; ++j) { const float2 w2 = *(const float2*)(dn_conv_w + j * 1536 + wh * 512 + h * 128 + 2 * lane); cw[wh][j][0] = w2.x; cw[wh][j][1] = w2.y; }
        float Gc = gin;
#pragma unroll
        for (int o = 1; o < 64; o <<= 1) { const float t = __shfl_up(Gc, o); if (lane >= o) Gc += t; }
        const float glast = __shfl(Gc, 63), eGl = __expf(Gc), bel = bin;
        if (wave == 0) { GS[lane] = Gc; GS[64 + lane] = eGl; GS[128 + lane] = bel; GS[192 + lane] = __expf(glast - Gc); if (lane == 0) B.GL[item] = glast; }
#pragma unroll
        for (int rr = 0; rr < 8; ++rr) {
            const int i = r0 + rr;
            float val[3][2];
#pragma unroll
            for (int wh = 0; wh < 3; ++wh) { float a0 = 0.f, a1 = 0.f;
#pragma unroll
                for (int j = 0; j < 4; ++j) { a0 += lo_f(xin[rr + j][wh]) * cw[wh][j][0]; a1 += hi_f(xin[rr + j][wh]) * cw[wh][j][1]; }
                val[wh][0] = silu_fast(a0); val[wh][1] = silu_fast(a1); }
            float sq = val[0][0] * val[0][0] + val[0][1] * val[0][1], sk = val[1][0] * val[1][0] + val[1][1] * val[1][1];
#pragma unroll
            for (int o = 1; o < 64; o <<= 1) { sq += __shfl_xor(sq, o); sk += __shfl_xor(sk, o); }
            const float fq = rsqrtf(sq + EPS) * 0.08838834764831845f, fk = rsqrtf(sk + EPS);
            const float eG = __shfl(eGl, i), be = __shfl(bel, i);
            const float q0 = val[0][0] * fq, q1 = val[0][1] * fq, k0 = val[1][0] * fk, k1 = val[1][1] * fk;
            *(unsigned*)(lds + P2_QB + i * ROWB + 4 * lane) = pkbf(q0, q1);
            *(unsigned*)(lds + P2_KB + i * ROWB + 4 * lane) = pkbf(k0, k1);
            const int kl = (2 * lane) & 31, pos = ((2 * lane) & ~31) + perm_pos(kl);
            *(unsigned*)(B.QD + ((size_t)item * 64 + i) * 128 + pos) = pkbf(q0 * eG, q1 * eG);
            *(float2*)(RW + i * 128 + 2 * lane) = make_float2(be * eG * k0, be * eG * k1);
            *(float2*)(RU + i * 128 + 2 * lane) = make_float2(be * val[2][0], be * val[2][1]);
        }
        __syncthreads();
        {
            const int g = lane >> 4, cl = lane & 15, mi = wave >> 1, nj0 = 2 * (wave & 1);
            bf16x8 ka[4], qa[4];
#pragma unroll
            for (int s_ = 0; s_ < 4; ++s_) { ka[s_] = *(const bf16x8*)(lds + P2_KB + (16 * mi + cl) * ROWB + (32 * s_ + 8 * g) * 2); qa[s_] = *(const bf16x8*)(lds + P2_QB + (16 * mi + cl) * ROWB + (32 * s_ + 8 * g) * 2); }
#pragma unroll
            for (int nn = 0; nn < 2; ++nn) {
                const int nj = nj0 + nn;
                f32x4 akk = {0.f, 0.f, 0.f, 0.f}, aqk = {0.f, 0.f, 0.f, 0.f};
#pragma unroll
                for (int s_ = 0; s_ < 4; ++s_) { const bf16x8 kb = *(const bf16x8*)(lds + P2_KB + (16 * nj + cl) * ROWB + (32 * s_ + 8 * g) * 2);
                    akk = __builtin_amdgcn_mfma_f32_16x16x32_bf16(ka[s_], kb, akk, 0, 0, 0); aqk = __builtin_amdgcn_mfma_f32_16x16x32_bf16(qa[s_], kb, aqk, 0, 0, 0); }
                const int j = 16 * nj + cl; const float Gj = GS[j];
                float lt[4];
                const int jpos = (j & ~31) + perm_pos(j & 31);
#pragma unroll
                for (int x_ = 0; x_ < 4; ++x_) { const int i = 16 * mi + 4 * g + x_; const float dec = __expf(fminf(GS[i] - Gj, 0.f));
                    lt[x_] = (i > j) ? GS[128 + i] * akk[x_] * dec : 0.f;
                    const float a = (i >= j) ? aqk[x_] * dec : 0.f;
                    B.AQK[((size_t)item * 64 + i) * 64 + jpos] = (bf16_t)(pkbf(a, 0.f) & 0xffffu); }
                *(float4*)(LT + j * 64 + 16 * mi + 4 * g) = make_float4(lt[0], lt[1], lt[2], lt[3]);
            }
        }
        __syncthreads();
        if (tid < 256) {
            const float* src = (tid < 128) ? (RU + tid) : (RW + (tid - 128));
            typedef __attribute__((address_space(3))) float lds_f32;
            const lds_f32* LTp = (const lds_f32*)(LT); asm volatile("" : "+v"(LTp));
            float acc[64];
#pragma unroll
            for (int i = 0; i < 64; ++i) acc[i] = src[i * 128];
#pragma unroll
            for (int j = 0; j < 63; ++j) {
                const float xj = acc[j];
#pragma unroll
                for (int q = (j + 1) >> 2; q < 16; ++q) {
                    const f32x4 l4 = *(const __attribute__((address_space(3))) f32x4*)(LTp + j * 64 + 4 * q);
                    if (4 * q + 0 > j) acc[4 * q + 0] -= l4.x * xj;
                    if (4 * q + 1 > j) acc[4 * q + 1] -= l4.y * xj;
                    if (4 * q + 2 > j) acc[4 * q + 2] -= l4.z * xj;
                    if (4 * q + 3 > j) acc[4 * q + 3] -= l4.w * xj;
                }
            }
            if (tid < 128) {
                u32x4* dst = (u32x4*)(B.UT + ((size_t)item * 128 + tid) * 64);
#pragma unroll
                for (int q = 0; q < 8; ++q) { u32x4 w; w.x = pkbf(acc[8 * q], acc[8 * q + 1]); w.y = pkbf(acc[8 * q + 2], acc[8 * q + 3]); w.z = pkbf(acc[8 * q + 4], acc[8 * q + 5]); w.w = pkbf(acc[8 * q + 6], acc[8 * q + 7]); dst[q] = w; }
            } else {
                const int dk = tid - 128, pos = (dk & ~31) + perm_pos(dk & 31);
                bf16_t* dst = B.WN + (size_t)item * 64 * 128 + pos;
#pragma unroll
                for (int i = 0; i < 64; ++i) dst[i * 128] = (bf16_t)(pkbf(-acc[i], 0.f) & 0xffffu);
            }
        } else if (tid < 384) {
            const int dk = tid - 256;
            u32x4* dst = (u32x4*)(B.KDT + ((size_t)item * 128 + dk) * 64);
#pragma unroll
            for (int q = 0; q < 8; ++q) { float v[8];
#pragma unroll
                for (int e = 0; e < 8; ++e) { const int p_ = 8 * q + e, i = (p_ & ~31) + perm_inv(p_ & 31); v[e] = bf2f(*(const bf16_t*)(lds + P2_KB + i * ROWB + 2 * dk)) * GS[192 + i]; }
                u32x4 w; w.x = pkbf(v[0], v[1]); w.y = pkbf(v[2], v[3]); w.z = pkbf(v[4], v[5]); w.w = pkbf(v[6], v[7]); dst[q] = w; }
        }
        if (tid >= 256) hook(item, wave - 4, lane);
        __syncthreads();
    }
#undef DN_PREP_LOAD
}

constexpr int SROW = 288, SKROW = 160;
constexpr int SC_WN = 0, SC_QD = 64 * SROW, SC_KDT = 128 * SROW, SC_AQK = SC_KDT + 128 * SKROW, SC_BUF = SC_AQK + 64 * SKROW  ;
__device__ __forceinline__ void scan(unsigned char* lds, int tid, int bid, int G, const DnBufs B, bf16_t* ymix) {
    (void)ymix;
    const int lane = tid & 63, wave = __builtin_amdgcn_readfirstlane(tid >> 6), g = lane >> 4, cl = lane & 15;
#define DN_BAR() do { asm volatile("s_waitcnt lgkmcnt(0)" ::: "memory"); __builtin_amdgcn_s_barrier(); asm volatile("" ::: "memory"); } while (0)
    for (int unit = bid; unit < 2 * BATCH * NH; unit += G) {
        const int bh = unit >> 1;
        __syncthreads();
        if (wave < 4) {
            const int wdv = 4 * (unit & 1) + wave, dv = 16 * wdv + cl;
            f32x4 S[8]; bf16x8 Sb[4];
#pragma unroll
            for (int r = 0; r < 8; ++r) S[r] = (f32x4){0.f, 0.f, 0.f, 0.f};
#pragma unroll
            for (int s_ = 0; s_ < 4; ++s_) Sb[s_] = (bf16x8){0, 0, 0, 0, 0, 0, 0, 0};
            const float eglv = __expf(B.GL[bh * 32 + (lane & 31)]);
            u32x2 uA[4], uB[4];
            f32x4 vn[4];
#define DN_LOAD_U(upre, c_) do { const size_t it_ = (size_t)(bh * 32 + (c_)); \
            _Pragma("unroll") for (int m_ = 0; m_ < 4; ++m_) upre[m_] = *(const u32x2*)(B.UT + (it_ * 128 + dv) * 64 + 16 * m_ + 4 * g); } while (0)
#define DN_VN(upre) do { _Pragma("unroll") for (int m = 0; m < 4; ++m) vn[m] = (f32x4){lo_f(upre[m].x), hi_f(upre[m].x), lo_f(upre[m].y), hi_f(upre[m].y)}; } while (0)
#define DN_SB() __builtin_amdgcn_sched_barrier(0)
#define DN_LDW(f, off_, m0_) do { _Pragma("unroll") for (int m = 0; m < 2; ++m) _Pragma("unroll") for (int s_ = 0; s_ < 4; ++s_) f[m * 4 + s_] = *(const bf16x8*)(buf + (off_) + (16 * ((m0_) + m) + cl) * SROW + (32 * s_ + 8 * g) * 2); } while (0)
#define DN_LDK(f, off_, r0_) do { _Pragma("unroll") for (int r = 0; r < 4; ++r) _Pragma("unroll") for (int s_ = 0; s_ < 2; ++s_) f[r * 2 + s_] = *(const bf16x8*)(buf + (off_) + (16 * ((r0_) + r) + cl) * SKROW + (32 * s_ + 8 * g) * 2); } while (0)
#define DN_MMW(acc, m0_, f) do { _Pragma("unroll") for (int s_ = 0; s_ < 4; ++s_) _Pragma("unroll") for (int m = 0; m < 2; ++m) acc[(m0_) + m] = __builtin_amdgcn_mfma_f32_16x16x32_bf16(f[m * 4 + s_], Sb[s_], acc[(m0_) + m], 0, 0, 0); } while (0)
#define DN_MMK(acc, r0_, f) do { _Pragma("unroll") for (int s_ = 0; s_ < 2; ++s_) _Pragma("unroll") for (int r = 0; r < 4; ++r) acc[(r0_) + r] = __builtin_amdgcn_mfma_f32_16x16x32_bf16(f[r * 2 + s_], Vb[s_], acc[(r0_) + r], 0, 0, 0); } while (0)
#define DN_CHUNK(bufoff_, c_) do { \
            const unsigned char* buf = lds + (bufoff_); const int item = bh * 32 + (c_); \
            const float egl = __shfl(eglv, (c_)); \
            f32x4 o[4]; \
            _Pragma("unroll") for (int m = 0; m < 4; ++m) o[m] = (f32x4){0.f, 0.f, 0.f, 0.f}; \
            bf16x8 fA[8], fB[8]; \
            DN_LDW(fA, SC_WN, 0); DN_LDW(fB, SC_WN, 2); DN_SB(); \
            DN_MMW(vn, 0, fA); DN_SB(); DN_LDW(fA, SC_QD, 0); DN_SB(); \
            DN_MMW(vn, 2, fB); DN_SB(); DN_LDW(fB, SC_QD, 2); DN_SB(); \
            bf16x8 Vb[2]; \
            _Pragma("unroll") for (int s_ = 0; s_ < 2; ++s_) { u32x4 w; w.x = pkbf(vn[2 * s_][0], vn[2 * s_][1]); w.y = pkbf(vn[2 * s_][2], vn[2 * s_][3]); w.z = pkbf(vn[2 * s_ + 1][0], vn[2 * s_ + 1][1]); w.w = pkbf(vn[2 * s_ + 1][2], vn[2 * s_ + 1][3]); \
                Vb[s_] = __builtin_bit_cast(bf16x8, w); } \
            DN_MMW(o, 0, fA); DN_SB(); DN_LDK(fA, SC_KDT, 0); DN_SB(); \
            DN_MMW(o, 2, fB); DN_SB(); DN_LDK(fB, SC_KDT, 4); DN_SB(); \
            _Pragma("unroll") for (int r = 0; r < 8; ++r) S[r] = S[r] * egl; \
            DN_MMK(S, 0, fA); DN_SB(); DN_LDK(fA, SC_AQK, 0); DN_SB(); \
            DN_MMK(S, 4, fB); DN_SB(); \
            DN_MMK(o, 0, fA); DN_SB(); \
            _Pragma("unroll") for (int s_ = 0; s_ < 4; ++s_) { u32x4 w; w.x = pkbf(S[2 * s_][0], S[2 * s_][1]); w.y = pkbf(S[2 * s_][2], S[2 * s_][3]); w.z = pkbf(S[2 * s_ + 1][0], S[2 * s_ + 1][1]); w.w = pkbf(S[2 * s_ + 1][2], S[2 * s_ + 1][3]); \
                Sb[s_] = __builtin_bit_cast(bf16x8, w); } \
            { bf16_t* od_ = B.UT + ((size_t)item * 128 + 16 * wdv) * 64 + lane; \
              _Pragma("unroll") for (int m = 0; m < 4; ++m) _Pragma("unroll") for (int x_ = 0; x_ < 4; ++x_) od_[(m * 4 + x_) * 64] = (bf16_t)(pkbf(o[m][x_], 0.f) & 0xffffu); } \
        } while (0)
            DN_LOAD_U(uA, 0); DN_LOAD_U(uB, 1);
            DN_BAR();
            for (int c = 0; c < SEQ / 64; c += 2) {
                DN_VN(uA); if (c + 2 < SEQ / 64) DN_LOAD_U(uA, c + 2);
                DN_CHUNK(0, c);
                DN_BAR();
                DN_VN(uB); if (c + 3 < SEQ / 64) DN_LOAD_U(uB, c + 3);
                DN_CHUNK(SC_BUF, c + 1);
                DN_BAR();
            }
#undef DN_LOAD_U
#undef DN_VN
#undef DN_SB
#undef DN_LDW
#undef DN_LDK
#undef DN_MMW
#undef DN_MMK
#undef DN_CHUNK
        } else {
            const int lt = tid - 256;
            const int o_w = (lt >> 4) * SROW + (lt & 15) * 16, o_k = (lt >> 3) * SKROW + (lt & 7) * 16;
            u32x4 p0[14], p1[14], p2[14];
#define DN_LOADP(pre, c_) do { const size_t it_ = (size_t)(bh * 32 + (c_)); \
            _Pragma("unroll") for (int q = 0; q < 4; ++q) { pre[q] = *(const u32x4*)(B.WN + it_ * 8192 + (size_t)(lt + 256 * q) * 8); pre[4 + q] = *(const u32x4*)(B.QD + it_ * 8192 + (size_t)(lt + 256 * q) * 8); \
                pre[8 + q] = *(const u32x4*)(B.KDT + it_ * 8192 + (size_t)(lt + 256 * q) * 8); } \
            _Pragma("unroll") for (int q = 0; q < 2; ++q) pre[12 + q] = *(const u32x4*)(B.AQK + it_ * 4096 + (size_t)(lt + 256 * q) * 8); } while (0)
#define DN_WRITEP(pre, bufoff_) do { unsigned char* d_ = lds + (bufoff_); \
            _Pragma("unroll") for (int q = 0; q < 4; ++q) { *(u32x4*)(d_ + SC_WN + o_w + q * 16 * SROW) = pre[q]; *(u32x4*)(d_ + SC_QD + o_w + q * 16 * SROW) = pre[4 + q]; *(u32x4*)(d_ + SC_KDT + o_k + q * 32 * SKROW) = pre[8 + q]; } \
            _Pragma("unroll") for (int q = 0; q < 2; ++q) *(u32x4*)(d_ + SC_AQK + o_k + q * 32 * SKROW) = pre[12 + q]; } while (0)
            DN_LOADP(p0, 0); DN_LOADP(p1, 1); DN_LOADP(p2, 2);
            DN_WRITEP(p0, 0);
            DN_BAR();
            DN_LOADP(p0, 3);
#define DN_STEP(j_, set_, bufoff_) do { const int cc_ = c + (j_); if (cc_ < SEQ / 64) { if (cc_ + 1 < SEQ / 64) DN_WRITEP(set_, bufoff_); DN_BAR(); if (cc_ + 4 < SEQ / 64) DN_LOADP(set_, cc_ + 4); } } while (0)
            for (int c = 0; c < SEQ / 64; c += 6) {
                DN_STEP(0, p1, SC_BUF); DN_STEP(1, p2, 0); DN_STEP(2, p0, SC_BUF); DN_STEP(3, p1, 0); DN_STEP(4, p2, SC_BUF); DN_STEP(5, p0, 0);
            }
#undef DN_STEP
#undef DN_LOADP
#undef DN_WRITEP
        }
        __syncthreads();
    }
#undef DN_BAR
}
}

__device__ __forceinline__ void transpose_item(const float* W, int ldw, int k0, int n0, bf16_t* WT, int ldk, int dst_row0, float* scr_f, int lane) {
    unsigned* scr = (unsigned*)scr_f;
    const int c4 = (lane & 7) * 4, rq = lane >> 3;
    float4 lo[4], hi[4];
#pragma unroll
    for (int i = 0; i < 4; ++i) { const float* src = W + (size_t)(k0 + 2 * (rq + 8 * i)) * ldw + n0 + c4; lo[i] = *(const float4*)src; hi[i] = *(const float4*)(src + ldw); }
#pragma unroll
    for (int i = 0; i < 4; ++i) { const int kp = rq + 8 * i; unsigned* d = scr + c4 * 36 + kp;
        d[0] = dn::pkbf(lo[i].x, hi[i].x); d[36] = dn::pkbf(lo[i].y, hi[i].y); d[72] = dn::pkbf(lo[i].z, hi[i].z); d[108] = dn::pkbf(lo[i].w, hi[i].w); }
    asm volatile("s_waitcnt lgkmcnt(0)" ::: "memory");
#pragma unroll
    for (int j = 0; j < 4; ++j) { const int n = rq + 8 * j; const uint4 o = *(const uint4*)(scr + n * 36 + 4 * (lane & 7));
        *(uint4*)(WT + (size_t)(dst_row0 + n) * ldk + k0 + 8 * (lane & 7)) = o; }
    asm volatile("s_waitcnt lgkmcnt(0)" ::: "memory");
}

constexpr int CV_IG = NE * 16 * 16, CV_ID = NE * 8 * 32, CV_PREP = 6;
__device__ __forceinline__ void conv_item(int r, const float* w_gate, const float* w_up, const float* w_down, bf16_t* wgu_t, bf16_t* wd_t, float* scr, int lane) {
    if (r < 2 * CV_IG) { const int up = r >= CV_IG; if (up) r -= CV_IG; const int e = r >> 8, kb = (r >> 4) & 15, nb = r & 15, n0 = nb * 32;
        transpose_item((up ? w_up : w_gate) + (size_t)e * DM * FF, FF, kb * 64, n0, wgu_t + (size_t)e * DM * DM, DM, (n0 >> 7) * 256 + (n0 & 127) + (up ? 128 : 0), scr, lane); return; }
    r -= 2 * CV_IG;
    { const int e = r >> 8, kb = (r >> 5) & 7, nb = r & 31; transpose_item(w_down + (size_t)e * FF * DM, DM, kb * 64, nb * 32, wd_t + (size_t)e * DM * FF, FF, nb * 32, scr, lane); }
}

#define XB_TMO      128
#define XB_XCNT(j)  (256  + 64 * (j))
#define XB_XSUB(j)  (1280 + 64 * (j))
#define XB_XGEN(j)  (2304 + 64 * (j))
#define XB_TOP      3328
#define XB_TOPGEN   3392
#define XCD_BAR_WORDS 3456
#define XB_SPIN_CAP (1u << 18)
#define XLAS __attribute__((address_space(3)))
__device__ __forceinline__ unsigned xb_ld(unsigned* p)              { return __hip_atomic_load(p, __ATOMIC_RELAXED, __HIP_MEMORY_SCOPE_AGENT); }
__device__ __forceinline__ unsigned xb_add(unsigned* p, unsigned v) { return __hip_atomic_fetch_add(p, v, __ATOMIC_RELAXED, __HIP_MEMORY_SCOPE_AGENT); }
__device__ __forceinline__ unsigned xb_xcc_id() { return (unsigned)__builtin_amdgcn_s_getreg((3 << 11) | 20) & 0xFu; }
#define XB_SPIN(cond, bar) do { unsigned _sp = 0; while (cond) { if (_sp < 32u) __builtin_amdgcn_s_sleep(1); else __builtin_amdgcn_s_sleep(24); \
    if ((++_sp & 255u) == 0u) { if (xb_ld(&(bar)[XB_TMO])) break; if (_sp > XB_SPIN_CAP) { atomicAdd(&(bar)[XB_TMO], 1u); break; } } } } while (0)
struct XcdBarrier { unsigned* bar; unsigned x; volatile XLAS unsigned* st; };
__device__ __forceinline__ XcdBarrier xcd_barrier_post(unsigned* bar, volatile XLAS unsigned* st) {
    XcdBarrier b; b.bar = bar; b.x = xb_xcc_id(); b.st = st;
    if (threadIdx.x == 0) (void)xb_add(&bar[XB_XCNT(b.x)], 1u);
    return b;
}
__device__ __forceinline__ void xcd_barrier_complete(unsigned* bar, unsigned x, unsigned& nloc, unsigned& nx) {
    const unsigned G = gridDim.x * gridDim.y * gridDim.z;
    unsigned sum, cnt, mine, sp = 0u;
    for (;;) {
        sum = 0u; cnt = 0u; mine = 0u;
#pragma unroll
        for (unsigned j = 0; j < 16; ++j) { const unsigned c = xb_ld(&bar[XB_XCNT(j)]); sum += c; cnt += (c > 0u) ? 1u : 0u; mine = (j == x) ? c : mine; }
        if (sum == G) break;
        __builtin_amdgcn_s_sleep(1);
        if ((++sp & 255u) == 0u) { if (xb_ld(&bar[XB_TMO])) break; if (sp > XB_SPIN_CAP) { atomicAdd(&bar[XB_TMO], 1u); break; } }
    }
    nloc = mine > 0u ? mine : 1u; nx = cnt > 0u ? cnt : 1u;
}
__device__ __forceinline__ void xcd_barrier(const XcdBarrier& b) {
    asm volatile("s_waitcnt vmcnt(0)" ::: "memory");
    __syncthreads();
    if (threadIdx.x == 0) {
        unsigned* bar = b.bar;
        __builtin_amdgcn_s_waitcnt(0);
        unsigned nloc = b.st[0], nx = b.st[1];
        if (nloc == 0u) { xcd_barrier_complete(bar, b.x, nloc, nx); b.st[0] = nloc; b.st[1] = nx; }
        const unsigned old = xb_add(&bar[XB_XSUB(b.x)], 1u);
        const unsigned gen = old / nloc;
        if (old + 1u == (gen + 1u) * nloc) {
            __builtin_amdgcn_fence(__ATOMIC_RELEASE, "agent");
            asm volatile("s_waitcnt vmcnt(0)" ::: "memory");
            const unsigned og = xb_add(&bar[XB_TOP], 1u);
            const unsigned tg = og / nx;
            if (og + 1u == (tg + 1u) * nx) xb_add(&bar[XB_TOPGEN], 1u);
            else XB_SPIN(xb_ld(&bar[XB_TOPGEN]) == tg, bar);
            __builtin_amdgcn_fence(__ATOMIC_ACQUIRE, "agent");
            xb_add(&bar[XB_XGEN(b.x)], 1u);
            asm volatile("s_waitcnt vmcnt(0)" ::: "memory");
        } else {
            XB_SPIN(xb_ld(&bar[XB_XGEN(b.x)]) == gen, bar);
            __builtin_amdgcn_fence(__ATOMIC_ACQUIRE, "agent");
            asm volatile("s_waitcnt vmcnt(0)" ::: "memory");
        }
    }
    __syncthreads();
}

__global__ void __launch_bounds__(NT, 2) fwd_kernel(Params p) {
    extern __shared__ __attribute__((aligned(16))) unsigned char lds_raw[];
    float* lds = (float*)lds_raw;
    int tid = threadIdx.x, lane = tid & 63, wave = tid >> 6;
    const int G = gridDim.x, bid = blockIdx.x;
    int gw = bid * 8 + wave; const int NGW = G * 8;
#define FRESH() do { tid = threadIdx.x; asm volatile("" : "+v"(tid)); lane = tid & 63; wave = tid >> 6; gw = bid * 8 + wave; } while (0)
#define GRID_SYNC() do { \
        const __attribute__((address_space(4))) Params* Pb_ = (const __attribute__((address_space(4))) Params*)__builtin_amdgcn_kernarg_segment_ptr(); asm volatile("" : "+s"(Pb_)); \
        XcdBarrier xb_; xb_.bar = (unsigned*)(Pb_->ws + WS_BAR); xb_.x = xb_xcc_id(); xb_.st = (volatile XLAS unsigned*)((XLAS unsigned char*)lds_raw + LDS_BYTES - 64); xcd_barrier(xb_); } while (0)
#define SEAM() } GRID_SYNC(); FRESH(); { LOADP();

#define LOADP() \
    const __attribute__((address_space(4))) Params* P_ = (const __attribute__((address_space(4))) Params*)__builtin_amdgcn_kernarg_segment_ptr(); asm volatile("" : "+s"(P_)); \
    const float* x = P_->in[0]; const float* mix_g = P_->in[1]; const float* w_in = P_->in[2]; const float* conv_a_w = P_->in[3]; \
    const float* conv_a_g = P_->in[4]; const float* dn_conv_w = P_->in[5]; const float* dn_a_log = P_->in[6]; const float* dn_dt_bias = P_->in[7]; \
    const float* dn_norm_g = P_->in[8]; const float* w_out = P_->in[9]; const float* ffn_g = P_->in[10]; const float* r_group_w = P_->in[11]; \
    const float* r_exp_w = P_->in[12]; const float* w_gate = P_->in[13]; const float* w_up = P_->in[14]; const float* w_down = P_->in[15]; \
    const float* final_g = P_->in[16]; unsigned char* ws = P_->ws; float* outp = P_->out; \
    int* cnt = (int*)(ws + WS_CTL); float* rstd2 = (float*)(ws + WS_RSTD2); \
    int* tok_e = (int*)(ws + WS_TOKE); float* tok_g = (float*)(ws + WS_TOKG); int* tok_p = (int*)(ws + WS_TOKP); int* slot_tok = (int*)(ws + WS_SLOTTOK); \
    float* bg = (float*)(ws + WS_BG); bf16_t* win_t = (bf16_t*)(ws + WS_WIN); bf16_t* wout_t = (bf16_t*)(ws + WS_WOUT); \
    bf16_t* proj = (bf16_t*)(ws + WS_PROJ); bf16_t* hb = (bf16_t*)(ws + WS_HB); bf16_t* ymix = (bf16_t*)(ws + WS_YMIX); \
    bf16_t* act = (bf16_t*)(ws + WS_ACT); bf16_t* yexp = (bf16_t*)(ws + WS_YEXP); bf16_t* h2b = (bf16_t*)(ws + WS_H2B); \
    bf16_t* wgu_t = (bf16_t*)(ws + WS_WGU); bf16_t* wd_t = (bf16_t*)(ws + WS_WD); float* x1 = outp; \
    dn::DnBufs DB{(bf16_t*)outp, (bf16_t*)outp + (size_t)8 * 1024 * 1024, (bf16_t*)outp + (size_t)16 * 1024 * 1024, (bf16_t*)outp + (size_t)24 * 1024 * 1024, (bf16_t*)(ws + WS_AQK), (float*)(ws + WS_GL)}; \
    (void)x; (void)mix_g; (void)w_in; (void)conv_a_w; (void)conv_a_g; (void)dn_conv_w; (void)dn_a_log; (void)dn_dt_bias; (void)dn_norm_g; (void)w_out; (void)ffn_g; (void)r_group_w; (void)r_exp_w; \
    (void)w_gate; (void)w_up; (void)w_down; (void)final_g; (void)cnt; (void)rstd2; (void)tok_e; (void)tok_g; (void)tok_p; (void)slot_tok; (void)bg; (void)win_t; (void)wout_t; (void)proj; (void)hb; (void)ymix; \
    (void)act; (void)yexp; (void)h2b; (void)wgu_t; (void)wd_t; (void)x1; (void)DB
    {
        volatile XLAS unsigned* xst_ = (volatile XLAS unsigned*)((XLAS unsigned char*)lds_raw + LDS_BYTES - 64);
        if (tid == 0) { xst_[0] = 0u; xst_[1] = 0u; }
        __syncthreads();
        (void)xcd_barrier_post((unsigned*)(p.ws + WS_BAR), xst_);
    }
#define MIXA_ROWS(first_, stride_) do { typedef unsigned u32x4_t __attribute__((ext_vector_type(4))); const int c0 = lane * 8; \
        for (int r0_ = (first_); r0_ < NTOK; r0_ += 2 * (stride_)) { \
            u32x4_t ahv[2][3], acv[2][3], abv[2]; float mk[2][3]; int rr_[2]; \
            _Pragma("unroll") for (int t = 0; t < 2; ++t) { const int r = (r0_ + t * (stride_) < NTOK) ? r0_ + t * (stride_) : r0_; rr_[t] = r; const int sq = r % SEQ; const bf16_t* pr = proj + (size_t)r * NPB; \
                _Pragma("unroll") for (int j = 0; j < 3; ++j) { const bool ok = sq + j - 2 >= 0; const bf16_t* pj = pr + (ok ? (ptrdiff_t)(j - 2) * NPB : 0); mk[t][j] = ok ? 1.f : 0.f; \
                    ahv[t][j] = *(const u32x4_t*)(pj + C_AH + c0); acv[t][j] = *(const u32x4_t*)(pj + C_AC + c0); } \
                abv[t] = *(const u32x4_t*)(pr + C_AB + c0); } \
            _Pragma("unroll") for (int t = 0; t < 2; ++t) { if (t == 1 && r0_ + (stride_) >= NTOK) break; const int r = rr_[t]; \
                float conv[8]; _Pragma("unroll") for (int i = 0; i < 8; ++i) conv[i] = 0.f; \
                _Pragma("unroll") for (int j = 0; j < 3; ++j) { const u32x4_t ah = ahv[t][j], ac = acv[t][j]; const float m_ = mk[t][j]; \
                    float4 w0 = *(const float4*)(conv_a_w + j * 512 + c0), w1 = *(const float4*)(conv_a_w + j * 512 + c0 + 4); \
                    w0.x *= m_; w0.y *= m_; w0.z *= m_; w0.w *= m_; w1.x *= m_; w1.y *= m_; w1.z *= m_; w1.w *= m_; \
                    conv[0] += dn::lo_f(ah.x) * dn::lo_f(ac.x) * w0.x; conv[1] += dn::hi_f(ah.x) * dn::hi_f(ac.x) * w0.y; conv[2] += dn::lo_f(ah.y) * dn::lo_f(ac.y) * w0.z; conv[3] += dn::hi_f(ah.y) * dn::hi_f(ac.y) * w0.w; \
                    conv[4] += dn::lo_f(ah.z) * dn::lo_f(ac.z) * w1.x; conv[5] += dn::hi_f(ah.z) * dn::hi_f(ac.z) * w1.y; conv[6] += dn::lo_f(ah.w) * dn::lo_f(ac.w) * w1.z; conv[7] += dn::hi_f(ah.w) * dn::hi_f(ac.w) * w1.w; } \
                const u32x4_t ab = abv[t]; \
                float yv[8] = {dn::lo_f(ab.x) * conv[0], dn::hi_f(ab.x) * conv[1], dn::lo_f(ab.y) * conv[2], dn::hi_f(ab.y) * conv[3], dn::lo_f(ab.z) * conv[4], dn::hi_f(ab.z) * conv[5], dn::lo_f(ab.w) * conv[6], dn::hi_f(ab.w) * conv[7]}; \
                float ss = 0.f; _Pragma("unroll") for (int i = 0; i < 8; ++i) ss += yv[i] * yv[i]; \
                ss += __shfl_xor(ss, 1); ss += __shfl_xor(ss, 2); ss += __shfl_xor(ss, 4); \
                const float rs = rsqrtf(ss * (1.f / 64.f) + EPS); \
                const float4 g0 = *(const float4*)(conv_a_g + c0), g1 = *(const float4*)(conv_a_g + c0 + 4); \
                u32x4_t w; w.x = dn::pkbf(yv[0] * rs * g0.x, yv[1] * rs * g0.y); w.y = dn::pkbf(yv[2] * rs * g0.z, yv[3] * rs * g0.w); w.z = dn::pkbf(yv[4] * rs * g1.x, yv[5] * rs * g1.y); w.w = dn::pkbf(yv[6] * rs * g1.z, yv[7] * rs * g1.w); \
                *(u32x4_t*)(ymix + (size_t)r * DM + c0) = w; } } } while (0)
    int* Loff = (int*)(lds_raw + LDS_TAB);
    int* Ltile = Loff + 64;
    int* Lend = Loff + 128;
    int* LsmE = Loff + 192;
    {
    LOADP();
    REP(0) {
    {
        float* scr = lds + wave * (64 * 33);
        constexpr int I_IN = (DM / 64) * (NPB / 32), I_OUT = (DM / 64) * (DM / 32);
        constexpr int I_G = NE * 16 * 16, I_D = NE * 8 * 32;
        for (int it = gw; it < I_IN + I_OUT; it += NGW) {
            int r = it;
            if (r < I_IN) { const int kb = r / (NPB / 32), nb = r % (NPB / 32); transpose_item(w_in, NPROJ, kb * 64, nb * 32, win_t, DM, nb * 32, scr, lane); continue; } r -= I_IN;
            { const int kb = r / (DM / 32), nb = r % (DM / 32); transpose_item(w_out, DM, kb * 64, nb * 32, wout_t, DM, nb * 32, scr, lane); }
        }
        float wx[4][4][8];
#pragma unroll
        for (int j = 0; j < 4; ++j)
#pragma unroll
            for (int i = 0; i < 4; ++i) { const float* wr_ = w_in + (size_t)(4 * lane + 256 * j + i) * NPROJ + NPB; const float4 w0 = *(const float4*)wr_, w1 = *(const float4*)(wr_ + 4);
                wx[j][i][0] = w0.x; wx[j][i][1] = w0.y; wx[j][i][2] = w0.z; wx[j][i][3] = w0.w; wx[j][i][4] = w1.x; wx[j][i][5] = w1.y; wx[j][i][6] = w1.z; wx[j][i][7] = w1.w; }
        const int hsel = (lane >> 3) & 3; const bool is_alpha = lane >= 32;
        const float aneg = -expf(dn_a_log[hsel]), dtb = dn_dt_bias[hsel];
        float4 vnx[4];
        if (gw < NTOK) {
#pragma unroll
            for (int j = 0; j < 4; ++j) vnx[j] = ((const float4*)(x + (size_t)gw * DM) + lane)[64 * j]; }
        for (int r = gw; r < NTOK; r += NGW) {
            float4 v[4]; float s = 0.f;
#pragma unroll
            for (int j = 0; j < 4; ++j) { v[j] = vnx[j]; s += v[j].x * v[j].x + v[j].y * v[j].y + v[j].z * v[j].z + v[j].w * v[j].w; }
            if (r + NGW < NTOK) {
#pragma unroll
                for (int j = 0; j < 4; ++j) vnx[j] = ((const float4*)(x + (size_t)(r + NGW) * DM) + lane)[64 * j]; }
            const float rs = rsqrtf(wave_sum(s) * (1.f / DM) + EPS);
            float dots[8];
#pragma unroll
            for (int c = 0; c < 8; ++c) dots[c] = 0.f;
            unsigned long long* o8 = (unsigned long long*)(hb + (size_t)r * DM) + lane;
#pragma unroll
            for (int j = 0; j < 4; ++j) { const float4 g = ((const float4*)mix_g)[lane + 64 * j];
                v[j].x *= rs * g.x; v[j].y *= rs * g.y; v[j].z *= rs * g.z; v[j].w *= rs * g.w;
                o8[64 * j] = (unsigned long long)pk2(v[j].x, v[j].y) | ((unsigned long long)pk2(v[j].z, v[j].w) << 32);
                const float hv[4] = {v[j].x, v[j].y, v[j].z, v[j].w};
#pragma unroll
                for (int i = 0; i < 4; ++i)
#pragma unroll
                    for (int c = 0; c < 8; ++c) dots[c] += hv[i] * wx[j][i][c]; }
            const float tot = reduce8_tr(dots, lane);
            if ((lane & 7) == 0) bg[(size_t)r * 8 + (lane >> 3)] = is_alpha ? aneg * softplus_f(tot + dtb) : sigmoid_f(tot);
        }
    }
    }
    SEAM()
    REP(1) {
        pg8::Gemm g{hb, DM, nullptr}; pg8::DenseOrder S; S.init(NTOK, NPB, DM, win_t, G, bid);
        pg8::EpiBf16 E{proj, NPB};
        pg8::gemm_phase<pg8::EpiBf16, pg8::DenseOrder, false, true>((PG8_LAS unsigned char*)lds_raw, g, S, E);
    }
    SEAM()
    REP(3) dn::prep(lds_raw, tid, bid, G, proj, bg, dn_conv_w, DB, [&](int item, int w4, int lane_) {
        const __attribute__((address_space(4))) Params* Q_ = (const __attribute__((address_space(4))) Params*)__builtin_amdgcn_kernarg_segment_ptr(); asm volatile("" : "+s"(Q_));
        unsigned char* ws_ = Q_->ws;
        float* scr_ = (float*)(lds_raw + dn::P2_END + w4 * 4608);
        const int s0 = (w4 < 2) ? w4 : 2 * w4 - 2, ns = (w4 < 2) ? 1 : 2;
        for (int s_ = 0; s_ < ns; ++s_) conv_item(item * CV_PREP + s0 + s_, Q_->in[13], Q_->in[14], Q_->in[15], (bf16_t*)(ws_ + WS_WGU), (bf16_t*)(ws_ + WS_WD), scr_, lane_);
    });
    SEAM()
    REP(4) {
    constexpr int NSU = 2 * BATCH * NH;
    if (bid >= NSU || G <= NSU) {
        float* scr = lds + wave * (64 * 33);
        constexpr int I_G = NE * 16 * 16, I_D = NE * 8 * 32;
        const int nw = (G <= NSU) ? NGW : (G - NSU) * 8, w0 = (G <= NSU) ? gw : gw - NSU * 8;
        for (int it = CV_PREP * (BATCH * NH * (SEQ / 64)) + w0; it < 2 * I_G + I_D; it += nw) conv_item(it, w_gate, w_up, w_down, wgu_t, wd_t, scr, lane);
        if (G > NSU) MIXA_ROWS(w0, nw);
    }
    if (bid < NSU || G <= NSU) dn::scan(lds_raw, tid, bid, G, DB, ymix);
    }
    SEAM()
    {
        typedef unsigned u32x4_t __attribute__((ext_vector_type(4)));
        const int c0 = lane * 8;
        if (G <= 2 * BATCH * NH) MIXA_ROWS(gw, NGW);
        for (int r0_ = gw; r0_ < NTOK; r0_ += 4 * NGW) {
            u32x4_t ovv[4], zvv[4]; int rr_[4];
#pragma unroll
            for (int t = 0; t < 4; ++t) {
                const int r = (r0_ + t * NGW < NTOK) ? r0_ + t * NGW : r0_; rr_[t] = r;
                zvv[t] = *(const u32x4_t*)(proj + (size_t)r * NPB + C_Z + c0);
                const int oi_ = r & 63, oitem_ = ((r / SEQ) * NH + (c0 >> 7)) * (SEQ / 64) + ((r % SEQ) >> 6);
                ovv[t] = *(const u32x4_t*)(DB.UT + ((size_t)oitem_ * 128 + (c0 & 112)) * 64 + (((oi_ >> 4) * 4 + (oi_ & 3)) * 4 + ((oi_ >> 2) & 3)) * 16 + (c0 & 15));
            }
#pragma unroll
            for (int t = 0; t < 4; ++t) {
                if (t > 0 && r0_ + t * NGW >= NTOK) break;
                const int r = rr_[t];
                const u32x4_t ov = ovv[t], zv = zvv[t];
                float o[8] = {dn::lo_f(ov.x), dn::hi_f(ov.x), dn::lo_f(ov.y), dn::hi_f(ov.y), dn::lo_f(ov.z), dn::hi_f(ov.z), dn::lo_f(ov.w), dn::hi_f(ov.w)};
                const float z[8] = {dn::lo_f(zv.x), dn::hi_f(zv.x), dn::lo_f(zv.y), dn::hi_f(zv.y), dn::lo_f(zv.z), dn::hi_f(zv.z), dn::lo_f(zv.w), dn::hi_f(zv.w)};
                float ss = 0.f;
#pragma unroll
                for (int i = 0; i < 8; ++i) ss += o[i] * o[i];
                ss += __shfl_xor(ss, 1); ss += __shfl_xor(ss, 2); ss += __shfl_xor(ss, 4); ss += __shfl_xor(ss, 8);
                const float rs = rsqrtf(ss * (1.f / 128.f) + EPS);
                const float4 g0 = *(const float4*)(dn_norm_g + (c0 & 127)), g1 = *(const float4*)(dn_norm_g + (c0 & 127) + 4);
                const float gv[8] = {g0.x, g0.y, g0.z, g0.w, g1.x, g1.y, g1.z, g1.w};
#pragma unroll
                for (int i = 0; i < 8; ++i) o[i] = o[i] * rs * gv[i] * dn::silu_fast(z[i]);
                u32x4_t w; w.x = dn::pkbf(o[0], o[1]); w.y = dn::pkbf(o[2], o[3]); w.z = dn::pkbf(o[4], o[5]); w.w = dn::pkbf(o[6], o[7]);
                *(u32x4_t*)(ymix + (size_t)r * DM + 512 + c0) = w;
            }
        }
    }
    SEAM()
    REP(5) {
        pg8::Gemm g{ymix, DM, nullptr}; pg8::DenseOrder S; S.init(NTOK, DM, DM, wout_t, G, bid);
        pg8::EpiResid E{x, x1, DM};
        pg8::gemm_phase<pg8::EpiResid, pg8::DenseOrder, false, false>((PG8_LAS unsigned char*)lds_raw, g, S, E);
    }
    SEAM()
    {
        {
            const float4* src = (const float4*)r_exp_w; float4* dst = (float4*)lds_raw;
            for (int i = tid; i < DM * 8; i += NT) { const int k = i >> 3, sl = i & 7; dst[k * 8 + (sl ^ (k & 7))] = src[i]; }
        }
        float4 wg[16];
#pragma unroll
        for (int j = 0; j < 16; ++j) wg[j] = *(const float4*)(r_group_w + (size_t)(lane + 64 * j) * 4);
        float gf[16];
#pragma unroll
        for (int j = 0; j < 16; ++j) gf[j] = ffn_g[lane + 64 * j];
        int* lcnt = (int*)(lds_raw + LDS_TAB + 2048);
        if (tid < NE) lcnt[tid] = 0;
        __syncthreads();
        float hnx[16];
        if (gw < NTOK) {
#pragma unroll
            for (int j = 0; j < 16; ++j) hnx[j] = x1[(size_t)gw * DM + lane + 64 * j]; }
        for (int r = gw; r < NTOK; r += NGW) {
            float hv[16]; float s = 0.f;
#pragma unroll
            for (int j = 0; j < 16; ++j) { hv[j] = hnx[j]; s += hv[j] * hv[j]; }
            if (r + NGW < NTOK) {
#pragma unroll
                for (int j = 0; j < 16; ++j) hnx[j] = x1[(size_t)(r + NGW) * DM + lane + 64 * j]; }
            const float rs = rsqrtf(wave_sum(s) * (1.f / DM) + EPS);
            float gl4[4] = {0.f, 0.f, 0.f, 0.f};
#pragma unroll
            for (int j = 0; j < 16; ++j) { hv[j] *= rs * gf[j]; h2b[(size_t)r * DM + lane + 64 * j] = (bf16_t)f2bf(hv[j]);
                gl4[0] += hv[j] * wg[j].x; gl4[1] += hv[j] * wg[j].y; gl4[2] += hv[j] * wg[j].z; gl4[3] += hv[j] * wg[j].w; }
            const float gt = reduce4_tr(gl4, lane);
            const float gl[4] = {lane_bcast(gt, 0), lane_bcast(gt, 16), lane_bcast(gt, 32), lane_bcast(gt, 48)};
            int gi = 0; float gm = gl[0];
#pragma unroll
            for (int g = 1; g < 4; ++g) if (gl[g] > gm) { gm = gl[g]; gi = g; }
            float gs = 0.f;
#pragma unroll
            for (int g = 0; g < 4; ++g) gs += expf(gl[g] - gm);
            const float gprob = 1.f / gs;
            float ed[8] = {0.f, 0.f, 0.f, 0.f, 0.f, 0.f, 0.f, 0.f};
#pragma unroll
            for (int j = 0; j < 16; ++j) { const int k = lane + 64 * j; const float4* row = (const float4*)lds_raw + k * 8;
                const float4 w0 = row[(2 * gi) ^ (k & 7)], w1 = row[(2 * gi + 1) ^ (k & 7)];
                ed[0] += hv[j] * w0.x; ed[1] += hv[j] * w0.y; ed[2] += hv[j] * w0.z; ed[3] += hv[j] * w0.w; ed[4] += hv[j] * w1.x; ed[5] += hv[j] * w1.y; ed[6] += hv[j] * w1.z; ed[7] += hv[j] * w1.w; }
            const float et = reduce8_tr(ed, lane);
            float el[8];
#pragma unroll
            for (int e = 0; e < 8; ++e) el[e] = lane_bcast(et, 8 * e);
            int i1 = 0; float m1 = el[0];
#pragma unroll
            for (int e = 1; e < 8; ++e) if (el[e] > m1) { m1 = el[e]; i1 = e; }
            int i2 = -1; float m2 = -INFINITY;
#pragma unroll
            for (int e = 0; e < 8; ++e) if (e != i1 && el[e] > m2) { m2 = el[e]; i2 = e; }
            const float p2 = expf(m2 - m1), inv = 1.f / (1.f + p2);
            if (lane == 0) {
                const int e1 = gi * 8 + i1, e2 = gi * 8 + i2;
                tok_e[2 * r] = e1; tok_e[2 * r + 1] = e2;
                tok_g[2 * r] = gprob * inv; tok_g[2 * r + 1] = gprob * p2 * inv;
                tok_p[2 * r] = atomicAdd(&lcnt[e1], 1); tok_p[2 * r + 1] = atomicAdd(&lcnt[e2], 1);
            }
        }
        __syncthreads();
        if (tid < NE) ((int*)(ws + WS_CNTB))[bid * NE + tid] = lcnt[tid];
    }
    SEAM()
    {
        const int* cntb = (const int*)(ws + WS_CNTB);
        int* red = (int*)(lds_raw + LDS_TAB + 4096);
        int* Lbase = (int*)(lds_raw + LDS_TAB + 2048);
        { const int e = tid & 31, part = tid >> 5; int sall = 0, sbef = 0;
          for (int b_ = part; b_ < G; b_ += 16) { const int v = cntb[b_ * NE + e]; sall += v; sbef += (b_ < bid) ? v : 0; }
          red[part * 32 + e] = sall; red[512 + part * 32 + e] = sbef; }
        __syncthreads();
        if (tid < NE) { int a = 0, b_ = 0; for (int q = 0; q < 16; ++q) { a += red[q * 32 + tid]; b_ += red[512 + q * 32 + tid]; } red[1024 + tid] = a; Lbase[tid] = b_; }
        __syncthreads();
        if (tid == 0) { int o = 0, tl = 0, ns = 0;
            for (int e = 0; e < NE; ++e) { Loff[e] = o; Ltile[e] = tl; const int c = red[1024 + e], full = c >> 8, rem = c & 255;
                if (rem > 128 || rem == 0) { tl += full + (rem ? 1 : 0); Lend[e] = o + c; }
                else { tl += full; Lend[e] = o + 256 * full; LsmE[ns++] = e; }
                o += c; }
            Loff[NE] = o; Ltile[NE] = tl; LsmE[63] = ns; }
        __syncthreads();
        for (int q = tid; q < 16 * (NTOK / (8 * G) + 1); q += NT) {
            const int w = (q >> 1) & 7, k = q >> 4, r = bid * 8 + w + NGW * k, i = 2 * r + (q & 1);
            if (r < NTOK) { const int e = tok_e[i]; const int sl = Loff[e] + Lbase[e] + tok_p[i]; slot_tok[sl] = r; tok_p[i] = sl; }
        }
    }
    SEAM()
    REP(7) {
        pg8::Gemm g{h2b, DM, slot_tok};
        pg8::GroupedOrder S{Loff, Ltile, Lend, LsmE, Ltile[NE] * 4, (Ltile[NE] + LsmE[63]) * 4, G, bid, (const char*)wgu_t, (size_t)DM * DM * 2, (size_t)256 * DM * 2};
        pg8::EpiAct E{act};
        pg8::gemm_phase<pg8::EpiAct, pg8::GroupedOrder, true, true>((PG8_LAS unsigned char*)lds_raw, g, S, E);
    }
    SEAM()
    REP(8) {
        pg8::Gemm g{act, FF, nullptr};
        pg8::GroupedOrder S{Loff, Ltile, Lend, LsmE, Ltile[NE] * 4, (Ltile[NE] + LsmE[63]) * 4, G, bid, (const char*)wd_t, (size_t)DM * FF * 2, (size_t)256 * FF * 2};
        pg8::EpiBf16 E{yexp, DM};
        pg8::gemm_phase<pg8::EpiBf16, pg8::GroupedOrder, false, true>((PG8_LAS unsigned char*)lds_raw, g, S, E);
    }
    SEAM()
    {
        const int nmine = (NTOK - gw + NGW - 1) / NGW;
        const float4* fg = (const float4*)final_g + lane;
        float4 gfin[4];
#pragma unroll
        for (int j = 0; j < 4; ++j) gfin[j] = fg[64 * j];
        for (int k0 = 0; k0 < nmine; k0 += 16) {
            const int kk = k0 + (lane & 15), rr = gw + NGW * (kk < nmine ? kk : k0);
            const int2 sv = *(const int2*)(tok_p + 2 * rr); const float2 gv = *(const float2*)(tok_g + 2 * rr);
            for (int k = k0; k < nmine && k < k0 + 16; k += 4) {
                int rT[4]; bool has[4]; int s0[4], s1[4]; float g0[4], g1[4];
#pragma unroll
                for (int t = 0; t < 4; ++t) { has[t] = k + t < nmine; const int l_ = has[t] ? k + t - k0 : k - k0; rT[t] = gw + NGW * (has[t] ? k + t : k);
                    s0[t] = __shfl(sv.x, l_); s1[t] = __shfl(sv.y, l_); g0[t] = __shfl(gv.x, l_); g1[t] = __shfl(gv.y, l_); }
                float4 xv[4][4]; uint2 ya[4][4], yb[4][4];
#pragma unroll
                for (int t = 0; t < 4; ++t)
#pragma unroll
                    for (int j = 0; j < 4; ++j) { xv[t][j] = ((const float4*)(x1 + (size_t)rT[t] * DM) + lane)[64 * j]; ya[t][j] = ((const uint2*)(yexp + (size_t)s0[t] * DM) + lane)[64 * j]; yb[t][j] = ((const uint2*)(yexp + (size_t)s1[t] * DM) + lane)[64 * j]; }
                float ssum[4];
#pragma unroll
                for (int t = 0; t < 4; ++t) { float a_ = 0.f;
#pragma unroll
                    for (int j = 0; j < 4; ++j) {
                        xv[t][j] = make_float4(xv[t][j].x + g0[t] * dn::lo_f(ya[t][j].x) + g1[t] * dn::lo_f(yb[t][j].x), xv[t][j].y + g0[t] * dn::hi_f(ya[t][j].x) + g1[t] * dn::hi_f(yb[t][j].x),
                                               xv[t][j].z + g0[t] * dn::lo_f(ya[t][j].y) + g1[t] * dn::lo_f(yb[t][j].y), xv[t][j].w + g0[t] * dn::hi_f(ya[t][j].y) + g1[t] * dn::hi_f(yb[t][j].y));
                        a_ += xv[t][j].x * xv[t][j].x + xv[t][j].y * xv[t][j].y + xv[t][j].z * xv[t][j].z + xv[t][j].w * xv[t][j].w; }
                    ssum[t] = a_; }
#pragma unroll
                for (int o = 1; o < 64; o <<= 1) {
#pragma unroll
                    for (int t = 0; t < 4; ++t) ssum[t] += __shfl_xor(ssum[t], o); }
#pragma unroll
                for (int t = 0; t < 4; ++t) { if (has[t]) { const float rs = rsqrtf(ssum[t] * (1.f / DM) + EPS); float4* od = (float4*)(outp + (size_t)rT[t] * DM) + lane;
#pragma unroll
                    for (int j = 0; j < 4; ++j) od[64 * j] = make_float4(xv[t][j].x * rs * gfin[j].x, xv[t][j].y * rs * gfin[j].y, xv[t][j].z * rs * gfin[j].z, xv[t][j].w * rs * gfin[j].w); } }
            }
        }
    }
    }
}

extern "C" void kernel_launch(void* const* d_in, const int* in_sizes, int n_in, void* d_out, int out_size, void* d_ws, size_t ws_size, hipStream_t stream) {
    static int grid_blocks = 0;
    if (!grid_blocks) {
        int dev = 0, cus = 0, per_cu = 0;
        (void)hipGetDevice(&dev);
        (void)hipDeviceGetAttribute(&cus, hipDeviceAttributeMultiprocessorCount, dev);
        (void)hipFuncSetAttribute((const void*)fwd_kernel, hipFuncAttributeMaxDynamicSharedMemorySize, LDS_BYTES);
        (void)hipOccupancyMaxActiveBlocksPerMultiprocessor(&per_cu, (const void*)fwd_kernel, NT, LDS_BYTES);
        if (per_cu < 1) per_cu = 1;
        if (per_cu > 1 && 2 * LDS_BYTES > 160 * 1024) per_cu = 1;
        grid_blocks = cus * per_cu;
        fprintf(stderr, "kernel_launch: cus %d per_cu %d grid %d ws_size %zu\n", cus, per_cu, grid_blocks, ws_size);
    }
    (void)hipMemsetAsync((char*)d_ws + WS_CTL, 0, CTL_ZERO_BYTES, stream);
    Params p{};
    for (int i = 0; i < 17; ++i) p.in[i] = (const float*)d_in[i];
    p.out = (float*)d_out; p.ws = (unsigned char*)d_ws;
    hipLaunchKernelGGL(fwd_kernel, dim3(grid_blocks), dim3(NT), LDS_BYTES, stream, p);
    hipError_t e = hipPeekAtLastError();
    if (e != hipSuccess) fprintf(stderr, "launch failed: %s (grid %d)\n", hipGetErrorString(e), grid_blocks);
}
```

```cpp
#include <hip/hip_runtime.h>
#include <cstdio>
#include <cstdint>

constexpr int BATCH = 8, SEQ = 2048, DM = 1024, NTOK = BATCH * SEQ;
constexpr int NH = 4, HD = 128, NPROJ = 3592, NPB = 3584;
constexpr int C_AH = 0, C_AB = 512, C_AC = 1024, C_Q = 1536, C_K = 2048, C_V = 2560, C_Z = 3072;
constexpr int NE = 32, FF = 512;
constexpr float EPS = 1e-6f;
constexpr int NT = 512;
#ifndef REP_PHASE
#define REP_PHASE -1
#endif
#define REP(k) for (int rep_ = 0; rep_ < ((REP_PHASE == (k)) ? 2 : 1); ++rep_)
constexpr int LDS_BYTES = 144 * 1024;
constexpr int LDS_TAB = 131072;

typedef unsigned short bf16_t;
constexpr size_t MiB = 1u << 20;
constexpr size_t WS_CTL = 0;
constexpr size_t WS_BAR = 65536;
constexpr size_t CTL_ZERO_BYTES = 131072;
constexpr size_t WS_RSTD2 = 1 * MiB;
constexpr size_t WS_TOKE = WS_RSTD2 + 65536;
constexpr size_t WS_TOKG = WS_TOKE + 131072;
constexpr size_t WS_TOKP = WS_TOKG + 131072;
constexpr size_t WS_SLOTTOK = WS_TOKP + 131072;
constexpr size_t WS_GL = WS_SLOTTOK + 131072;
constexpr size_t WS_CNTB = WS_GL + 8192;
constexpr size_t WS_BG = 2 * MiB;
constexpr size_t WS_WIN = 3 * MiB;
constexpr size_t WS_WOUT = 10 * MiB;
constexpr size_t WS_WGU = 12 * MiB;
constexpr size_t WS_WD = 76 * MiB;
constexpr size_t WS_PROJ = 108 * MiB;
constexpr size_t WS_HB = 220 * MiB;
constexpr size_t WS_YMIX = 220 * MiB;
constexpr size_t WS_AQK = 252 * MiB;
constexpr size_t WS_H2B = 108 * MiB;
constexpr size_t WS_ACT = 140 * MiB;
constexpr size_t WS_YEXP = 173 * MiB;

struct Params { const float* in[17]; float* out; unsigned char* ws; };

__device__ __forceinline__ float wave_sum(float v) {
#pragma unroll
    for (int o = 1; o < 64; o <<= 1) v += __shfl_xor(v, o);
    return v;
}
__device__ __forceinline__ float silu_f(float x) { return x / (1.f + expf(-x)); }
__device__ __forceinline__ float sigmoid_f(float x) { return 1.f / (1.f + expf(-x)); }
__device__ __forceinline__ float softplus_f(float x) { return fmaxf(x, 0.f) + log1pf(expf(-fabsf(x))); }
__device__ __forceinline__ float bf2f(bf16_t h) { return __uint_as_float((unsigned)h << 16); }
__device__ __forceinline__ unsigned f2bf(float f) { unsigned u = __float_as_uint(f); return (u + 0x7fffu + ((u >> 16) & 1u)) >> 16; }
__device__ __forceinline__ unsigned pk2(float lo, float hi) { return f2bf(lo) | (f2bf(hi) << 16); }


__device__ __forceinline__ float reduce8_tr(const float (&v)[8], int lane) {
    float a[4], b[2];
#pragma unroll
    for (int i = 0; i < 4; ++i) { const bool hi = lane & 32; const float send = hi ? v[i] : v[i + 4], keep = hi ? v[i + 4] : v[i]; a[i] = keep + __shfl_xor(send, 32); }
#pragma unroll
    for (int i = 0; i < 2; ++i) { const bool hi = lane & 16; const float send = hi ? a[i] : a[i + 2], keep = hi ? a[i + 2] : a[i]; b[i] = keep + __shfl_xor(send, 16); }
    const bool hi = lane & 8; const float send = hi ? b[0] : b[1], keep = hi ? b[1] : b[0];
    float c = keep + __shfl_xor(send, 8);
    c += __shfl_xor(c, 4); c += __shfl_xor(c, 2); c += __shfl_xor(c, 1);
    return c;
}
__device__ __forceinline__ float reduce4_tr(const float (&v)[4], int lane) {
    float a[2];
#pragma unroll
    for (int i = 0; i < 2; ++i) { const bool hi = lane & 32; const float send = hi ? v[i] : v[i + 2], keep = hi ? v[i + 2] : v[i]; a[i] = keep + __shfl_xor(send, 32); }
    const bool hi = lane & 16; const float send = hi ? a[0] : a[1], keep = hi ? a[1] : a[0];
    float c = keep + __shfl_xor(send, 16);
    c += __shfl_xor(c, 8); c += __shfl_xor(c, 4); c += __shfl_xor(c, 2); c += __shfl_xor(c, 1);
    return c;
}
__device__ __forceinline__ float lane_bcast(float v, int src) { return __int_as_float(__builtin_amdgcn_readlane(__float_as_int(v), src)); }

namespace pg8 {
#define PG8_LAS __attribute__((address_space(3)))
typedef short bf16x8 __attribute__((ext_vector_type(8)));
typedef float f32x4 __attribute__((ext_vector_type(4)));
typedef unsigned u32x4 __attribute__((ext_vector_type(4)));
constexpr int BM = 256, BK = 64, HALF = 128, HTB = HALF * BK * 2, STAGE_BYTES = 8 * HTB, NXCD = 8, WGM = 8;

__host__ __device__ __forceinline__ int lds_byte(int r, int c) { const int st = (r >> 4) * 2 + (c >> 5), rr = r & 15, cc = c & 31, ob = rr * 64 + cc * 2; return st * 1024 + (ob ^ (((ob >> 9) & 1) << 5)); }
__host__ __device__ __forceinline__ void stage_rc(int b, int& R, int& C) { const int st = b / 1024, sb = b % 1024, swz = sb ^ (((sb >> 9) & 1) << 5); R = (st >> 1) * 16 + swz / 64; C = (st & 1) * 32 + (swz % 64) / 2; }
__host__ __device__ __forceinline__ int perm32(int rho) { const int n = rho >> 4, i = rho & 15; return 8 * (i >> 2) + 4 * n + (i & 3); }

struct Unit { int arow0, rowend, pn, half; const char* B; };
struct Gemm { const bf16_t* A; int K; const int* gidx; };

struct DenseOrder {
    int nM, nN, nwg, G, c, M, nfull, tail; const char* Bt; size_t tstep;
    __device__ void init(int M_, int N, int K, const bf16_t* Bt_, int G_, int c_) { M = M_; nM = M / BM; nN = N / BM; nwg = nM * nN; G = G_; c = c_; Bt = (const char*)Bt_; tstep = (size_t)BM * K * 2;
        nfull = (nwg / G) * G; tail = nwg - nfull; if (2 * tail > G) { nfull = nwg; tail = 0; } }
    __device__ bool next(int i, Unit& u) const {
        const long L = (long)i * G + c; int wgid, hs = -1;
        if (L < nfull) wgid = (int)L;
        else { const long hu = L - nfull; if (hu >= 2 * tail) return false; wgid = nfull + (int)(hu % tail); hs = (int)(hu / tail); }
        { const int q = nwg / NXCD, r = nwg % NXCD, xcd = wgid % NXCD, off = wgid / NXCD; wgid = (xcd < r ? xcd * (q + 1) : r * (q + 1) + (xcd - r) * q) + off; }
        const int nig = WGM * nN, gid = wgid / nig, fm = gid * WGM, gsz = (nM - fm) < WGM ? (nM - fm) : WGM;
        const int pm = fm + ((wgid % nig) % gsz); u.pn = (wgid % nig) / gsz; u.B = Bt + (size_t)u.pn * tstep;
        if (hs < 0) { u.arow0 = pm * BM; u.rowend = M; u.half = 0; } else { u.arow0 = pm * BM + HALF * hs; u.rowend = u.arow0 + HALF; u.half = 1; }
        return true;
    }
};

typedef __bf16 bf16x2_t __attribute__((ext_vector_type(2)));
typedef float f32x2_t __attribute__((ext_vector_type(2)));
__device__ __forceinline__ unsigned cvt_pk_bf16(float lo, float hi) { const f32x2_t v = {lo, hi}; return __builtin_bit_cast(unsigned, __builtin_convertvector(v, bf16x2_t)); }

struct EpiBf16 {
    static constexpr bool PERM = true;
    bf16_t* O; int ldc;
    __device__ __forceinline__ void operator()(const f32x4 (&acc)[2][2][4][2], const Unit& u, int wr, int wc, int fr, int fq) const {
        const int row0 = u.arow0 + wr * 64 + fr, col0 = u.pn * BM + wc * 32 + 8 * fq;
#pragma unroll
        for (int ai = 0; ai < 2; ++ai)
#pragma unroll
            for (int m = 0; m < 4; ++m) { const int row = row0 + ai * HALF + m * 16; bf16_t* rowp = O + (size_t)row * ldc + col0;
                if (row < u.rowend) {
#pragma unroll
                    for (int bj = 0; bj < 2; ++bj) { const f32x4 v0 = acc[ai][bj][m][0], v1 = acc[ai][bj][m][1];
                        u32x4 w; w.x = cvt_pk_bf16(v0[0], v0[1]); w.y = cvt_pk_bf16(v0[2], v0[3]); w.z = cvt_pk_bf16(v1[0], v1[1]); w.w = cvt_pk_bf16(v1[2], v1[3]);
                        *(u32x4*)(rowp + bj * HALF) = w; } } }
    }
};
struct EpiResid {
    static constexpr bool PERM = false;
    const float* base; float* C; int ldc;
    __device__ __forceinline__ void operator()(const f32x4 (&acc)[2][2][4][2], const Unit& u, int wr, int wc, int fr, int fq) const {
        const int row0 = u.arow0 + wr * 64 + fr, col0 = u.pn * BM + wc * 32 + 4 * fq;
#pragma unroll
        for (int ai = 0; ai < 2; ++ai) {
            f32x4 bv[4][2][2];
#pragma unroll
            for (int m = 0; m < 4; ++m) { const size_t off = (size_t)(row0 + ai * HALF + m * 16) * ldc + col0;
#pragma unroll
                for (int bj = 0; bj < 2; ++bj)
#pragma unroll
                    for (int n = 0; n < 2; ++n) bv[m][bj][n] = *(const f32x4*)(base + off + bj * HALF + n * 16); }
#pragma unroll
            for (int m = 0; m < 4; ++m) { const size_t off = (size_t)(row0 + ai * HALF + m * 16) * ldc + col0;
#pragma unroll
                for (int bj = 0; bj < 2; ++bj)
#pragma unroll
                    for (int n = 0; n < 2; ++n) *(f32x4*)(C + off + bj * HALF + n * 16) = bv[m][bj][n] + acc[ai][bj][m][n]; }
        }
    }
};
struct EpiAct {
    static constexpr bool PERM = true;
    bf16_t* O;
    __device__ __forceinline__ void operator()(const f32x4 (&acc)[2][2][4][2], const Unit& u, int wr, int wc, int fr, int fq) const {
        const int row0 = u.arow0 + wr * 64 + fr, col0 = u.pn * HALF + wc * 32 + 8 * fq;
#pragma unroll
        for (int ai = 0; ai < 2; ++ai)
#pragma unroll
            for (int m = 0; m < 4; ++m) { const int row = row0 + ai * HALF + m * 16;
                if (row < u.rowend) { float v[8];
#pragma unroll
                    for (int n = 0; n < 2; ++n)
#pragma unroll
                        for (int j = 0; j < 4; ++j) { const float gt = acc[ai][0][m][n][j], up = acc[ai][1][m][n][j]; v[n * 4 + j] = gt * __builtin_amdgcn_rcpf(1.f + __builtin_amdgcn_exp2f(-1.4426950408889634f * gt)) * up; }
                    u32x4 w; w.x = cvt_pk_bf16(v[0], v[1]); w.y = cvt_pk_bf16(v[2], v[3]); w.z = cvt_pk_bf16(v[4], v[5]); w.w = cvt_pk_bf16(v[6], v[7]);
                    *(u32x4*)(O + (size_t)row * 512 + col0) = w; } }
    }
};
struct GroupedOrder {
    const int* Loff; const int* Ttile; const int* Lend; const int* LsmE; int nfullu, nunits, G, c; const char* Bt; size_t estride, tstep;
    __device__ bool next(int i, Unit& u) const {
        const int L = (G == 256) ? ((i * 8 + (c & 7)) * 32 + (c >> 3)) : (i * G + c);
        if (L >= nunits) return false;
        u.pn = L & 3;
        if (L < nfullu) { const int tile = L >> 2; int e = 0; while (Ttile[e + 1] <= tile) ++e;
            u.arow0 = Loff[e] + (tile - Ttile[e]) * BM; u.rowend = Lend[e]; u.half = 0; u.B = Bt + (size_t)e * estride + (size_t)u.pn * tstep; }
        else { const int e = LsmE[(L - nfullu) >> 2]; u.arow0 = Lend[e]; u.rowend = Loff[e + 1]; u.half = 1; u.B = Bt + (size_t)e * estride + (size_t)u.pn * tstep; }
        return true;
    }
};

template <class Epi, class Sched, bool GATHER, bool ALIGN_EPI>
__device__ __forceinline__ void gemm_phase(PG8_LAS unsigned char* lds, const Gemm g, const Sched& S, const Epi& E) {
    const int tid = threadIdx.x, wid = __builtin_amdgcn_readfirstlane(tid >> 6), lane = tid & 63, wr = wid >> 2, wc = wid & 3, fr = lane & 15, fq = lane >> 4;
    const int K = g.K, nt = K / BK;
    int RA[2], CA[2]; unsigned voffB[2];
#pragma unroll
    for (int i = 0; i < 2; ++i) { int R, C; stage_rc(tid * 16 + i * 8192, R, C); const int Rb = Epi::PERM ? ((R & ~31) + perm32(R & 31)) : R;
        RA[i] = R; CA[i] = C; voffB[i] = (unsigned)(Rb * K + C) * 2u; }
    const size_t kstep = (size_t)(BK * 2);
    const size_t hstep = (size_t)HALF * K * 2;
    const unsigned ldsw = (unsigned)wid * 1024u;
    const int aoff = lds_byte(wr * 64 + fr, fq * 8), boff = lds_byte(wc * 32 + fr, fq * 8);
    const char* A0 = (const char*)g.A;
#define PG8_SA(b, h) (((b) * 2 + (h)) * HTB)
#define PG8_SB(b, h) ((4 + (b) * 2 + (h)) * HTB)
#define PG8_STAGE(bufoff, gbase, voff) do { _Pragma("unroll") for (int _i = 0; _i < 2; ++_i) \
        __builtin_amdgcn_global_load_lds((const unsigned*)((const char*)(gbase) + (voff)[_i]), (PG8_LAS unsigned*)(lds + (bufoff) + ldsw + _i * 8192), 16, 0, 0); } while (0)
#define PG8_LDA(dst, b, h) do { _Pragma("unroll") for (int m = 0; m < 4; ++m) _Pragma("unroll") for (int k = 0; k < 2; ++k) dst[m][k] = *(const PG8_LAS bf16x8*)(lds + PG8_SA(b, h) + aoff + m * 2048 + k * 1024); } while (0)
#define PG8_LDB(dst, b, h) do { _Pragma("unroll") for (int n = 0; n < 2; ++n) _Pragma("unroll") for (int k = 0; k < 2; ++k) dst[n][k] = *(const PG8_LAS bf16x8*)(lds + PG8_SB(b, h) + boff + n * 2048 + k * 1024); } while (0)
#define PG8_MMA(ai, bj, At, Bt) do { __builtin_amdgcn_s_setprio(1); _Pragma("unroll") for (int m = 0; m < 4; ++m) _Pragma("unroll") for (int n = 0; n < 2; ++n) _Pragma("unroll") for (int k = 0; k < 2; ++k) \
        acc[ai][bj][m][n] = __builtin_amdgcn_mfma_f32_16x16x32_bf16(Bt[n][k], At[m][k], acc[ai][bj][m][n], 0, 0, 0); __builtin_amdgcn_s_setprio(0); } while (0)
#define PG8_WAIT_V(n) asm volatile("s_waitcnt vmcnt(" #n ")" ::: "memory")
#define PG8_WAIT_L(n) asm volatile("s_waitcnt lgkmcnt(" #n ")" ::: "memory")
#define PG8_BAR __builtin_amdgcn_s_barrier()
#define PG8_SCHED __builtin_amdgcn_sched_barrier(0)
#define PG8_AOFF(dst, u) do { _Pragma("unroll") for (int _h = 0; _h < 2; ++_h) _Pragma("unroll") for (int _i = 0; _i < 2; ++_i) { int _r = (u).arow0 + _h * HALF + RA[_i]; _r = _r < (u).rowend ? _r : (u).rowend - 1; \
        if (GATHER) _r = g.gidx[_r]; dst[_h][_i] = (unsigned)(_r * K + CA[_i]) * 2u; } } while (0)
    Unit cur, nxt; int ui = 0;
    if (!S.next(0, cur)) return;
    f32x4 acc[2][2][4][2];
#pragma unroll
    for (int a = 0; a < 2; ++a)
#pragma unroll
        for (int b = 0; b < 2; ++b)
#pragma unroll
            for (int m = 0; m < 4; ++m)
#pragma unroll
                for (int n = 0; n < 2; ++n) acc[a][b][m][n] = (f32x4){0.f, 0.f, 0.f, 0.f};
    bf16x8 At[4][2], B0[2][2], B1[2][2];
    unsigned cvA[2][2], nvA[2][2];
    PG8_AOFF(cvA, cur);
    const char* cB = cur.B;
    PG8_STAGE(PG8_SB(0, 0), cB, voffB); PG8_STAGE(PG8_SB(0, 1), cB + hstep, voffB); PG8_STAGE(PG8_SA(0, 0), A0, cvA[0]); PG8_STAGE(PG8_SA(0, 1), A0, cvA[1]);
    if (wr == 1) PG8_BAR;
    PG8_WAIT_V(2); PG8_BAR;
    PG8_STAGE(PG8_SB(1, 0), cB + kstep, voffB); PG8_STAGE(PG8_SA(1, 0), A0 + kstep, cvA[0]); PG8_STAGE(PG8_SB(1, 1), cB + hstep + kstep, voffB);
    PG8_WAIT_V(6); PG8_BAR;
    for (;;) {
        const bool has_next = S.next(ui + 1, nxt);
        if (has_next) { PG8_AOFF(nvA, nxt); } else {
#pragma unroll
            for (int h = 0; h < 2; ++h)
#pragma unroll
                for (int i = 0; i < 2; ++i) nvA[h][i] = cvA[h][i]; }
        const char* nB = has_next ? nxt.B : cB;
        for (int t = 0; t < nt; t += 2) {
            const bool last = (t == nt - 2);
            const char* a1 = A0 + (size_t)(t + 1) * kstep;
            const char* a2 = last ? A0 : A0 + (size_t)(t + 2) * kstep; const char* b2 = last ? nB : cB + (size_t)(t + 2) * kstep;
            const char* a3 = a2 + kstep; const char* b3 = b2 + kstep;
            unsigned s2[2][2];
#pragma unroll
            for (int h = 0; h < 2; ++h)
#pragma unroll
                for (int i = 0; i < 2; ++i) s2[h][i] = last ? nvA[h][i] : cvA[h][i];
            PG8_LDB(B0, 0, 0); PG8_LDB(B1, 0, 1); PG8_SCHED; PG8_LDA(At, 0, 0); PG8_STAGE(PG8_SA(1, 1), a1, cvA[1]);
            PG8_WAIT_V(8); PG8_WAIT_L(0); PG8_BAR; PG8_MMA(0, 0, At, B0); PG8_MMA(0, 1, At, B1); PG8_BAR; PG8_SCHED;
            PG8_LDA(At, 0, 1); PG8_STAGE(PG8_SB(0, 0), b2, voffB); PG8_STAGE(PG8_SB(0, 1), b2 + hstep, voffB); PG8_STAGE(PG8_SA(0, 0), a2, s2[0]);
            PG8_WAIT_V(8); PG8_WAIT_L(0); PG8_BAR; if (!cur.half) { PG8_MMA(1, 0, At, B0); PG8_MMA(1, 1, At, B1); } PG8_BAR; PG8_SCHED;
            PG8_LDB(B0, 1, 0); PG8_LDB(B1, 1, 1); PG8_SCHED; PG8_LDA(At, 1, 0); PG8_STAGE(PG8_SA(0, 1), a2, s2[1]);
            PG8_WAIT_V(8); PG8_WAIT_L(0); PG8_BAR; PG8_MMA(0, 0, At, B0); PG8_MMA(0, 1, At, B1); PG8_BAR; PG8_SCHED;
            PG8_LDA(At, 1, 1); PG8_STAGE(PG8_SB(1, 0), b3, voffB); PG8_STAGE(PG8_SB(1, 1), b3 + hstep, voffB); PG8_STAGE(PG8_SA(1, 0), a3, s2[0]);
            PG8_WAIT_V(8); PG8_WAIT_L(0); PG8_BAR; if (!cur.half) { PG8_MMA(1, 0, At, B0); PG8_MMA(1, 1, At, B1); } PG8_BAR; PG8_SCHED;
        }
        if constexpr (ALIGN_EPI) { if (wr == 0) PG8_BAR; }
        E(acc, cur, wr, wc, fr, fq);
        if (!has_next) break;
#pragma unroll
        for (int a = 0; a < 2; ++a)
#pragma unroll
            for (int b = 0; b < 2; ++b)
#pragma unroll
                for (int m = 0; m < 4; ++m)
#pragma unroll
                    for (int n = 0; n < 2; ++n) acc[a][b][m][n] = (f32x4){0.f, 0.f, 0.f, 0.f};
        cur = nxt; cB = nB; ++ui;
#pragma unroll
        for (int h = 0; h < 2; ++h)
#pragma unroll
            for (int i = 0; i < 2; ++i) cvA[h][i] = nvA[h][i];
        if constexpr (ALIGN_EPI) { if (wr == 1) PG8_BAR; }
    }
    PG8_WAIT_V(0);
    if constexpr (!ALIGN_EPI) { if (wr == 0) PG8_BAR; }
    PG8_BAR;
#undef PG8_SA
#undef PG8_SB
#undef PG8_STAGE
#undef PG8_LDA
#undef PG8_LDB
#undef PG8_MMA
#undef PG8_WAIT_V
#undef PG8_WAIT_L
#undef PG8_BAR
#undef PG8_SCHED
#undef PG8_AOFF
}
}


namespace dn {
typedef short bf16x8 __attribute__((ext_vector_type(8)));
typedef float f32x4 __attribute__((ext_vector_type(4)));
typedef unsigned u32x4 __attribute__((ext_vector_type(4)));
typedef unsigned u32x2 __attribute__((ext_vector_type(2)));
__device__ __forceinline__ int perm_pos(int kl) { return 8 * ((kl >> 2) & 3) + 4 * (kl >> 4) + (kl & 3); }
__device__ __forceinline__ int perm_inv(int p) { return 16 * ((p >> 2) & 1) + 4 * (p >> 3) + (p & 3); }
typedef __bf16 bf16x2_t __attribute__((ext_vector_type(2)));
typedef float f32x2_t __attribute__((ext_vector_type(2)));
__device__ __forceinline__ unsigned pkbf(float lo, float hi) { const f32x2_t v = {lo, hi}; return __builtin_bit_cast(unsigned, __builtin_convertvector(v, bf16x2_t)); }
__device__ __forceinline__ float lo_f(unsigned u) { return __uint_as_float(u << 16); }
__device__ __forceinline__ float hi_f(unsigned u) { return __uint_as_float(u & 0xffff0000u); }
constexpr int P2_LT = 0, P2_G = 16384, P2_QB = 17408, P2_KB = P2_QB + 17408, P2_RU = P2_KB + 17408, P2_RW = P2_RU + 32768;
constexpr int ROWB = 272;

struct DnBufs { bf16_t* UT; bf16_t* WN; bf16_t* QD; bf16_t* KDT; bf16_t* AQK; float* GL; };

__device__ __forceinline__ float silu_fast(float a) { return a * __builtin_amdgcn_rcpf(1.f + __builtin_amdgcn_exp2f(-1.4426950408889634f * a)); }
constexpr int P2_END = P2_RW + 32768;
template <class Hook>
__device__ __forceinline__ void prep(unsigned char* lds, int tid, int bid, int G, const bf16_t* proj, const float* bg, const float* dn_conv_w, const DnBufs B, Hook hook) {
    const int lane = tid & 63, wave = tid >> 6;
    float* RU = (float*)(lds + P2_RU); float* RW = (float*)(lds + P2_RW); float* LT = (float*)(lds + P2_LT); float* GS = (float*)(lds + P2_G);
    const int nitems = BATCH * NH * (SEQ / 64);
    const int r0 = wave * 8;
    unsigned xin[11][3]; float gin, bin;
#define DN_PREP_LOAD(item_) do { const int bh_ = (item_) >> 5, c_ = (item_) & 31, b_ = bh_ >> 2, h_ = bh_ & 3, t0_ = c_ * 64; \
        _Pragma("unroll") for (int rr = 0; rr < 11; ++rr) { const int t = t0_ + r0 + rr - 3; \
            _Pragma("unroll") for (int wh = 0; wh < 3; ++wh) { const unsigned v_ = *(const unsigned*)(proj + ((size_t)b_ * SEQ + (t >= 0 ? t : 0)) * NPB + C_Q + wh * 512 + h_ * 128 + 2 * lane); xin[rr][wh] = (t >= 0) ? v_ : 0u; } } \
        gin = bg[((size_t)b_ * SEQ + t0_ + lane) * 8 + 4 + h_]; bin = bg[((size_t)b_ * SEQ + t0_ + lane) * 8 + h_]; } while (0)
    for (int item = bid; item < nitems; item += G) {
        const int bh = item >> 5, h = bh & 3;
        DN_PREP_LOAD(item);
        float cw[3][4][2];
#pragma unroll
        for (int wh = 0; wh < 3; ++wh)
#pragma unroll
            for (int j = 0; j < 4; ++j) { const float2 w2 = *(const float2*)(dn_conv_w + j * 1536 + wh * 512 + h * 128 + 2 * lane); cw[wh][j][0] = w2.x; cw[wh][j][1] = w2.y; }
        float Gc = gin;
#pragma unroll
        for (int o = 1; o < 64; o <<= 1) { const float t = __shfl_up(Gc, o); if (lane >= o) Gc += t; }
        const float glast = __shfl(Gc, 63), eGl = __expf(Gc), bel = bin;
        if (wave == 0) { GS[lane] = Gc; GS[64 + lane] = eGl; GS[128 + lane] = bel; GS[192 + lane] = __expf(glast - Gc); if (lane == 0) B.GL[item] = glast; }
#pragma unroll
        for (int rr = 0; rr < 8; ++rr) {
            const int i = r0 + rr;
            float val[3][2];
#pragma unroll
            for (int wh = 0; wh < 3; ++wh) { float a0 = 0.f, a1 = 0.f;
#pragma unroll
                for (int j = 0; j < 4; ++j) { a0 += lo_f(xin[rr + j][wh]) * cw[wh][j][0]; a1 += hi_f(xin[rr + j][wh]) * cw[wh][j][1]; }
                val[wh][0] = silu_fast(a0); val[wh][1] = silu_fast(a1); }
            float sq = val[0][0] * val[0][0] + val[0][1] * val[0][1], sk = val[1][0] * val[1][0] + val[1][1] * val[1][1];
#pragma unroll
            for (int o = 1; o < 64; o <<= 1) { sq += __shfl_xor(sq, o); sk += __shfl_xor(sk, o); }
            const float fq = rsqrtf(sq + EPS) * 0.08838834764831845f, fk = rsqrtf(sk + EPS);
            const float eG = __shfl(eGl, i), be = __shfl(bel, i);
            const float q0 = val[0][0] * fq, q1 = val[0][1] * fq, k0 = val[1][0] * fk, k1 = val[1][1] * fk;
            *(unsigned*)(lds + P2_QB + i * ROWB + 4 * lane) = pkbf(q0, q1);
            *(unsigned*)(lds + P2_KB + i * ROWB + 4 * lane) = pkbf(k0, k1);
            const int kl = (2 * lane) & 31, pos = ((2 * lane) & ~31) + perm_pos(kl);
            *(unsigned*)(B.QD + ((size_t)item * 64 + i) * 128 + pos) = pkbf(q0 * eG, q1 * eG);
            *(float2*)(RW + i * 128 + 2 * lane) = make_float2(be * eG * k0, be * eG * k1);
            *(float2*)(RU + i * 128 + 2 * lane) = make_float2(be * val[2][0], be * val[2][1]);
        }
        __syncthreads();
        {
            const int g = lane >> 4, cl = lane & 15, mi = wave >> 1, nj0 = 2 * (wave & 1);
            bf16x8 ka[4], qa[4];
#pragma unroll
            for (int s_ = 0; s_ < 4; ++s_) { ka[s_] = *(const bf16x8*)(lds + P2_KB + (16 * mi + cl) * ROWB + (32 * s_ + 8 * g) * 2); qa[s_] = *(const bf16x8*)(lds + P2_QB + (16 * mi + cl) * ROWB + (32 * s_ + 8 * g) * 2); }
#pragma unroll
            for (int nn = 0; nn < 2; ++nn) {
                const int nj = nj0 + nn;
                f32x4 akk = {0.f, 0.f, 0.f, 0.f}, aqk = {0.f, 0.f, 0.f, 0.f};
#pragma unroll
                for (int s_ = 0; s_ < 4; ++s_) { const bf16x8 kb = *(const bf16x8*)(lds + P2_KB + (16 * nj + cl) * ROWB + (32 * s_ + 8 * g) * 2);
                    akk = __builtin_amdgcn_mfma_f32_16x16x32_bf16(ka[s_], kb, akk, 0, 0, 0); aqk = __builtin_amdgcn_mfma_f32_16x16x32_bf16(qa[s_], kb, aqk, 0, 0, 0); }
                const int j = 16 * nj + cl; const float Gj = GS[j];
                float lt[4];
                const int jpos = (j & ~31) + perm_pos(j & 31);
#pragma unroll
                for (int x_ = 0; x_ < 4; ++x_) { const int i = 16 * mi + 4 * g + x_; const float dec = __expf(fminf(GS[i] - Gj, 0.f));
                    lt[x_] = (i > j) ? GS[128 + i] * akk[x_] * dec : 0.f;
                    const float a = (i >= j) ? aqk[x_] * dec : 0.f;
                    B.AQK[((size_t)item * 64 + i) * 64 + jpos] = (bf16_t)(pkbf(a, 0.f) & 0xffffu); }
                *(float4*)(LT + j * 64 + 16 * mi + 4 * g) = make_float4(lt[0], lt[1], lt[2], lt[3]);
            }
        }
        __syncthreads();
        if (tid < 256) {
            const float* src = (tid < 128) ? (RU + tid) : (RW + (tid - 128));
            typedef __attribute__((address_space(3))) float lds_f32;
            const lds_f32* LTp = (const lds_f32*)(LT); asm volatile("" : "+v"(LTp));
            float acc[64];
#pragma unroll
            for (int i = 0; i < 64; ++i) acc[i] = src[i * 128];
#pragma unroll
            for (int j = 0; j < 63; ++j) {
                const float xj = acc[j];
#pragma unroll
                for (int q = (j + 1) >> 2; q < 16; ++q) {
                    const f32x4 l4 = *(const __attribute__((address_space(3))) f32x4*)(LTp + j * 64 + 4 * q);
                    if (4 * q + 0 > j) acc[4 * q + 0] -= l4.x * xj;
                    if (4 * q + 1 > j) acc[4 * q + 1] -= l4.y * xj;
                    if (4 * q + 2 > j) acc[4 * q + 2] -= l4.z * xj;
                    if (4 * q + 3 > j) acc[4 * q + 3] -= l4.w * xj;
                }
            }
            if (tid < 128) {
                u32x4* dst = (u32x4*)(B.UT + ((size_t)item * 128 + tid) * 64);
#pragma unroll
                for (int q = 0; q < 8; ++q) { u32x4 w; w.x = pkbf(acc[8 * q], acc[8 * q + 1]); w.y = pkbf(acc[8 * q + 2], acc[8 * q + 3]); w.z = pkbf(acc[8 * q + 4], acc[8 * q + 5]); w.w = pkbf(acc[8 * q + 6], acc[8 * q + 7]); dst[q] = w; }
            } else {
                const int dk = tid - 128, pos = (dk & ~31) + perm_pos(dk & 31);
                bf16_t* dst = B.WN + (size_t)item * 64 * 128 + pos;
#pragma unroll
                for (int i = 0; i < 64; ++i) dst[i * 128] = (bf16_t)(pkbf(-acc[i], 0.f) & 0xffffu);
            }
        } else if (tid < 384) {
            const int dk = tid - 256;
            u32x4* dst = (u32x4*)(B.KDT + ((size_t)item * 128 + dk) * 64);
#pragma unroll
            for (int q = 0; q < 8; ++q) { float v[8];
#pragma unroll
                for (int e = 0; e < 8; ++e) { const int p_ = 8 * q + e, i = (p_ & ~31) + perm_inv(p_ & 31); v[e] = bf2f(*(const bf16_t*)(lds + P2_KB + i * ROWB + 2 * dk)) * GS[192 + i]; }
                u32x4 w; w.x = pkbf(v[0], v[1]); w.y = pkbf(v[2], v[3]); w.z = pkbf(v[4], v[5]); w.w = pkbf(v[6], v[7]); dst[q] = w; }
        }
        if (tid >= 256) hook(item, wave - 4, lane);
        __syncthreads();
    }
#undef DN_PREP_LOAD
}

constexpr int SROW = 288, SKROW = 160;
constexpr int SC_WN = 0, SC_QD = 64 * SROW, SC_KDT = 128 * SROW, SC_AQK = SC_KDT + 128 * SKROW, SC_BUF = SC_AQK + 64 * SKROW  , SC_OT = 2048;
__device__ __forceinline__ void scan(unsigned char* lds, int tid, int bid, int G, const DnBufs B, bf16_t* ymix, unsigned* flags) {
    const int lane = tid & 63, wave = __builtin_amdgcn_readfirstlane(tid >> 6), g = lane >> 4, cl = lane & 15;
#define DN_BAR() do { asm volatile("s_waitcnt lgkmcnt(0)" ::: "memory"); __builtin_amdgcn_s_barrier(); asm volatile("" ::: "memory"); } while (0)
    for (int unit = bid; unit < 2 * BATCH * NH; unit += G) {
        const int bh = unit >> 1;
        __syncthreads();
        if (wave < 4) {
            const int wdv = 4 * (unit & 1) + wave, dv = 16 * wdv + cl;
            f32x4 S[8]; bf16x8 Sb[4];
#pragma unroll
            for (int r = 0; r < 8; ++r) S[r] = (f32x4){0.f, 0.f, 0.f, 0.f};
#pragma unroll
            for (int s_ = 0; s_ < 4; ++s_) Sb[s_] = (bf16x8){0, 0, 0, 0, 0, 0, 0, 0};
            const float eglv = __expf(B.GL[bh * 32 + (lane & 31)]);
            u32x2 uA[4], uB[4];
            f32x4 vn[4];
#define DN_LOAD_U(upre, c_) do { const size_t it_ = (size_t)(bh * 32 + (c_)); \
            _Pragma("unroll") for (int m_ = 0; m_ < 4; ++m_) upre[m_] = *(const u32x2*)(B.UT + (it_ * 128 + dv) * 64 + 16 * m_ + 4 * g); } while (0)
#define DN_VN(upre) do { _Pragma("unroll") for (int m = 0; m < 4; ++m) vn[m] = (f32x4){lo_f(upre[m].x), hi_f(upre[m].x), lo_f(upre[m].y), hi_f(upre[m].y)}; } while (0)
#define DN_SB() __builtin_amdgcn_sched_barrier(0)
#define DN_LDW(f, off_, m0_) do { _Pragma("unroll") for (int m = 0; m < 2; ++m) _Pragma("unroll") for (int s_ = 0; s_ < 4; ++s_) f[m * 4 + s_] = *(const bf16x8*)(buf + (off_) + (16 * ((m0_) + m) + cl) * SROW + (32 * s_ + 8 * g) * 2); } while (0)
#define DN_LDK(f, off_, r0_) do { _Pragma("unroll") for (int r = 0; r < 4; ++r) _Pragma("unroll") for (int s_ = 0; s_ < 2; ++s_) f[r * 2 + s_] = *(const bf16x8*)(buf + (off_) + (16 * ((r0_) + r) + cl) * SKROW + (32 * s_ + 8 * g) * 2); } while (0)
#define DN_MMW(acc, m0_, f) do { _Pragma("unroll") for (int s_ = 0; s_ < 4; ++s_) _Pragma("unroll") for (int m = 0; m < 2; ++m) acc[(m0_) + m] = __builtin_amdgcn_mfma_f32_16x16x32_bf16(f[m * 4 + s_], Sb[s_], acc[(m0_) + m], 0, 0, 0); } while (0)
#define DN_MMK(acc, r0_, f) do { _Pragma("unroll") for (int s_ = 0; s_ < 2; ++s_) _Pragma("unroll") for (int r = 0; r < 4; ++r) acc[(r0_) + r] = __builtin_amdgcn_mfma_f32_16x16x32_bf16(f[r * 2 + s_], Vb[s_], acc[(r0_) + r], 0, 0, 0); } while (0)
#define DN_CHUNK(bufoff_, c_) do { \
            const unsigned char* buf = lds + (bufoff_); const int item = bh * 32 + (c_); \
            const float egl = __shfl(eglv, (c_)); \
            f32x4 o[4]; \
            _Pragma("unroll") for (int m = 0; m < 4; ++m) o[m] = (f32x4){0.f, 0.f, 0.f, 0.f}; \
            bf16x8 fA[8], fB[8]; \
            DN_LDW(fA, SC_WN, 0); DN_LDW(fB, SC_WN, 2); DN_SB(); \
            DN_MMW(vn, 0, fA); DN_SB(); DN_LDW(fA, SC_QD, 0); DN_SB(); \
            DN_MMW(vn, 2, fB); DN_SB(); DN_LDW(fB, SC_QD, 2); DN_SB(); \
            bf16x8 Vb[2]; \
            _Pragma("unroll") for (int s_ = 0; s_ < 2; ++s_) { u32x4 w; w.x = pkbf(vn[2 * s_][0], vn[2 * s_][1]); w.y = pkbf(vn[2 * s_][2], vn[2 * s_][3]); w.z = pkbf(vn[2 * s_ + 1][0], vn[2 * s_ + 1][1]); w.w = pkbf(vn[2 * s_ + 1][2], vn[2 * s_ + 1][3]); \
                Vb[s_] = __builtin_bit_cast(bf16x8, w); } \
            DN_MMW(o, 0, fA); DN_SB(); DN_LDK(fA, SC_KDT, 0); DN_SB(); \
            DN_MMW(o, 2, fB); DN_SB(); DN_LDK(fB, SC_KDT, 4); DN_SB(); \
            _Pragma("unroll") for (int r = 0; r < 8; ++r) S[r] = S[r] * egl; \
            DN_MMK(S, 0, fA); DN_SB(); DN_LDK(fA, SC_AQK, 0); DN_SB(); \
            DN_MMK(S, 4, fB); DN_SB(); \
            DN_MMK(o, 0, fA); DN_SB(); \
            _Pragma("unroll") for (int s_ = 0; s_ < 4; ++s_) { u32x4 w; w.x = pkbf(S[2 * s_][0], S[2 * s_][1]); w.y = pkbf(S[2 * s_][2], S[2 * s_][3]); w.z = pkbf(S[2 * s_ + 1][0], S[2 * s_ + 1][1]); w.w = pkbf(S[2 * s_ + 1][2], S[2 * s_ + 1][3]); \
                Sb[s_] = __builtin_bit_cast(bf16x8, w); } \
            { unsigned char* sc_ = lds + 2 * SC_BUF + wave * SC_OT; \
              _Pragma("unroll") for (int m = 0; m < 4; ++m) _Pragma("unroll") for (int x_ = 0; x_ < 4; ++x_) *(bf16_t*)(sc_ + (m * 4 + x_) * 128 + 2 * lane) = (bf16_t)(pkbf(o[m][x_], 0.f) & 0xffffu); \
              if ((c_) < 30) asm volatile("s_waitcnt vmcnt(11)" ::: "memory");     \
              else asm volatile("s_waitcnt vmcnt(3)" ::: "memory");                \
              if ((c_) > 1 && lane == 0) __hip_atomic_fetch_add(flagp + ((c_) - 2) * 32, 1u, __ATOMIC_RELAXED, __HIP_MEMORY_SCOPE_AGENT); \
              _Pragma("unroll") for (int q_ = 0; q_ < 2; ++q_) { \
                  const u32x4 w_ = *(const u32x4*)(sc_ + q_ * 1024 + lane * 16); \
                  const bf16_t* p_ = B.UT + ((size_t)item * 128 + 16 * wdv) * 64 + q_ * 512 + lane * 8; \
                  asm volatile("global_store_dwordx4 %0, %1, off sc1" :: "v"(p_), "v"(w_) : "memory"); } } \
        } while (0)
            unsigned* flagp = flags + (size_t)(bh >> 2) * 32 * 32;
            DN_LOAD_U(uA, 0); DN_LOAD_U(uB, 1);
            DN_BAR();
            for (int c = 0; c < SEQ / 64; c += 2) {
                DN_VN(uA); if (c + 2 < SEQ / 64) DN_LOAD_U(uA, c + 2);
                DN_CHUNK(0, c);
                DN_BAR();
                DN_VN(uB); if (c + 3 < SEQ / 64) DN_LOAD_U(uB, c + 3);
                DN_CHUNK(SC_BUF, c + 1);
                DN_BAR();
            }
            asm volatile("s_waitcnt vmcnt(0)" ::: "memory");
            if (lane == 0) { __hip_atomic_fetch_add(flagp + (SEQ / 64 - 2) * 32, 1u, __ATOMIC_RELAXED, __HIP_MEMORY_SCOPE_AGENT); __hip_atomic_fetch_add(flagp + (SEQ / 64 - 1) * 32, 1u, __ATOMIC_RELAXED, __HIP_MEMORY_SCOPE_AGENT); }
#undef DN_LOAD_U
#undef DN_VN
#undef DN_SB
#undef DN_LDW
#undef DN_LDK
#undef DN_MMW
#undef DN_MMK
#undef DN_CHUNK
        } else {
            const int lt = tid - 256;
            const int o_w = (lt >> 4) * SROW + (lt & 15) * 16, o_k = (lt >> 3) * SKROW + (lt & 7) * 16;
            u32x4 p0[14], p1[14], p2[14];
#define DN_LOADP(pre, c_) do { const size_t it_ = (size_t)(bh * 32 + (c_)); \
            _Pragma("unroll") for (int q = 0; q < 4; ++q) { pre[q] = *(const u32x4*)(B.WN + it_ * 8192 + (size_t)(lt + 256 * q) * 8); pre[4 + q] = *(const u32x4*)(B.QD + it_ * 8192 + (size_t)(lt + 256 * q) * 8); \
                pre[8 + q] = *(const u32x4*)(B.KDT + it_ * 8192 + (size_t)(lt + 256 * q) * 8); } \
            _Pragma("unroll") for (int q = 0; q < 2; ++q) pre[12 + q] = *(const u32x4*)(B.AQK + it_ * 4096 + (size_t)(lt + 256 * q) * 8); } while (0)
#define DN_WRITEP(pre, bufoff_) do { unsigned char* d_ = lds + (bufoff_); \
            _Pragma("unroll") for (int q = 0; q < 4; ++q) { *(u32x4*)(d_ + SC_WN + o_w + q * 16 * SROW) = pre[q]; *(u32x4*)(d_ + SC_QD + o_w + q * 16 * SROW) = pre[4 + q]; *(u32x4*)(d_ + SC_KDT + o_k + q * 32 * SKROW) = pre[8 + q]; } \
            _Pragma("unroll") for (int q = 0; q < 2; ++q) *(u32x4*)(d_ + SC_AQK + o_k + q * 32 * SKROW) = pre[12 + q]; } while (0)
            DN_LOADP(p0, 0); DN_LOADP(p1, 1); DN_LOADP(p2, 2);
            DN_WRITEP(p0, 0);
            DN_BAR();
            DN_LOADP(p0, 3);
#define DN_STEP(j_, set_, bufoff_) do { const int cc_ = c + (j_); if (cc_ < SEQ / 64) { if (cc_ + 1 < SEQ / 64) DN_WRITEP(set_, bufoff_); DN_BAR(); if (cc_ + 4 < SEQ / 64) DN_LOADP(set_, cc_ + 4); } } while (0)
            for (int c = 0; c < SEQ / 64; c += 6) {
                DN_STEP(0, p1, SC_BUF); DN_STEP(1, p2, 0); DN_STEP(2, p0, SC_BUF); DN_STEP(3, p1, 0); DN_STEP(4, p2, SC_BUF); DN_STEP(5, p0, 0);
            }
#undef DN_STEP
#undef DN_LOADP
#undef DN_WRITEP
        }
        __syncthreads();
    }
#undef DN_BAR
}
}

__device__ __forceinline__ void transpose_item(const float* W, int ldw, int k0, int n0, bf16_t* WT, int ldk, int dst_row0, float* scr_f, int lane) {
    unsigned* scr = (unsigned*)scr_f;
    const int c4 = (lane & 7) * 4, rq = lane >> 3;
    float4 lo[4], hi[4];
#pragma unroll
    for (int i = 0; i < 4; ++i) { const float* src = W + (size_t)(k0 + 2 * (rq + 8 * i)) * ldw + n0 + c4; lo[i] = *(const float4*)src; hi[i] = *(const float4*)(src + ldw); }
#pragma unroll
    for (int i = 0; i < 4; ++i) { const int kp = rq + 8 * i; unsigned* d = scr + c4 * 36 + kp;
        d[0] = dn::pkbf(lo[i].x, hi[i].x); d[36] = dn::pkbf(lo[i].y, hi[i].y); d[72] = dn::pkbf(lo[i].z, hi[i].z); d[108] = dn::pkbf(lo[i].w, hi[i].w); }
    asm volatile("s_waitcnt lgkmcnt(0)" ::: "memory");
#pragma unroll
    for (int j = 0; j < 4; ++j) { const int n = rq + 8 * j; const uint4 o = *(const uint4*)(scr + n * 36 + 4 * (lane & 7));
        *(uint4*)(WT + (size_t)(dst_row0 + n) * ldk + k0 + 8 * (lane & 7)) = o; }
    asm volatile("s_waitcnt lgkmcnt(0)" ::: "memory");
}

constexpr int CV_IG = NE * 16 * 16, CV_ID = NE * 8 * 32, CV_PREP = 10;
__device__ __forceinline__ void conv_item(int r, const float* w_gate, const float* w_up, const float* w_down, bf16_t* wgu_t, bf16_t* wd_t, float* scr, int lane) {
    if (r < 2 * CV_IG) { const int up = r >= CV_IG; if (up) r -= CV_IG; const int e = r >> 8, kb = (r >> 4) & 15, nb = r & 15, n0 = nb * 32;
        transpose_item((up ? w_up : w_gate) + (size_t)e * DM * FF, FF, kb * 64, n0, wgu_t + (size_t)e * DM * DM, DM, (n0 >> 7) * 256 + (n0 & 127) + (up ? 128 : 0), scr, lane); return; }
    r -= 2 * CV_IG;
    { const int e = r >> 8, kb = (r >> 5) & 7, nb = r & 31; transpose_item(w_down + (size_t)e * FF * DM, DM, kb * 64, nb * 32, wd_t + (size_t)e * DM * FF, FF, nb * 32, scr, lane); }
}

#define XB_TMO      128
#define XB_XCNT(j)  (256  + 64 * (j))
#define XB_XSUB(j)  (1280 + 64 * (j))
#define XB_XGEN(j)  (2304 + 64 * (j))
#define XB_TOP      3328
#define XB_TOPGEN   3392
#define XCD_BAR_WORDS 3456
#define XB_SPIN_CAP (1u << 18)
#define XLAS __attribute__((address_space(3)))
__device__ __forceinline__ unsigned xb_ld(unsigned* p)              { return __hip_atomic_load(p, __ATOMIC_RELAXED, __HIP_MEMORY_SCOPE_AGENT); }
__device__ __forceinline__ unsigned xb_add(unsigned* p, unsigned v) { return __hip_atomic_fetch_add(p, v, __ATOMIC_RELAXED, __HIP_MEMORY_SCOPE_AGENT); }
__device__ __forceinline__ unsigned xb_xcc_id() { return (unsigned)__builtin_amdgcn_s_getreg((3 << 11) | 20) & 0xFu; }
#define XB_SPIN(cond, bar) do { unsigned _sp = 0; while (cond) { if (_sp < 32u) __builtin_amdgcn_s_sleep(1); else __builtin_amdgcn_s_sleep(24); \
    if ((++_sp & 255u) == 0u) { if (xb_ld(&(bar)[XB_TMO])) break; if (_sp > XB_SPIN_CAP) { atomicAdd(&(bar)[XB_TMO], 1u); break; } } } } while (0)
struct XcdBarrier { unsigned* bar; unsigned x; volatile XLAS unsigned* st; };
__device__ __forceinline__ XcdBarrier xcd_barrier_post(unsigned* bar, volatile XLAS unsigned* st) {
    XcdBarrier b; b.bar = bar; b.x = xb_xcc_id(); b.st = st;
    if (threadIdx.x == 0) (void)xb_add(&bar[XB_XCNT(b.x)], 1u);
    return b;
}
__device__ __forceinline__ void xcd_barrier_complete(unsigned* bar, unsigned x, unsigned& nloc, unsigned& nx) {
    const unsigned G = gridDim.x * gridDim.y * gridDim.z;
    unsigned sum, cnt, mine, sp = 0u;
    for (;;) {
        sum = 0u; cnt = 0u; mine = 0u;
#pragma unroll
        for (unsigned j = 0; j < 16; ++j) { const unsigned c = xb_ld(&bar[XB_XCNT(j)]); sum += c; cnt += (c > 0u) ? 1u : 0u; mine = (j == x) ? c : mine; }
        if (sum == G) break;
        __builtin_amdgcn_s_sleep(1);
        if ((++sp & 255u) == 0u) { if (xb_ld(&bar[XB_TMO])) break; if (sp > XB_SPIN_CAP) { atomicAdd(&bar[XB_TMO], 1u); break; } }
    }
    nloc = mine > 0u ? mine : 1u; nx = cnt > 0u ? cnt : 1u;
}
__device__ __forceinline__ void xcd_barrier(const XcdBarrier& b) {
    asm volatile("s_waitcnt vmcnt(0)" ::: "memory");
    __syncthreads();
    if (threadIdx.x == 0) {
        unsigned* bar = b.bar;
        __builtin_amdgcn_s_waitcnt(0);
        unsigned nloc = b.st[0], nx = b.st[1];
        if (nloc == 0u) { xcd_barrier_complete(bar, b.x, nloc, nx); b.st[0] = nloc; b.st[1] = nx; }
        const unsigned old = xb_add(&bar[XB_XSUB(b.x)], 1u);
        const unsigned gen = old / nloc;
        if (old + 1u == (gen + 1u) * nloc) {
            __builtin_amdgcn_fence(__ATOMIC_RELEASE, "agent");
            asm volatile("s_waitcnt vmcnt(0)" ::: "memory");
            const unsigned og = xb_add(&bar[XB_TOP], 1u);
            const unsigned tg = og / nx;
            if (og + 1u == (tg + 1u) * nx) xb_add(&bar[XB_TOPGEN], 1u);
            else XB_SPIN(xb_ld(&bar[XB_TOPGEN]) == tg, bar);
            __builtin_amdgcn_fence(__ATOMIC_ACQUIRE, "agent");
            xb_add(&bar[XB_XGEN(b.x)], 1u);
            asm volatile("s_waitcnt vmcnt(0)" ::: "memory");
        } else {
            XB_SPIN(xb_ld(&bar[XB_XGEN(b.x)]) == gen, bar);
            __builtin_amdgcn_fence(__ATOMIC_ACQUIRE, "agent");
            asm volatile("s_waitcnt vmcnt(0)" ::: "memory");
        }
    }
    __syncthreads();
}

__global__ void __launch_bounds__(NT, 2) fwd_kernel(Params p) {
    extern __shared__ __attribute__((aligned(16))) unsigned char lds_raw[];
    float* lds = (float*)lds_raw;
    int tid = threadIdx.x, lane = tid & 63, wave = tid >> 6;
    const int G = gridDim.x, bid = blockIdx.x;
    int gw = bid * 8 + wave; const int NGW = G * 8;
#define FRESH() do { tid = threadIdx.x; asm volatile("" : "+v"(tid)); lane = tid & 63; wave = tid >> 6; gw = bid * 8 + wave; } while (0)
#define GRID_SYNC() do { \
        const __attribute__((address_space(4))) Params* Pb_ = (const __attribute__((address_space(4))) Params*)__builtin_amdgcn_kernarg_segment_ptr(); asm volatile("" : "+s"(Pb_)); \
        XcdBarrier xb_; xb_.bar = (unsigned*)(Pb_->ws + WS_BAR); xb_.x = xb_xcc_id(); xb_.st = (volatile XLAS unsigned*)((XLAS unsigned char*)lds_raw + LDS_BYTES - 64); xcd_barrier(xb_); } while (0)
#define SEAM() } GRID_SYNC(); FRESH(); { LOADP();

#define LOADP() \
    const __attribute__((address_space(4))) Params* P_ = (const __attribute__((address_space(4))) Params*)__builtin_amdgcn_kernarg_segment_ptr(); asm volatile("" : "+s"(P_)); \
    const float* x = P_->in[0]; const float* mix_g = P_->in[1]; const float* w_in = P_->in[2]; const float* conv_a_w = P_->in[3]; \
    const float* conv_a_g = P_->in[4]; const float* dn_conv_w = P_->in[5]; const float* dn_a_log = P_->in[6]; const float* dn_dt_bias = P_->in[7]; \
    const float* dn_norm_g = P_->in[8]; const float* w_out = P_->in[9]; const float* ffn_g = P_->in[10]; const float* r_group_w = P_->in[11]; \
    const float* r_exp_w = P_->in[12]; const float* w_gate = P_->in[13]; const float* w_up = P_->in[14]; const float* w_down = P_->in[15]; \
    const float* final_g = P_->in[16]; unsigned char* ws = P_->ws; float* outp = P_->out; \
    int* cnt = (int*)(ws + WS_CTL); float* rstd2 = (float*)(ws + WS_RSTD2); \
    int* tok_e = (int*)(ws + WS_TOKE); float* tok_g = (float*)(ws + WS_TOKG); int* tok_p = (int*)(ws + WS_TOKP); int* slot_tok = (int*)(ws + WS_SLOTTOK); \
    float* bg = (float*)(ws + WS_BG); bf16_t* win_t = (bf16_t*)(ws + WS_WIN); bf16_t* wout_t = (bf16_t*)(ws + WS_WOUT); \
    bf16_t* proj = (bf16_t*)(ws + WS_PROJ); bf16_t* hb = (bf16_t*)(ws + WS_HB); bf16_t* ymix = (bf16_t*)(ws + WS_YMIX); \
    bf16_t* act = (bf16_t*)(ws + WS_ACT); bf16_t* yexp = (bf16_t*)(ws + WS_YEXP); bf16_t* h2b = (bf16_t*)(ws + WS_H2B); \
    bf16_t* wgu_t = (bf16_t*)(ws + WS_WGU); bf16_t* wd_t = (bf16_t*)(ws + WS_WD); float* x1 = outp; \
    dn::DnBufs DB{(bf16_t*)outp, (bf16_t*)outp + (size_t)8 * 1024 * 1024, (bf16_t*)outp + (size_t)16 * 1024 * 1024, (bf16_t*)outp + (size_t)24 * 1024 * 1024, (bf16_t*)(ws + WS_AQK), (float*)(ws + WS_GL)}; \
    (void)x; (void)mix_g; (void)w_in; (void)conv_a_w; (void)conv_a_g; (void)dn_conv_w; (void)dn_a_log; (void)dn_dt_bias; (void)dn_norm_g; (void)w_out; (void)ffn_g; (void)r_group_w; (void)r_exp_w; \
    (void)w_gate; (void)w_up; (void)w_down; (void)final_g; (void)cnt; (void)rstd2; (void)tok_e; (void)tok_g; (void)tok_p; (void)slot_tok; (void)bg; (void)win_t; (void)wout_t; (void)proj; (void)hb; (void)ymix; \
    (void)act; (void)yexp; (void)h2b; (void)wgu_t; (void)wd_t; (void)x1; (void)DB
    {
        volatile XLAS unsigned* xst_ = (volatile XLAS unsigned*)((XLAS unsigned char*)lds_raw + LDS_BYTES - 64);
        if (tid == 0) { xst_[0] = 0u; xst_[1] = 0u; }
        __syncthreads();
        (void)xcd_barrier_post((unsigned*)(p.ws + WS_BAR), xst_);
    }
#define MIXA_ROWS(first_, stride_) do { typedef unsigned u32x4_t __attribute__((ext_vector_type(4))); const int c0 = lane * 8; \
        for (int r0_ = (first_); r0_ < NTOK; r0_ += 2 * (stride_)) { \
            u32x4_t ahv[2][3], acv[2][3], abv[2]; float mk[2][3]; int rr_[2]; \
            _Pragma("unroll") for (int t = 0; t < 2; ++t) { const int r = (r0_ + t * (stride_) < NTOK) ? r0_ + t * (stride_) : r0_; rr_[t] = r; const int sq = r % SEQ; const bf16_t* pr = proj + (size_t)r * NPB; \
                _Pragma("unroll") for (int j = 0; j < 3; ++j) { const bool ok = sq + j - 2 >= 0; const bf16_t* pj = pr + (ok ? (ptrdiff_t)(j - 2) * NPB : 0); mk[t][j] = ok ? 1.f : 0.f; \
                    ahv[t][j] = *(const u32x4_t*)(pj + C_AH + c0); acv[t][j] = *(const u32x4_t*)(pj + C_AC + c0); } \
                abv[t] = *(const u32x4_t*)(pr + C_AB + c0); } \
            _Pragma("unroll") for (int t = 0; t < 2; ++t) { if (t == 1 && r0_ + (stride_) >= NTOK) break; const int r = rr_[t]; \
                float conv[8]; _Pragma("unroll") for (int i = 0; i < 8; ++i) conv[i] = 0.f; \
                _Pragma("unroll") for (int j = 0; j < 3; ++j) { const u32x4_t ah = ahv[t][j], ac = acv[t][j]; const float m_ = mk[t][j]; \
                    float4 w0 = *(const float4*)(conv_a_w + j * 512 + c0), w1 = *(const float4*)(conv_a_w + j * 512 + c0 + 4); \
                    w0.x *= m_; w0.y *= m_; w0.z *= m_; w0.w *= m_; w1.x *= m_; w1.y *= m_; w1.z *= m_; w1.w *= m_; \
                    conv[0] += dn::lo_f(ah.x) * dn::lo_f(ac.x) * w0.x; conv[1] += dn::hi_f(ah.x) * dn::hi_f(ac.x) * w0.y; conv[2] += dn::lo_f(ah.y) * dn::lo_f(ac.y) * w0.z; conv[3] += dn::hi_f(ah.y) * dn::hi_f(ac.y) * w0.w; \
                    conv[4] += dn::lo_f(ah.z) * dn::lo_f(ac.z) * w1.x; conv[5] += dn::hi_f(ah.z) * dn::hi_f(ac.z) * w1.y; conv[6] += dn::lo_f(ah.w) * dn::lo_f(ac.w) * w1.z; conv[7] += dn::hi_f(ah.w) * dn::hi_f(ac.w) * w1.w; } \
                const u32x4_t ab = abv[t]; \
                float yv[8] = {dn::lo_f(ab.x) * conv[0], dn::hi_f(ab.x) * conv[1], dn::lo_f(ab.y) * conv[2], dn::hi_f(ab.y) * conv[3], dn::lo_f(ab.z) * conv[4], dn::hi_f(ab.z) * conv[5], dn::lo_f(ab.w) * conv[6], dn::hi_f(ab.w) * conv[7]}; \
                float ss = 0.f; _Pragma("unroll") for (int i = 0; i < 8; ++i) ss += yv[i] * yv[i]; \
                ss += __shfl_xor(ss, 1); ss += __shfl_xor(ss, 2); ss += __shfl_xor(ss, 4); \
                const float rs = rsqrtf(ss * (1.f / 64.f) + EPS); \
                const float4 g0 = *(const float4*)(conv_a_g + c0), g1 = *(const float4*)(conv_a_g + c0 + 4); \
                u32x4_t w; w.x = dn::pkbf(yv[0] * rs * g0.x, yv[1] * rs * g0.y); w.y = dn::pkbf(yv[2] * rs * g0.z, yv[3] * rs * g0.w); w.z = dn::pkbf(yv[4] * rs * g1.x, yv[5] * rs * g1.y); w.w = dn::pkbf(yv[6] * rs * g1.z, yv[7] * rs * g1.w); \
                *(u32x4_t*)(ymix + (size_t)r * DM + c0) = w; } } } while (0)
    int* Loff = (int*)(lds_raw + LDS_TAB);
    int* Ltile = Loff + 64;
    int* Lend = Loff + 128;
    int* LsmE = Loff + 192;
    {
    LOADP();
    REP(0) {
    {
        float* scr = lds + wave * (64 * 33);
        constexpr int I_IN = (DM / 64) * (NPB / 32), I_OUT = (DM / 64) * (DM / 32);
        constexpr int I_G = NE * 16 * 16, I_D = NE * 8 * 32;
        for (int it = gw; it < I_IN + I_OUT; it += NGW) {
            int r = it;
            if (r < I_IN) { const int kb = r / (NPB / 32), nb = r % (NPB / 32); transpose_item(w_in, NPROJ, kb * 64, nb * 32, win_t, DM, nb * 32, scr, lane); continue; } r -= I_IN;
            { const int kb = r / (DM / 32), nb = r % (DM / 32); transpose_item(w_out, DM, kb * 64, nb * 32, wout_t, DM, nb * 32, scr, lane); }
        }
        float wx[4][4][8];
#pragma unroll
        for (int j = 0; j < 4; ++j)
#pragma unroll
            for (int i = 0; i < 4; ++i) { const float* wr_ = w_in + (size_t)(4 * lane + 256 * j + i) * NPROJ + NPB; const float4 w0 = *(const float4*)wr_, w1 = *(const float4*)(wr_ + 4);
                wx[j][i][0] = w0.x; wx[j][i][1] = w0.y; wx[j][i][2] = w0.z; wx[j][i][3] = w0.w; wx[j][i][4] = w1.x; wx[j][i][5] = w1.y; wx[j][i][6] = w1.z; wx[j][i][7] = w1.w; }
        const int hsel = (lane >> 3) & 3; const bool is_alpha = lane >= 32;
        const float aneg = -expf(dn_a_log[hsel]), dtb = dn_dt_bias[hsel];
        float4 vnx[4];
        if (gw < NTOK) {
#pragma unroll
            for (int j = 0; j < 4; ++j) vnx[j] = ((const float4*)(x + (size_t)gw * DM) + lane)[64 * j]; }
        for (int r = gw; r < NTOK; r += NGW) {
            float4 v[4]; float s = 0.f;
#pragma unroll
            for (int j = 0; j < 4; ++j) { v[j] = vnx[j]; s += v[j].x * v[j].x + v[j].y * v[j].y + v[j].z * v[j].z + v[j].w * v[j].w; }
            if (r + NGW < NTOK) {
#pragma unroll
                for (int j = 0; j < 4; ++j) vnx[j] = ((const float4*)(x + (size_t)(r + NGW) * DM) + lane)[64 * j]; }
            const float rs = rsqrtf(wave_sum(s) * (1.f / DM) + EPS);
            float dots[8];
#pragma unroll
            for (int c = 0; c < 8; ++c) dots[c] = 0.f;
            unsigned long long* o8 = (unsigned long long*)(hb + (size_t)r * DM) + lane;
#pragma unroll
            for (int j = 0; j < 4; ++j) { const float4 g = ((const float4*)mix_g)[lane + 64 * j];
                v[j].x *= rs * g.x; v[j].y *= rs * g.y; v[j].z *= rs * g.z; v[j].w *= rs * g.w;
                o8[64 * j] = (unsigned long long)pk2(v[j].x, v[j].y) | ((unsigned long long)pk2(v[j].z, v[j].w) << 32);
                const float hv[4] = {v[j].x, v[j].y, v[j].z, v[j].w};
#pragma unroll
                for (int i = 0; i < 4; ++i)
#pragma unroll
                    for (int c = 0; c < 8; ++c) dots[c] += hv[i] * wx[j][i][c]; }
            const float tot = reduce8_tr(dots, lane);
            if ((lane & 7) == 0) bg[(size_t)r * 8 + (lane >> 3)] = is_alpha ? aneg * softplus_f(tot + dtb) : sigmoid_f(tot);
        }
    }
    }
    SEAM()
    REP(1) {
        pg8::Gemm g{hb, DM, nullptr}; pg8::DenseOrder S; S.init(NTOK, NPB, DM, win_t, G, bid);
        pg8::EpiBf16 E{proj, NPB};
        pg8::gemm_phase<pg8::EpiBf16, pg8::DenseOrder, false, true>((PG8_LAS unsigned char*)lds_raw, g, S, E);
    }
    SEAM()
    REP(3) dn::prep(lds_raw, tid, bid, G, proj, bg, dn_conv_w, DB, [&](int item, int w4, int lane_) {
        const __attribute__((address_space(4))) Params* Q_ = (const __attribute__((address_space(4))) Params*)__builtin_amdgcn_kernarg_segment_ptr(); asm volatile("" : "+s"(Q_));
        unsigned char* ws_ = Q_->ws;
        float* scr_ = (float*)(lds_raw + dn::P2_END + w4 * 4608);
        const int s0 = (w4 < 2) ? 2 * w4 : 3 * w4 - 2, ns = (w4 < 2) ? 2 : 3;
        for (int s_ = 0; s_ < ns; ++s_) conv_item(item * CV_PREP + s0 + s_, Q_->in[13], Q_->in[14], Q_->in[15], (bf16_t*)(ws_ + WS_WGU), (bf16_t*)(ws_ + WS_WD), scr_, lane_);
    });
    SEAM()
    REP(4) {
    constexpr int NSU = 2 * BATCH * NH;
    if (bid >= NSU || G <= NSU) {
        float* scr = lds + wave * (64 * 33);
        constexpr int I_G = NE * 16 * 16, I_D = NE * 8 * 32;
        const int nw = (G <= NSU) ? NGW : (G - NSU) * 8, w0 = (G <= NSU) ? gw : gw - NSU * 8;
        for (int it = CV_PREP * (BATCH * NH * (SEQ / 64)) + w0; it < 2 * I_G + I_D; it += nw) conv_item(it, w_gate, w_up, w_down, wgu_t, wd_t, scr, lane);
        if (G > NSU) MIXA_ROWS(w0, nw);
    }
    unsigned* dnflags = (unsigned*)(ws + WS_CTL);
    if (bid < NSU || G <= NSU) dn::scan(lds_raw, tid, bid, G, DB, ymix, dnflags);
    if (bid >= NSU || G <= NSU) {
        typedef unsigned u32x4_t __attribute__((ext_vector_type(4)));
        const int c0 = lane * 8;
        const int nw = (G <= NSU) ? NGW : (G - NSU) * 8, w0 = (G <= NSU) ? gw : gw - NSU * 8;
        if (G <= NSU) MIXA_ROWS(gw, NGW);
        const int wq0 = ((G <= NSU) ? bid : bid - NSU) * 8;
        for (int q0 = wq0; q0 < NTOK / 4; q0 += nw) {
            const int q = q0 + wave;
            const int ch = q >> 7, bb = (q >> 4) & 7, i4 = q & 15;
            const int rbase = bb * SEQ + ch * 64 + i4 * 4;
            u32x4_t ovv[4], zvv[4];
#pragma unroll
            for (int t = 0; t < 4; ++t) zvv[t] = *(const u32x4_t*)(proj + (size_t)(rbase + t) * NPB + C_Z + c0);
            if (wave == 0) {
                unsigned* fl = dnflags + (bb * 32 + ch) * 32;
                for (unsigned spins = 0; spins < (1u << 21); ++spins) {
                    if ((unsigned)__builtin_amdgcn_readfirstlane(__hip_atomic_load(fl, __ATOMIC_RELAXED, __HIP_MEMORY_SCOPE_AGENT)) >= 32u) break;
                    __builtin_amdgcn_s_sleep(32);
                }
                __builtin_amdgcn_fence(__ATOMIC_ACQUIRE, "agent");
                asm volatile("s_waitcnt vmcnt(0)" ::: "memory");
            }
            __syncthreads();
#pragma unroll
            for (int t = 0; t < 4; ++t) {
                const int r = rbase + t;
                const int oi_ = r & 63, oitem_ = ((r / SEQ) * NH + (c0 >> 7)) * (SEQ / 64) + ((r % SEQ) >> 6);
                ovv[t] = *(const u32x4_t*)(DB.UT + ((size_t)oitem_ * 128 + (c0 & 112)) * 64 + (((oi_ >> 4) * 4 + (oi_ & 3)) * 4 + ((oi_ >> 2) & 3)) * 16 + (c0 & 15));
            }
#pragma unroll
            for (int t = 0; t < 4; ++t) {
                const int r = rbase + t;
                const u32x4_t ov = ovv[t], zv = zvv[t];
                float o[8] = {dn::lo_f(ov.x), dn::hi_f(ov.x), dn::lo_f(ov.y), dn::hi_f(ov.y), dn::lo_f(ov.z), dn::hi_f(ov.z), dn::lo_f(ov.w), dn::hi_f(ov.w)};
                const float z[8] = {dn::lo_f(zv.x), dn::hi_f(zv.x), dn::lo_f(zv.y), dn::hi_f(zv.y), dn::lo_f(zv.z), dn::hi_f(zv.z), dn::lo_f(zv.w), dn::hi_f(zv.w)};
                float ss = 0.f;
#pragma unroll
                for (int i = 0; i < 8; ++i) ss += o[i] * o[i];
                ss += __shfl_xor(ss, 1); ss += __shfl_xor(ss, 2); ss += __shfl_xor(ss, 4); ss += __shfl_xor(ss, 8);
                const float rs = rsqrtf(ss * (1.f / 128.f) + EPS);
                const float4 g0 = *(const float4*)(dn_norm_g + (c0 & 127)), g1 = *(const float4*)(dn_norm_g + (c0 & 127) + 4);
                const float gv[8] = {g0.x, g0.y, g0.z, g0.w, g1.x, g1.y, g1.z, g1.w};
#pragma unroll
                for (int i = 0; i < 8; ++i) o[i] = o[i] * rs * gv[i] * dn::silu_fast(z[i]);
                u32x4_t w; w.x = dn::pkbf(o[0], o[1]); w.y = dn::pkbf(o[2], o[3]); w.z = dn::pkbf(o[4], o[5]); w.w = dn::pkbf(o[6], o[7]);
                *(u32x4_t*)(ymix + (size_t)r * DM + 512 + c0) = w;
            }
        }
    }
    }
    SEAM()
    REP(5) {
        pg8::Gemm g{ymix, DM, nullptr}; pg8::DenseOrder S; S.init(NTOK, DM, DM, wout_t, G, bid);
        pg8::EpiResid E{x, x1, DM};
        pg8::gemm_phase<pg8::EpiResid, pg8::DenseOrder, false, false>((PG8_LAS unsigned char*)lds_raw, g, S, E);
    }
    SEAM()
    {
        {
            const float4* src = (const float4*)r_exp_w; float4* dst = (float4*)lds_raw;
            for (int i = tid; i < DM * 8; i += NT) { const int k = i >> 3, sl = i & 7; dst[k * 8 + (sl ^ (k & 7))] = src[i]; }
        }
        float4 wg[16];
#pragma unroll
        for (int j = 0; j < 16; ++j) wg[j] = *(const float4*)(r_group_w + (size_t)(lane + 64 * j) * 4);
        float gf[16];
#pragma unroll
        for (int j = 0; j < 16; ++j) gf[j] = ffn_g[lane + 64 * j];
        int* lcnt = (int*)(lds_raw + LDS_TAB + 2048);
        if (tid < NE) lcnt[tid] = 0;
        __syncthreads();
        float hnx[16];
        if (gw < NTOK) {
#pragma unroll
            for (int j = 0; j < 16; ++j) hnx[j] = x1[(size_t)gw * DM + lane + 64 * j]; }
        for (int r = gw; r < NTOK; r += NGW) {
            float hv[16]; float s = 0.f;
#pragma unroll
            for (int j = 0; j < 16; ++j) { hv[j] = hnx[j]; s += hv[j] * hv[j]; }
            if (r + NGW < NTOK) {
#pragma unroll
                for (int j = 0; j < 16; ++j) hnx[j] = x1[(size_t)(r + NGW) * DM + lane + 64 * j]; }
            const float rs = rsqrtf(wave_sum(s) * (1.f / DM) + EPS);
            float gl4[4] = {0.f, 0.f, 0.f, 0.f};
#pragma unroll
            for (int j = 0; j < 16; ++j) { hv[j] *= rs * gf[j]; h2b[(size_t)r * DM + lane + 64 * j] = (bf16_t)f2bf(hv[j]);
                gl4[0] += hv[j] * wg[j].x; gl4[1] += hv[j] * wg[j].y; gl4[2] += hv[j] * wg[j].z; gl4[3] += hv[j] * wg[j].w; }
            const float gt = reduce4_tr(gl4, lane);
            const float gl[4] = {lane_bcast(gt, 0), lane_bcast(gt, 16), lane_bcast(gt, 32), lane_bcast(gt, 48)};
            int gi = 0; float gm = gl[0];
#pragma unroll
            for (int g = 1; g < 4; ++g) if (gl[g] > gm) { gm = gl[g]; gi = g; }
            float gs = 0.f;
#pragma unroll
            for (int g = 0; g < 4; ++g) gs += expf(gl[g] - gm);
            const float gprob = 1.f / gs;
            float ed[8] = {0.f, 0.f, 0.f, 0.f, 0.f, 0.f, 0.f, 0.f};
#pragma unroll
            for (int j = 0; j < 16; ++j) { const int k = lane + 64 * j; const float4* row = (const float4*)lds_raw + k * 8;
                const float4 w0 = row[(2 * gi) ^ (k & 7)], w1 = row[(2 * gi + 1) ^ (k & 7)];
                ed[0] += hv[j] * w0.x; ed[1] += hv[j] * w0.y; ed[2] += hv[j] * w0.z; ed[3] += hv[j] * w0.w; ed[4] += hv[j] * w1.x; ed[5] += hv[j] * w1.y; ed[6] += hv[j] * w1.z; ed[7] += hv[j] * w1.w; }
            const float et = reduce8_tr(ed, lane);
            float el[8];
#pragma unroll
            for (int e = 0; e < 8; ++e) el[e] = lane_bcast(et, 8 * e);
            int i1 = 0; float m1 = el[0];
#pragma unroll
            for (int e = 1; e < 8; ++e) if (el[e] > m1) { m1 = el[e]; i1 = e; }
            int i2 = -1; float m2 = -INFINITY;
#pragma unroll
            for (int e = 0; e < 8; ++e) if (e != i1 && el[e] > m2) { m2 = el[e]; i2 = e; }
            const float p2 = expf(m2 - m1), inv = 1.f / (1.f + p2);
            if (lane == 0) {
                const int e1 = gi * 8 + i1, e2 = gi * 8 + i2;
                tok_e[2 * r] = e1; tok_e[2 * r + 1] = e2;
                tok_g[2 * r] = gprob * inv; tok_g[2 * r + 1] = gprob * p2 * inv;
                tok_p[2 * r] = atomicAdd(&lcnt[e1], 1); tok_p[2 * r + 1] = atomicAdd(&lcnt[e2], 1);
            }
        }
        __syncthreads();
        if (tid < NE) ((int*)(ws + WS_CNTB))[bid * NE + tid] = lcnt[tid];
    }
    SEAM()
    {
        const int* cntb = (const int*)(ws + WS_CNTB);
        int* red = (int*)(lds_raw + LDS_TAB + 4096);
        int* Lbase = (int*)(lds_raw + LDS_TAB + 2048);
        { const int e = tid & 31, part = tid >> 5; int sall = 0, sbef = 0;
          for (int b_ = part; b_ < G; b_ += 16) { const int v = cntb[b_ * NE + e]; sall += v; sbef += (b_ < bid) ? v : 0; }
          red[part * 32 + e] = sall; red[512 + part * 32 + e] = sbef; }
        __syncthreads();
        if (tid < NE) { int a = 0, b_ = 0; for (int q = 0; q < 16; ++q) { a += red[q * 32 + tid]; b_ += red[512 + q * 32 + tid]; } red[1024 + tid] = a; Lbase[tid] = b_; }
        __syncthreads();
        if (tid == 0) { int o = 0, tl = 0, ns = 0;
            for (int e = 0; e < NE; ++e) { Loff[e] = o; Ltile[e] = tl; const int c = red[1024 + e], full = c >> 8, rem = c & 255;
                if (rem > 128 || rem == 0) { tl += full + (rem ? 1 : 0); Lend[e] = o + c; }
                else { tl += full; Lend[e] = o + 256 * full; LsmE[ns++] = e; }
                o += c; }
            Loff[NE] = o; Ltile[NE] = tl; LsmE[63] = ns; }
        __syncthreads();
        for (int q = tid; q < 16 * (NTOK / (8 * G) + 1); q += NT) {
            const int w = (q >> 1) & 7, k = q >> 4, r = bid * 8 + w + NGW * k, i = 2 * r + (q & 1);
            if (r < NTOK) { const int e = tok_e[i]; const int sl = Loff[e] + Lbase[e] + tok_p[i]; slot_tok[sl] = r; tok_p[i] = sl; }
        }
    }
    SEAM()
    REP(7) {
        pg8::Gemm g{h2b, DM, slot_tok};
        pg8::GroupedOrder S{Loff, Ltile, Lend, LsmE, Ltile[NE] * 4, (Ltile[NE] + LsmE[63]) * 4, G, bid, (const char*)wgu_t, (size_t)DM * DM * 2, (size_t)256 * DM * 2};
        pg8::EpiAct E{act};
        pg8::gemm_phase<pg8::EpiAct, pg8::GroupedOrder, true, true>((PG8_LAS unsigned char*)lds_raw, g, S, E);
    }
    SEAM()
    REP(8) {
        pg8::Gemm g{act, FF, nullptr};
        pg8::GroupedOrder S{Loff, Ltile, Lend, LsmE, Ltile[NE] * 4, (Ltile[NE] + LsmE[63]) * 4, G, bid, (const char*)wd_t, (size_t)DM * FF * 2, (size_t)256 * FF * 2};
        pg8::EpiBf16 E{yexp, DM};
        pg8::gemm_phase<pg8::EpiBf16, pg8::GroupedOrder, false, true>((PG8_LAS unsigned char*)lds_raw, g, S, E);
    }
    SEAM()
    {
        const int nmine = (NTOK - gw + NGW - 1) / NGW;
        const float4* fg = (const float4*)final_g + lane;
        float4 gfin[4];
#pragma unroll
        for (int j = 0; j < 4; ++j) gfin[j] = fg[64 * j];
        for (int k0 = 0; k0 < nmine; k0 += 16) {
            const int kk = k0 + (lane & 15), rr = gw + NGW * (kk < nmine ? kk : k0);
            const int2 sv = *(const int2*)(tok_p + 2 * rr); const float2 gv = *(const float2*)(tok_g + 2 * rr);
            for (int k = k0; k < nmine && k < k0 + 16; k += 4) {
                int rT[4]; bool has[4]; int s0[4], s1[4]; float g0[4], g1[4];
#pragma unroll
                for (int t = 0; t < 4; ++t) { has[t] = k + t < nmine; const int l_ = has[t] ? k + t - k0 : k - k0; rT[t] = gw + NGW * (has[t] ? k + t : k);
                    s0[t] = __shfl(sv.x, l_); s1[t] = __shfl(sv.y, l_); g0[t] = __shfl(gv.x, l_); g1[t] = __shfl(gv.y, l_); }
                float4 xv[4][4]; uint2 ya[4][4], yb[4][4];
#pragma unroll
                for (int t = 0; t < 4; ++t)
#pragma unroll
                    for (int j = 0; j < 4; ++j) { xv[t][j] = ((const float4*)(x1 + (size_t)rT[t] * DM) + lane)[64 * j]; ya[t][j] = ((const uint2*)(yexp + (size_t)s0[t] * DM) + lane)[64 * j]; yb[t][j] = ((const uint2*)(yexp + (size_t)s1[t] * DM) + lane)[64 * j]; }
                float ssum[4];
#pragma unroll
                for (int t = 0; t < 4; ++t) { float a_ = 0.f;
#pragma unroll
                    for (int j = 0; j < 4; ++j) {
                        xv[t][j] = make_float4(xv[t][j].x + g0[t] * dn::lo_f(ya[t][j].x) + g1[t] * dn::lo_f(yb[t][j].x), xv[t][j].y + g0[t] * dn::hi_f(ya[t][j].x) + g1[t] * dn::hi_f(yb[t][j].x),
                                               xv[t][j].z + g0[t] * dn::lo_f(ya[t][j].y) + g1[t] * dn::lo_f(yb[t][j].y), xv[t][j].w + g0[t] * dn::hi_f(ya[t][j].y) + g1[t] * dn::hi_f(yb[t][j].y));
                        a_ += xv[t][j].x * xv[t][j].x + xv[t][j].y * xv[t][j].y + xv[t][j].z * xv[t][j].z + xv[t][j].w * xv[t][j].w; }
                    ssum[t] = a_; }
#pragma unroll
                for (int o = 1; o < 64; o <<= 1) {
#pragma unroll
                    for (int t = 0; t < 4; ++t) ssum[t] += __shfl_xor(ssum[t], o); }
#pragma unroll
                for (int t = 0; t < 4; ++t) { if (has[t]) { const float rs = rsqrtf(ssum[t] * (1.f / DM) + EPS); float4* od = (float4*)(outp + (size_t)rT[t] * DM) + lane;
#pragma unroll
                    for (int j = 0; j < 4; ++j) od[64 * j] = make_float4(xv[t][j].x * rs * gfin[j].x, xv[t][j].y * rs * gfin[j].y, xv[t][j].z * rs * gfin[j].z, xv[t][j].w * rs * gfin[j].w); } }
            }
        }
    }
    }
}

extern "C" void kernel_launch(void* const* d_in, const int* in_sizes, int n_in, void* d_out, int out_size, void* d_ws, size_t ws_size, hipStream_t stream) {
    static int grid_blocks = 0;
    if (!grid_blocks) {
        int dev = 0, cus = 0, per_cu = 0;
        (void)hipGetDevice(&dev);
        (void)hipDeviceGetAttribute(&cus, hipDeviceAttributeMultiprocessorCount, dev);
        (void)hipFuncSetAttribute((const void*)fwd_kernel, hipFuncAttributeMaxDynamicSharedMemorySize, LDS_BYTES);
        (void)hipOccupancyMaxActiveBlocksPerMultiprocessor(&per_cu, (const void*)fwd_kernel, NT, LDS_BYTES);
        if (per_cu < 1) per_cu = 1;
        if (per_cu > 1 && 2 * LDS_BYTES > 160 * 1024) per_cu = 1;
        grid_blocks = cus * per_cu;
        fprintf(stderr, "kernel_launch: cus %d per_cu %d grid %d ws_size %zu\n", cus, per_cu, grid_blocks, ws_size);
    }
    (void)hipMemsetAsync((char*)d_ws + WS_CTL, 0, CTL_ZERO_BYTES, stream);
    Params p{};
    for (int i = 0; i < 17; ++i) p.in[i] = (const float*)d_in[i];
    p.out = (float*)d_out; p.ws = (unsigned char*)d_ws;
    hipLaunchKernelGGL(fwd_kernel, dim3(grid_blocks), dim3(NT), LDS_BYTES, stream, p);
    hipError_t e = hipPeekAtLastError();
    if (e != hipSuccess) fprintf(stderr, "launch failed: %s (grid %d)\n", hipGetErrorString(e), grid_blocks);
}
```

```cpp
#include <hip/hip_runtime.h>
#include <cstdio>
#include <cstdint>

constexpr int BATCH = 8, SEQ = 2048, DM = 1024, NTOK = BATCH * SEQ;
constexpr int NH = 4, HD = 128, NPROJ = 3592, NPB = 3584;
constexpr int C_AH = 0, C_AB = 512, C_AC = 1024, C_Q = 1536, C_K = 2048, C_V = 2560, C_Z = 3072;
constexpr int NE = 32, FF = 512;
constexpr float EPS = 1e-6f;
constexpr int NT = 512;
#ifndef REP_PHASE
#define REP_PHASE -1
#endif
#define REP(k) for (int rep_ = 0; rep_ < ((REP_PHASE == (k)) ? 2 : 1); ++rep_)
constexpr int LDS_BYTES = 144 * 1024;
constexpr int LDS_TAB = 131072;

typedef unsigned short bf16_t;
constexpr size_t MiB = 1u << 20;
constexpr size_t WS_CTL = 0;
constexpr size_t WS_BAR = 65536;
constexpr size_t CTL_ZERO_BYTES = 131072;
constexpr size_t WS_RSTD2 = 1 * MiB;
constexpr size_t WS_TOKE = WS_RSTD2 + 65536;
constexpr size_t WS_TOKG = WS_TOKE + 131072;
constexpr size_t WS_TOKP = WS_TOKG + 131072;
constexpr size_t WS_SLOTTOK = WS_TOKP + 131072;
constexpr size_t WS_GL = WS_SLOTTOK + 131072;
constexpr size_t WS_CNTB = WS_GL + 8192;
constexpr size_t WS_BG = 2 * MiB;
constexpr size_t WS_WIN = 3 * MiB;
constexpr size_t WS_WOUT = 10 * MiB;
constexpr size_t WS_WGU = 12 * MiB;
constexpr size_t WS_WD = 76 * MiB;
constexpr size_t WS_PROJ = 108 * MiB;
constexpr size_t WS_HB = 220 * MiB;
constexpr size_t WS_YMIX = 220 * MiB;
constexpr size_t WS_AQK = 252 * MiB;
constexpr size_t WS_H2B = 108 * MiB;
constexpr size_t WS_ACT = 140 * MiB;
constexpr size_t WS_YEXP = 173 * MiB;

struct Params { const float* in[17]; float* out; unsigned char* ws; };

__device__ __forceinline__ float wave_sum(float v) {
#pragma unroll
    for (int o = 1; o < 64; o <<= 1) v += __shfl_xor(v, o);
    return v;
}
__device__ __forceinline__ float silu_f(float x) { return x / (1.f + expf(-x)); }
__device__ __forceinline__ float sigmoid_f(float x) { return 1.f / (1.f + expf(-x)); }
__device__ __forceinline__ float softplus_f(float x) { return fmaxf(x, 0.f) + log1pf(expf(-fabsf(x))); }
__device__ __forceinline__ float bf2f(bf16_t h) { return __uint_as_float((unsigned)h << 16); }
__device__ __forceinline__ unsigned f2bf(float f) { unsigned u = __float_as_uint(f); return (u + 0x7fffu + ((u >> 16) & 1u)) >> 16; }
__device__ __forceinline__ unsigned pk2(float lo, float hi) { return f2bf(lo) | (f2bf(hi) << 16); }


__device__ __forceinline__ float reduce8_tr(const float (&v)[8], int lane) {
    float a[4], b[2];
#pragma unroll
    for (int i = 0; i < 4; ++i) { const bool hi = lane & 32; const float send = hi ? v[i] : v[i + 4], keep = hi ? v[i + 4] : v[i]; a[i] = keep + __shfl_xor(send, 32); }
#pragma unroll
    for (int i = 0; i < 2; ++i) { const bool hi = lane & 16; const float send = hi ? a[i] : a[i + 2], keep = hi ? a[i + 2] : a[i]; b[i] = keep + __shfl_xor(send, 16); }
    const bool hi = lane & 8; const float send = hi ? b[0] : b[1], keep = hi ? b[1] : b[0];
    float c = keep + __shfl_xor(send, 8);
    c += __shfl_xor(c, 4); c += __shfl_xor(c, 2); c += __shfl_xor(c, 1);
    return c;
}
__device__ __forceinline__ float reduce4_tr(const float (&v)[4], int lane) {
    float a[2];
#pragma unroll
    for (int i = 0; i < 2; ++i) { const bool hi = lane & 32; const float send = hi ? v[i] : v[i + 2], keep = hi ? v[i + 2] : v[i]; a[i] = keep + __shfl_xor(send, 32); }
    const bool hi = lane & 16; const float send = hi ? a[0] : a[1], keep = hi ? a[1] : a[0];
    float c = keep + __shfl_xor(send, 16);
    c += __shfl_xor(c, 8); c += __shfl_xor(c, 4); c += __shfl_xor(c, 2); c += __shfl_xor(c, 1);
    return c;
}
__device__ __forceinline__ float lane_bcast(float v, int src) { return __int_as_float(__builtin_amdgcn_readlane(__float_as_int(v), src)); }

namespace pg8 {
#define PG8_LAS __attribute__((address_space(3)))
typedef short bf16x8 __attribute__((ext_vector_type(8)));
typedef float f32x4 __attribute__((ext_vector_type(4)));
typedef unsigned u32x4 __attribute__((ext_vector_type(4)));
constexpr int BM = 256, BK = 64, HALF = 128, HTB = HALF * BK * 2, STAGE_BYTES = 8 * HTB, NXCD = 8, WGM = 8;

__host__ __device__ __forceinline__ int lds_byte(int r, int c) { const int st = (r >> 4) * 2 + (c >> 5), rr = r & 15, cc = c & 31, ob = rr * 64 + cc * 2; return st * 1024 + (ob ^ (((ob >> 9) & 1) << 5)); }
__host__ __device__ __forceinline__ void stage_rc(int b, int& R, int& C) { const int st = b / 1024, sb = b % 1024, swz = sb ^ (((sb >> 9) & 1) << 5); R = (st >> 1) * 16 + swz / 64; C = (st & 1) * 32 + (swz % 64) / 2; }
__host__ __device__ __forceinline__ int perm32(int rho) { const int n = rho >> 4, i = rho & 15; return 8 * (i >> 2) + 4 * n + (i & 3); }

struct Unit { int arow0, rowend, pn, half; const char* B; };
struct Gemm { const bf16_t* A; int K; const int* gidx; };

struct DenseOrder {
    int nM, nN, nwg, G, c, M, nfull, tail; const char* Bt; size_t tstep;
    __device__ void init(int M_, int N, int K, const bf16_t* Bt_, int G_, int c_) { M = M_; nM = M / BM; nN = N / BM; nwg = nM * nN; G = G_; c = c_; Bt = (const char*)Bt_; tstep = (size_t)BM * K * 2;
        nfull = (nwg / G) * G; tail = nwg - nfull; if (2 * tail > G) { nfull = nwg; tail = 0; } }
    __device__ bool next(int i, Unit& u) const {
        const long L = (long)i * G + c; int wgid, hs = -1;
        if (L < nfull) wgid = (int)L;
        else { const long hu = L - nfull; if (hu >= 2 * tail) return false; wgid = nfull + (int)(hu % tail); hs = (int)(hu / tail); }
        { const int q = nwg / NXCD, r = nwg % NXCD, xcd = wgid % NXCD, off = wgid / NXCD; wgid = (xcd < r ? xcd * (q + 1) : r * (q + 1) + (xcd - r) * q) + off; }
        const int nig = WGM * nN, gid = wgid / nig, fm = gid * WGM, gsz = (nM - fm) < WGM ? (nM - fm) : WGM;
        const int pm = fm + ((wgid % nig) % gsz); u.pn = (wgid % nig) / gsz; u.B = Bt + (size_t)u.pn * tstep;
        if (hs < 0) { u.arow0 = pm * BM; u.rowend = M; u.half = 0; } else { u.arow0 = pm * BM + HALF * hs; u.rowend = u.arow0 + HALF; u.half = 1; }
        return true;
    }
};

typedef __bf16 bf16x2_t __attribute__((ext_vector_type(2)));
typedef float f32x2_t __attribute__((ext_vector_type(2)));
__device__ __forceinline__ unsigned cvt_pk_bf16(float lo, float hi) { const f32x2_t v = {lo, hi}; return __builtin_bit_cast(unsigned, __builtin_convertvector(v, bf16x2_t)); }

struct EpiBf16 {
    static constexpr bool PERM = true;
    bf16_t* O; int ldc;
    __device__ __forceinline__ void operator()(const f32x4 (&acc)[2][2][4][2], const Unit& u, int wr, int wc, int fr, int fq) const {
        const int row0 = u.arow0 + wr * 64 + fr, col0 = u.pn * BM + wc * 32 + 8 * fq;
#pragma unroll
        for (int ai = 0; ai < 2; ++ai)
#pragma unroll
            for (int m = 0; m < 4; ++m) { const int row = row0 + ai * HALF + m * 16; bf16_t* rowp = O + (size_t)row * ldc + col0;
                if (row < u.rowend) {
#pragma unroll
                    for (int bj = 0; bj < 2; ++bj) { const f32x4 v0 = acc[ai][bj][m][0], v1 = acc[ai][bj][m][1];
                        u32x4 w; w.x = cvt_pk_bf16(v0[0], v0[1]); w.y = cvt_pk_bf16(v0[2], v0[3]); w.z = cvt_pk_bf16(v1[0], v1[1]); w.w = cvt_pk_bf16(v1[2], v1[3]);
                        *(u32x4*)(rowp + bj * HALF) = w; } } }
    }
};
struct EpiResid {
    static constexpr bool PERM = false;
    const float* base; float* C; int ldc;
    __device__ __forceinline__ void operator()(const f32x4 (&acc)[2][2][4][2], const Unit& u, int wr, int wc, int fr, int fq) const {
        const int row0 = u.arow0 + wr * 64 + fr, col0 = u.pn * BM + wc * 32 + 4 * fq;
#pragma unroll
        for (int ai = 0; ai < 2; ++ai) {
            f32x4 bv[4][2][2];
#pragma unroll
            for (int m = 0; m < 4; ++m) { const size_t off = (size_t)(row0 + ai * HALF + m * 16) * ldc + col0;
#pragma unroll
                for (int bj = 0; bj < 2; ++bj)
#pragma unroll
                    for (int n = 0; n < 2; ++n) bv[m][bj][n] = *(const f32x4*)(base + off + bj * HALF + n * 16); }
#pragma unroll
            for (int m = 0; m < 4; ++m) { const size_t off = (size_t)(row0 + ai * HALF + m * 16) * ldc + col0;
#pragma unroll
                for (int bj = 0; bj < 2; ++bj)
#pragma unroll
                    for (int n = 0; n < 2; ++n) *(f32x4*)(C + off + bj * HALF + n * 16) = bv[m][bj][n] + acc[ai][bj][m][n]; }
        }
    }
};
struct EpiAct {
    static constexpr bool PERM = true;
    bf16_t* O;
    __device__ __forceinline__ void operator()(const f32x4 (&acc)[2][2][4][2], const Unit& u, int wr, int wc, int fr, int fq) const {
        const int row0 = u.arow0 + wr * 64 + fr, col0 = u.pn * HALF + wc * 32 + 8 * fq;
#pragma unroll
        for (int ai = 0; ai < 2; ++ai)
#pragma unroll
            for (int m = 0; m < 4; ++m) { const int row = row0 + ai * HALF + m * 16;
                if (row < u.rowend) { float v[8];
#pragma unroll
                    for (int n = 0; n < 2; ++n)
#pragma unroll
                        for (int j = 0; j < 4; ++j) { const float gt = acc[ai][0][m][n][j], up = acc[ai][1][m][n][j]; v[n * 4 + j] = gt * __builtin_amdgcn_rcpf(1.f + __builtin_amdgcn_exp2f(-1.4426950408889634f * gt)) * up; }
                    u32x4 w; w.x = cvt_pk_bf16(v[0], v[1]); w.y = cvt_pk_bf16(v[2], v[3]); w.z = cvt_pk_bf16(v[4], v[5]); w.w = cvt_pk_bf16(v[6], v[7]);
                    *(u32x4*)(O + (size_t)row * 512 + col0) = w; } }
    }
};
struct GroupedOrder {
    const int* Loff; const int* Ttile; const int* Lend; const int* LsmE; int nfullu, nunits, G, c; const char* Bt; size_t estride, tstep;
    __device__ bool next(int i, Unit& u) const {
        const int L = (G == 256) ? ((i * 8 + (c & 7)) * 32 + (c >> 3)) : (i * G + c);
        if (L >= nunits) return false;
        u.pn = L & 3;
        if (L < nfullu) { const int tile = L >> 2; int e = 0; while (Ttile[e + 1] <= tile) ++e;
            u.arow0 = Loff[e] + (tile - Ttile[e]) * BM; u.rowend = Lend[e]; u.half = 0; u.B = Bt + (size_t)e * estride + (size_t)u.pn * tstep; }
        else { const int e = LsmE[(L - nfullu) >> 2]; u.arow0 = Lend[e]; u.rowend = Loff[e + 1]; u.half = 1; u.B = Bt + (size_t)e * estride + (size_t)u.pn * tstep; }
        return true;
    }
};

template <class Epi, class Sched, bool GATHER, bool ALIGN_EPI>
__device__ __forceinline__ void gemm_phase(PG8_LAS unsigned char* lds, const Gemm g, const Sched& S, const Epi& E) {
    const int tid = threadIdx.x, wid = __builtin_amdgcn_readfirstlane(tid >> 6), lane = tid & 63, wr = wid >> 2, wc = wid & 3, fr = lane & 15, fq = lane >> 4;
    const int K = g.K, nt = K / BK;
    int RA[2], CA[2]; unsigned voffB[2];
#pragma unroll
    for (int i = 0; i < 2; ++i) { int R, C; stage_rc(tid * 16 + i * 8192, R, C); const int Rb = Epi::PERM ? ((R & ~31) + perm32(R & 31)) : R;
        RA[i] = R; CA[i] = C; voffB[i] = (unsigned)(Rb * K + C) * 2u; }
    const size_t kstep = (size_t)(BK * 2);
    const size_t hstep = (size_t)HALF * K * 2;
    const unsigned ldsw = (unsigned)wid * 1024u;
    const int aoff = lds_byte(wr * 64 + fr, fq * 8), boff = lds_byte(wc * 32 + fr, fq * 8);
    const char* A0 = (const char*)g.A;
#define PG8_SA(b, h) (((b) * 2 + (h)) * HTB)
#define PG8_SB(b, h) ((4 + (b) * 2 + (h)) * HTB)
#define PG8_STAGE(bufoff, gbase, voff) do { _Pragma("unroll") for (int _i = 0; _i < 2; ++_i) \
        __builtin_amdgcn_global_load_lds((const unsigned*)((const char*)(gbase) + (voff)[_i]), (PG8_LAS unsigned*)(lds + (bufoff) + ldsw + _i * 8192), 16, 0, 0); } while (0)
#define PG8_LDA(dst, b, h) do { _Pragma("unroll") for (int m = 0; m < 4; ++m) _Pragma("unroll") for (int k = 0; k < 2; ++k) dst[m][k] = *(const PG8_LAS bf16x8*)(lds + PG8_SA(b, h) + aoff + m * 2048 + k * 1024); } while (0)
#define PG8_LDB(dst, b, h) do { _Pragma("unroll") for (int n = 0; n < 2; ++n) _Pragma("unroll") for (int k = 0; k < 2; ++k) dst[n][k] = *(const PG8_LAS bf16x8*)(lds + PG8_SB(b, h) + boff + n * 2048 + k * 1024); } while (0)
#define PG8_MMA(ai, bj, At, Bt) do { __builtin_amdgcn_s_setprio(1); _Pragma("unroll") for (int m = 0; m < 4; ++m) _Pragma("unroll") for (int n = 0; n < 2; ++n) _Pragma("unroll") for (int k = 0; k < 2; ++k) \
        acc[ai][bj][m][n] = __builtin_amdgcn_mfma_f32_16x16x32_bf16(Bt[n][k], At[m][k], acc[ai][bj][m][n], 0, 0, 0); __builtin_amdgcn_s_setprio(0); } while (0)
#define PG8_WAIT_V(n) asm volatile("s_waitcnt vmcnt(" #n ")" ::: "memory")
#define PG8_WAIT_L(n) asm volatile("s_waitcnt lgkmcnt(" #n ")" ::: "memory")
#define PG8_BAR __builtin_amdgcn_s_barrier()
#define PG8_SCHED __builtin_amdgcn_sched_barrier(0)
#define PG8_AOFF(dst, u) do { _Pragma("unroll") for (int _h = 0; _h < 2; ++_h) _Pragma("unroll") for (int _i = 0; _i < 2; ++_i) { int _r = (u).arow0 + _h * HALF + RA[_i]; _r = _r < (u).rowend ? _r : (u).rowend - 1; \
        if (GATHER) _r = g.gidx[_r]; dst[_h][_i] = (unsigned)(_r * K + CA[_i]) * 2u; } } while (0)
    Unit cur, nxt; int ui = 0;
    if (!S.next(0, cur)) return;
    f32x4 acc[2][2][4][2];
#pragma unroll
    for (int a = 0; a < 2; ++a)
#pragma unroll
        for (int b = 0; b < 2; ++b)
#pragma unroll
            for (int m = 0; m < 4; ++m)
#pragma unroll
                for (int n = 0; n < 2; ++n) acc[a][b][m][n] = (f32x4){0.f, 0.f, 0.f, 0.f};
    bf16x8 At[4][2], B0[2][2], B1[2][2];
    unsigned cvA[2][2], nvA[2][2];
    PG8_AOFF(cvA, cur);
    const char* cB = cur.B;
    PG8_STAGE(PG8_SB(0, 0), cB, voffB); PG8_STAGE(PG8_SB(0, 1), cB + hstep, voffB); PG8_STAGE(PG8_SA(0, 0), A0, cvA[0]); PG8_STAGE(PG8_SA(0, 1), A0, cvA[1]);
    if (wr == 1) PG8_BAR;
    PG8_WAIT_V(2); PG8_BAR;
    PG8_STAGE(PG8_SB(1, 0), cB + kstep, voffB); PG8_STAGE(PG8_SA(1, 0), A0 + kstep, cvA[0]); PG8_STAGE(PG8_SB(1, 1), cB + hstep + kstep, voffB);
    PG8_WAIT_V(6); PG8_BAR;
    for (;;) {
        const bool has_next = S.next(ui + 1, nxt);
        if (has_next) { PG8_AOFF(nvA, nxt); } else {
#pragma unroll
            for (int h = 0; h < 2; ++h)
#pragma unroll
                for (int i = 0; i < 2; ++i) nvA[h][i] = cvA[h][i]; }
        const char* nB = has_next ? nxt.B : cB;
        for (int t = 0; t < nt; t += 2) {
            const bool last = (t == nt - 2);
            const char* a1 = A0 + (size_t)(t + 1) * kstep;
            const char* a2 = last ? A0 : A0 + (size_t)(t + 2) * kstep; const char* b2 = last ? nB : cB + (size_t)(t + 2) * kstep;
            const char* a3 = a2 + kstep; const char* b3 = b2 + kstep;
            unsigned s2[2][2];
#pragma unroll
            for (int h = 0; h < 2; ++h)
#pragma unroll
                for (int i = 0; i < 2; ++i) s2[h][i] = last ? nvA[h][i] : cvA[h][i];
            PG8_LDB(B0, 0, 0); PG8_LDB(B1, 0, 1); PG8_SCHED; PG8_LDA(At, 0, 0); PG8_STAGE(PG8_SA(1, 1), a1, cvA[1]);
            PG8_WAIT_V(8); PG8_WAIT_L(0); PG8_BAR; PG8_MMA(0, 0, At, B0); PG8_MMA(0, 1, At, B1); PG8_BAR; PG8_SCHED;
            PG8_LDA(At, 0, 1); PG8_STAGE(PG8_SB(0, 0), b2, voffB); PG8_STAGE(PG8_SB(0, 1), b2 + hstep, voffB); PG8_STAGE(PG8_SA(0, 0), a2, s2[0]);
            PG8_WAIT_V(8); PG8_WAIT_L(0); PG8_BAR; if (!cur.half) { PG8_MMA(1, 0, At, B0); PG8_MMA(1, 1, At, B1); } PG8_BAR; PG8_SCHED;
            PG8_LDB(B0, 1, 0); PG8_LDB(B1, 1, 1); PG8_SCHED; PG8_LDA(At, 1, 0); PG8_STAGE(PG8_SA(0, 1), a2, s2[1]);
            PG8_WAIT_V(8); PG8_WAIT_L(0); PG8_BAR; PG8_MMA(0, 0, At, B0); PG8_MMA(0, 1, At, B1); PG8_BAR; PG8_SCHED;
            PG8_LDA(At, 1, 1); PG8_STAGE(PG8_SB(1, 0), b3, voffB); PG8_STAGE(PG8_SB(1, 1), b3 + hstep, voffB); PG8_STAGE(PG8_SA(1, 0), a3, s2[0]);
            PG8_WAIT_V(8); PG8_WAIT_L(0); PG8_BAR; if (!cur.half) { PG8_MMA(1, 0, At, B0); PG8_MMA(1, 1, At, B1); } PG8_BAR; PG8_SCHED;
        }
        if constexpr (ALIGN_EPI) { if (wr == 0) PG8_BAR; }
        E(acc, cur, wr, wc, fr, fq);
        if (!has_next) break;
#pragma unroll
        for (int a = 0; a < 2; ++a)
#pragma unroll
            for (int b = 0; b < 2; ++b)
#pragma unroll
                for (int m = 0; m < 4; ++m)
#pragma unroll
                    for (int n = 0; n < 2; ++n) acc[a][b][m][n] = (f32x4){0.f, 0.f, 0.f, 0.f};
        cur = nxt; cB = nB; ++ui;
#pragma unroll
        for (int h = 0; h < 2; ++h)
#pragma unroll
            for (int i = 0; i < 2; ++i) cvA[h][i] = nvA[h][i];
        if constexpr (ALIGN_EPI) { if (wr == 1) PG8_BAR; }
    }
    PG8_WAIT_V(0);
    if constexpr (!ALIGN_EPI) { if (wr == 0) PG8_BAR; }
    PG8_BAR;
#undef PG8_SA
#undef PG8_SB
#undef PG8_STAGE
#undef PG8_LDA
#undef PG8_LDB
#undef PG8_MMA
#undef PG8_WAIT_V
#undef PG8_WAIT_L
#undef PG8_BAR
#undef PG8_SCHED
#undef PG8_AOFF
}
}


namespace dn {
typedef short bf16x8 __attribute__((ext_vector_type(8)));
typedef float f32x4 __attribute__((ext_vector_type(4)));
typedef unsigned u32x4 __attribute__((ext_vector_type(4)));
typedef unsigned u32x2 __attribute__((ext_vector_type(2)));
__device__ __forceinline__ int perm_pos(int kl) { return 8 * ((kl >> 2) & 3) + 4 * (kl >> 4) + (kl & 3); }
__device__ __forceinline__ int perm_inv(int p) { return 16 * ((p >> 2) & 1) + 4 * (p >> 3) + (p & 3); }
typedef __bf16 bf16x2_t __attribute__((ext_vector_type(2)));
typedef float f32x2_t __attribute__((ext_vector_type(2)));
__device__ __forceinline__ unsigned pkbf(float lo, float hi) { const f32x2_t v = {lo, hi}; return __builtin_bit_cast(unsigned, __builtin_convertvector(v, bf16x2_t)); }
__device__ __forceinline__ float lo_f(unsigned u) { return __uint_as_float(u << 16); }
__device__ __forceinline__ float hi_f(unsigned u) { return __uint_as_float(u & 0xffff0000u); }
constexpr int P2_LT = 0, P2_G = 16384, P2_QB = 17408, P2_KB = P2_QB + 17408, P2_RU = P2_KB + 17408, P2_RW = P2_RU + 32768;
constexpr int ROWB = 272;

struct DnBufs { bf16_t* UT; bf16_t* WN; bf16_t* QD; bf16_t* KDT; bf16_t* AQK; float* GL; };

__device__ __forceinline__ float silu_fast(float a) { return a * __builtin_amdgcn_rcpf(1.f + __builtin_amdgcn_exp2f(-1.4426950408889634f * a)); }
constexpr int P2_END = P2_RW + 32768;
template <class Hook>
__device__ __forceinline__ void prep(unsigned char* lds, int tid, int bid, int G, const bf16_t* proj, const float* bg, const float* dn_conv_w, const DnBufs B, Hook hook) {
    const int lane = tid & 63, wave = tid >> 6;
    float* RU = (float*)(lds + P2_RU); float* RW = (float*)(lds + P2_RW); float* LT = (float*)(lds + P2_LT); float* GS = (float*)(lds + P2_G);
    const int nitems = BATCH * NH * (SEQ / 64);
    const int r0 = wave * 8;
    unsigned xin[11][3]; float gin, bin;
#define DN_PREP_LOAD(item_) do { const int bh_ = (item_) >> 5, c_ = (item_) & 31, b_ = bh_ >> 2, h_ = bh_ & 3, t0_ = c_ * 64; \
        _Pragma("unroll") for (int rr = 0; rr < 11; ++rr) { const int t = t0_ + r0 + rr - 3; \
            _Pragma("unroll") for (int wh = 0; wh < 3; ++wh) { const unsigned v_ = *(const unsigned*)(proj + ((size_t)b_ * SEQ + (t >= 0 ? t : 0)) * NPB + C_Q + wh * 512 + h_ * 128 + 2 * lane); xin[rr][wh] = (t >= 0) ? v_ : 0u; } } \
        gin = bg[((size_t)b_ * SEQ + t0_ + lane) * 8 + 4 + h_]; bin = bg[((size_t)b_ * SEQ + t0_ + lane) * 8 + h_]; } while (0)
    for (int item = bid; item < nitems; item += G) {
        const int bh = item >> 5, h = bh & 3;
        DN_PREP_LOAD(item);
        float cw[3][4][2];
#pragma unroll
        for (int wh = 0; wh < 3; ++wh)
#pragma unroll
            for (int j = 0; j < 4; ++j) { const float2 w2 = *(const float2*)(dn_conv_w + j * 1536 + wh * 512 + h * 128 + 2 * lane); cw[wh][j][0] = w2.x; cw[wh][j][1] = w2.y; }
        float Gc = gin;
#pragma unroll
        for (int o = 1; o < 64; o <<= 1) { const float t = __shfl_up(Gc, o); if (lane >= o) Gc += t; }
        const float glast = __shfl(Gc, 63), eGl = __expf(Gc), bel = bin;
        if (wave == 0) { GS[lane] = Gc; GS[64 + lane] = eGl; GS[128 + lane] = bel; GS[192 + lane] = __expf(glast - Gc); if (lane == 0) B.GL[item] = glast; }
#pragma unroll
        for (int rr = 0; rr < 8; ++rr) {
            const int i = r0 + rr;
            float val[3][2];
#pragma unroll
            for (int wh = 0; wh < 3; ++wh) { float a0 = 0.f, a1 = 0.f;
#pragma unroll
                for (int j = 0; j < 4; ++j) { a0 += lo_f(xin[rr + j][wh]) * cw[wh][j][0]; a1 += hi_f(xin[rr + j][wh]) * cw[wh][j][1]; }
                val[wh][0] = silu_fast(a0); val[wh][1] = silu_fast(a1); }
            float sq = val[0][0] * val[0][0] + val[0][1] * val[0][1], sk = val[1][0] * val[1][0] + val[1][1] * val[1][1];
#pragma unroll
            for (int o = 1; o < 64; o <<= 1) { sq += __shfl_xor(sq, o); sk += __shfl_xor(sk, o); }
            const float fq = rsqrtf(sq + EPS) * 0.08838834764831845f, fk = rsqrtf(sk + EPS);
            const float eG = __shfl(eGl, i), be = __shfl(bel, i);
            const float q0 = val[0][0] * fq, q1 = val[0][1] * fq, k0 = val[1][0] * fk, k1 = val[1][1] * fk;
            *(unsigned*)(lds + P2_QB + i * ROWB + 4 * lane) = pkbf(q0, q1);
            *(unsigned*)(lds + P2_KB + i * ROWB + 4 * lane) = pkbf(k0, k1);
            const int kl = (2 * lane) & 31, pos = ((2 * lane) & ~31) + perm_pos(kl);
            *(unsigned*)(B.QD + ((size_t)item * 64 + i) * 128 + pos) = pkbf(q0 * eG, q1 * eG);
            *(float2*)(RW + i * 128 + 2 * lane) = make_float2(be * eG * k0, be * eG * k1);
            *(float2*)(RU + i * 128 + 2 * lane) = make_float2(be * val[2][0], be * val[2][1]);
        }
        __syncthreads();
        {
            const int g = lane >> 4, cl = lane & 15, mi = wave >> 1, nj0 = 2 * (wave & 1);
            bf16x8 ka[4], qa[4];
#pragma unroll
            for (int s_ = 0; s_ < 4; ++s_) { ka[s_] = *(const bf16x8*)(lds + P2_KB + (16 * mi + cl) * ROWB + (32 * s_ + 8 * g) * 2); qa[s_] = *(const bf16x8*)(lds + P2_QB + (16 * mi + cl) * ROWB + (32 * s_ + 8 * g) * 2); }
#pragma unroll
            for (int nn = 0; nn < 2; ++nn) {
                const int nj = nj0 + nn;
                f32x4 akk = {0.f, 0.f, 0.f, 0.f}, aqk = {0.f, 0.f, 0.f, 0.f};
#pragma unroll
                for (int s_ = 0; s_ < 4; ++s_) { const bf16x8 kb = *(const bf16x8*)(lds + P2_KB + (16 * nj + cl) * ROWB + (32 * s_ + 8 * g) * 2);
                    akk = __builtin_amdgcn_mfma_f32_16x16x32_bf16(ka[s_], kb, akk, 0, 0, 0); aqk = __builtin_amdgcn_mfma_f32_16x16x32_bf16(qa[s_], kb, aqk, 0, 0, 0); }
                const int j = 16 * nj + cl; const float Gj = GS[j];
                float lt[4];
                const int jpos = (j & ~31) + perm_pos(j & 31);
#pragma unroll
                for (int x_ = 0; x_ < 4; ++x_) { const int i = 16 * mi + 4 * g + x_; const float dec = __expf(fminf(GS[i] - Gj, 0.f));
                    lt[x_] = (i > j) ? GS[128 + i] * akk[x_] * dec : 0.f;
                    const float a = (i >= j) ? aqk[x_] * dec : 0.f;
                    B.AQK[((size_t)item * 64 + i) * 64 + jpos] = (bf16_t)(pkbf(a, 0.f) & 0xffffu); }
                *(float4*)(LT + j * 64 + 16 * mi + 4 * g) = make_float4(lt[0], lt[1], lt[2], lt[3]);
            }
        }
        __syncthreads();
        if (tid < 256) {
            const float* src = (tid < 128) ? (RU + tid) : (RW + (tid - 128));
            typedef __attribute__((address_space(3))) float lds_f32;
            const lds_f32* LTp = (const lds_f32*)(LT); asm volatile("" : "+v"(LTp));
            float acc[64];
#pragma unroll
            for (int i = 0; i < 64; ++i) acc[i] = src[i * 128];
#pragma unroll
            for (int j = 0; j < 63; ++j) {
                const float xj = acc[j];
#pragma unroll
                for (int q = (j + 1) >> 2; q < 16; ++q) {
                    const f32x4 l4 = *(const __attribute__((address_space(3))) f32x4*)(LTp + j * 64 + 4 * q);
                    if (4 * q + 0 > j) acc[4 * q + 0] -= l4.x * xj;
                    if (4 * q + 1 > j) acc[4 * q + 1] -= l4.y * xj;
                    if (4 * q + 2 > j) acc[4 * q + 2] -= l4.z * xj;
                    if (4 * q + 3 > j) acc[4 * q + 3] -= l4.w * xj;
                }
            }
            if (tid < 128) {
                u32x4* dst = (u32x4*)(B.UT + ((size_t)item * 128 + tid) * 64);
#pragma unroll
                for (int q = 0; q < 8; ++q) { u32x4 w; w.x = pkbf(acc[8 * q], acc[8 * q + 1]); w.y = pkbf(acc[8 * q + 2], acc[8 * q + 3]); w.z = pkbf(acc[8 * q + 4], acc[8 * q + 5]); w.w = pkbf(acc[8 * q + 6], acc[8 * q + 7]); dst[q] = w; }
            } else {
                const int dk = tid - 128, pos = (dk & ~31) + perm_pos(dk & 31);
                bf16_t* dst = B.WN + (size_t)item * 64 * 128 + pos;
#pragma unroll
                for (int i = 0; i < 64; ++i) dst[i * 128] = (bf16_t)(pkbf(-acc[i], 0.f) & 0xffffu);
            }
        } else if (tid < 384) {
            const int dk = tid - 256;
            u32x4* dst = (u32x4*)(B.KDT + ((size_t)item * 128 + dk) * 64);
#pragma unroll
            for (int q = 0; q < 8; ++q) { float v[8];
#pragma unroll
                for (int e = 0; e < 8; ++e) { const int p_ = 8 * q + e, i = (p_ & ~31) + perm_inv(p_ & 31); v[e] = bf2f(*(const bf16_t*)(lds + P2_KB + i * ROWB + 2 * dk)) * GS[192 + i]; }
                u32x4 w; w.x = pkbf(v[0], v[1]); w.y = pkbf(v[2], v[3]); w.z = pkbf(v[4], v[5]); w.w = pkbf(v[6], v[7]); dst[q] = w; }
        }
        if (tid >= 256) hook(item, wave - 4, lane);
        __syncthreads();
    }
#undef DN_PREP_LOAD
}

constexpr int SROW = 288, SKROW = 160;
constexpr int SC_WN = 0, SC_QD = 64 * SROW, SC_KDT = 128 * SROW, SC_AQK = SC_KDT + 128 * SKROW, SC_BUF = SC_AQK + 64 * SKROW  , SC_OT = 2048;
__device__ __forceinline__ void scan(unsigned char* lds, int tid, int bid, int G, const DnBufs B, bf16_t* ymix, unsigned* flags) {
    const int lane = tid & 63, wave = __builtin_amdgcn_readfirstlane(tid >> 6), g = lane >> 4, cl = lane & 15;
#define DN_BAR() do { asm volatile("s_waitcnt lgkmcnt(0)" ::: "memory"); __builtin_amdgcn_s_barrier(); asm volatile("" ::: "memory"); } while (0)
    for (int unit = bid; unit < 2 * BATCH * NH; unit += G) {
        const int bh = (unit & 7) | ((unit >> 4) << 3), uhalf = (unit >> 3) & 1;
        __syncthreads();
        if (wave < 4) {
            const int wdv = 4 * uhalf + wave, dv = 16 * wdv + cl;
            f32x4 S[8]; bf16x8 Sb[4];
#pragma unroll
            for (int r = 0; r < 8; ++r) S[r] = (f32x4){0.f, 0.f, 0.f, 0.f};
#pragma unroll
            for (int s_ = 0; s_ < 4; ++s_) Sb[s_] = (bf16x8){0, 0, 0, 0, 0, 0, 0, 0};
            const float eglv = __expf(B.GL[bh * 32 + (lane & 31)]);
            u32x2 uA[4], uB[4];
            f32x4 vn[4];
#define DN_LOAD_U(upre, c_) do { const size_t it_ = (size_t)(bh * 32 + (c_)); \
            _Pragma("unroll") for (int m_ = 0; m_ < 4; ++m_) upre[m_] = *(const u32x2*)(B.UT + (it_ * 128 + dv) * 64 + 16 * m_ + 4 * g); } while (0)
#define DN_VN(upre) do { _Pragma("unroll") for (int m = 0; m < 4; ++m) vn[m] = (f32x4){lo_f(upre[m].x), hi_f(upre[m].x), lo_f(upre[m].y), hi_f(upre[m].y)}; } while (0)
#define DN_SB() __builtin_amdgcn_sched_barrier(0)
#define DN_LDW(f, off_, m0_) do { _Pragma("unroll") for (int m = 0; m < 2; ++m) _Pragma("unroll") for (int s_ = 0; s_ < 4; ++s_) f[m * 4 + s_] = *(const bf16x8*)(buf + (off_) + (16 * ((m0_) + m) + cl) * SROW + (32 * s_ + 8 * g) * 2); } while (0)
#define DN_LDK(f, off_, r0_) do { _Pragma("unroll") for (int r = 0; r < 4; ++r) _Pragma("unroll") for (int s_ = 0; s_ < 2; ++s_) f[r * 2 + s_] = *(const bf16x8*)(buf + (off_) + (16 * ((r0_) + r) + cl) * SKROW + (32 * s_ + 8 * g) * 2); } while (0)
#define DN_MMW(acc, m0_, f) do { _Pragma("unroll") for (int s_ = 0; s_ < 4; ++s_) _Pragma("unroll") for (int m = 0; m < 2; ++m) acc[(m0_) + m] = __builtin_amdgcn_mfma_f32_16x16x32_bf16(f[m * 4 + s_], Sb[s_], acc[(m0_) + m], 0, 0, 0); } while (0)
#define DN_MMK(acc, r0_, f) do { _Pragma("unroll") for (int s_ = 0; s_ < 2; ++s_) _Pragma("unroll") for (int r = 0; r < 4; ++r) acc[(r0_) + r] = __builtin_amdgcn_mfma_f32_16x16x32_bf16(f[r * 2 + s_], Vb[s_], acc[(r0_) + r], 0, 0, 0); } while (0)
#define DN_CHUNK(bufoff_, c_) do { \
            const unsigned char* buf = lds + (bufoff_); const int item = bh * 32 + (c_); \
            const float egl = __shfl(eglv, (c_)); \
            f32x4 o[4]; \
            _Pragma("unroll") for (int m = 0; m < 4; ++m) o[m] = (f32x4){0.f, 0.f, 0.f, 0.f}; \
            bf16x8 fA[8], fB[8]; \
            DN_LDW(fA, SC_WN, 0); DN_LDW(fB, SC_WN, 2); DN_SB(); \
            DN_MMW(vn, 0, fA); DN_SB(); DN_LDW(fA, SC_QD, 0); DN_SB(); \
            DN_MMW(vn, 2, fB); DN_SB(); DN_LDW(fB, SC_QD, 2); DN_SB(); \
            bf16x8 Vb[2]; \
            _Pragma("unroll") for (int s_ = 0; s_ < 2; ++s_) { u32x4 w; w.x = pkbf(vn[2 * s_][0], vn[2 * s_][1]); w.y = pkbf(vn[2 * s_][2], vn[2 * s_][3]); w.z = pkbf(vn[2 * s_ + 1][0], vn[2 * s_ + 1][1]); w.w = pkbf(vn[2 * s_ + 1][2], vn[2 * s_ + 1][3]); \
                Vb[s_] = __builtin_bit_cast(bf16x8, w); } \
            DN_MMW(o, 0, fA); DN_SB(); DN_LDK(fA, SC_KDT, 0); DN_SB(); \
            DN_MMW(o, 2, fB); DN_SB(); DN_LDK(fB, SC_KDT, 4); DN_SB(); \
            _Pragma("unroll") for (int r = 0; r < 8; ++r) S[r] = S[r] * egl; \
            DN_MMK(S, 0, fA); DN_SB(); DN_LDK(fA, SC_AQK, 0); DN_SB(); \
            DN_MMK(S, 4, fB); DN_SB(); \
            DN_MMK(o, 0, fA); DN_SB(); \
            _Pragma("unroll") for (int s_ = 0; s_ < 4; ++s_) { u32x4 w; w.x = pkbf(S[2 * s_][0], S[2 * s_][1]); w.y = pkbf(S[2 * s_][2], S[2 * s_][3]); w.z = pkbf(S[2 * s_ + 1][0], S[2 * s_ + 1][1]); w.w = pkbf(S[2 * s_ + 1][2], S[2 * s_ + 1][3]); \
                Sb[s_] = __builtin_bit_cast(bf16x8, w); } \
            { unsigned char* sc_ = lds + 2 * SC_BUF + wave * SC_OT; \
              _Pragma("unroll") for (int m = 0; m < 4; ++m) _Pragma("unroll") for (int x_ = 0; x_ < 4; ++x_) *(bf16_t*)(sc_ + (m * 4 + x_) * 128 + 2 * lane) = (bf16_t)(pkbf(o[m][x_], 0.f) & 0xffffu); \
              if ((c_) < 30) asm volatile("s_waitcnt vmcnt(11)" ::: "memory");     \
              else asm volatile("s_waitcnt vmcnt(3)" ::: "memory");                \
              if ((c_) > 1 && lane == 0) __hip_atomic_fetch_add(flagp + ((c_) - 2) * 32, 1u, __ATOMIC_RELAXED, __HIP_MEMORY_SCOPE_AGENT); \
              _Pragma("unroll") for (int q_ = 0; q_ < 2; ++q_) { \
                  const u32x4 w_ = *(const u32x4*)(sc_ + q_ * 1024 + lane * 16); \
                  const bf16_t* p_ = B.UT + ((size_t)item * 128 + 16 * wdv) * 64 + q_ * 512 + lane * 8; \
                  asm volatile("global_store_dwordx4 %0, %1, off sc1" :: "v"(p_), "v"(w_) : "memory"); } } \
        } while (0)
            unsigned* flagp = flags + (size_t)(bh >> 2) * 32 * 32;
            DN_LOAD_U(uA, 0); DN_LOAD_U(uB, 1);
            DN_BAR();
            for (int c = 0; c < SEQ / 64; c += 2) {
                DN_VN(uA); if (c + 2 < SEQ / 64) DN_LOAD_U(uA, c + 2);
                DN_CHUNK(0, c);
                DN_BAR();
                DN_VN(uB); if (c + 3 < SEQ / 64) DN_LOAD_U(uB, c + 3);
                DN_CHUNK(SC_BUF, c + 1);
                DN_BAR();
            }
            asm volatile("s_waitcnt vmcnt(0)" ::: "memory");
            if (lane == 0) { __hip_atomic_fetch_add(flagp + (SEQ / 64 - 2) * 32, 1u, __ATOMIC_RELAXED, __HIP_MEMORY_SCOPE_AGENT); __hip_atomic_fetch_add(flagp + (SEQ / 64 - 1) * 32, 1u, __ATOMIC_RELAXED, __HIP_MEMORY_SCOPE_AGENT); }
#undef DN_LOAD_U
#undef DN_VN
#undef DN_SB
#undef DN_LDW
#undef DN_LDK
#undef DN_MMW
#undef DN_MMK
#undef DN_CHUNK
        } else {
            const int lt = tid - 256;
            const int o_w = (lt >> 4) * SROW + (lt & 15) * 16, o_k = (lt >> 3) * SKROW + (lt & 7) * 16;
            u32x4 p0[14], p1[14], p2[14];
#define DN_LOADP(pre, c_) do { const size_t it_ = (size_t)(bh * 32 + (c_)); \
            _Pragma("unroll") for (int q = 0; q < 4; ++q) { pre[q] = *(const u32x4*)(B.WN + it_ * 8192 + (size_t)(lt + 256 * q) * 8); pre[4 + q] = *(const u32x4*)(B.QD + it_ * 8192 + (size_t)(lt + 256 * q) * 8); \
                pre[8 + q] = *(const u32x4*)(B.KDT + it_ * 8192 + (size_t)(lt + 256 * q) * 8); } \
            _Pragma("unroll") for (int q = 0; q < 2; ++q) pre[12 + q] = *(const u32x4*)(B.AQK + it_ * 4096 + (size_t)(lt + 256 * q) * 8); } while (0)
#define DN_WRITEP(pre, bufoff_) do { unsigned char* d_ = lds + (bufoff_); \
            _Pragma("unroll") for (int q = 0; q < 4; ++q) { *(u32x4*)(d_ + SC_WN + o_w + q * 16 * SROW) = pre[q]; *(u32x4*)(d_ + SC_QD + o_w + q * 16 * SROW) = pre[4 + q]; *(u32x4*)(d_ + SC_KDT + o_k + q * 32 * SKROW) = pre[8 + q]; } \
            _Pragma("unroll") for (int q = 0; q < 2; ++q) *(u32x4*)(d_ + SC_AQK + o_k + q * 32 * SKROW) = pre[12 + q]; } while (0)
            DN_LOADP(p0, 0); DN_LOADP(p1, 1); DN_LOADP(p2, 2);
            DN_WRITEP(p0, 0);
            DN_BAR();
            DN_LOADP(p0, 3);
#define DN_STEP(j_, set_, bufoff_) do { const int cc_ = c + (j_); if (cc_ < SEQ / 64) { if (cc_ + 1 < SEQ / 64) DN_WRITEP(set_, bufoff_); DN_BAR(); if (cc_ + 4 < SEQ / 64) DN_LOADP(set_, cc_ + 4); } } while (0)
            for (int c = 0; c < SEQ / 64; c += 6) {
                DN_STEP(0, p1, SC_BUF); DN_STEP(1, p2, 0); DN_STEP(2, p0, SC_BUF); DN_STEP(3, p1, 0); DN_STEP(4, p2, SC_BUF); DN_STEP(5, p0, 0);
            }
#undef DN_STEP
#undef DN_LOADP
#undef DN_WRITEP
        }
        __syncthreads();
    }
#undef DN_BAR
}
}

__device__ __forceinline__ void transpose_item(const float* W, int ldw, int k0, int n0, bf16_t* WT, int ldk, int dst_row0, float* scr_f, int lane) {
    unsigned* scr = (unsigned*)scr_f;
    const int c4 = (lane & 7) * 4, rq = lane >> 3;
    float4 lo[4], hi[4];
#pragma unroll
    for (int i = 0; i < 4; ++i) { const float* src = W + (size_t)(k0 + 2 * (rq + 8 * i)) * ldw + n0 + c4; lo[i] = *(const float4*)src; hi[i] = *(const float4*)(src + ldw); }
#pragma unroll
    for (int i = 0; i < 4; ++i) { const int kp = rq + 8 * i; unsigned* d = scr + c4 * 36 + kp;
        d[0] = dn::pkbf(lo[i].x, hi[i].x); d[36] = dn::pkbf(lo[i].y, hi[i].y); d[72] = dn::pkbf(lo[i].z, hi[i].z); d[108] = dn::pkbf(lo[i].w, hi[i].w); }
    asm volatile("s_waitcnt lgkmcnt(0)" ::: "memory");
#pragma unroll
    for (int j = 0; j < 4; ++j) { const int n = rq + 8 * j; const uint4 o = *(const uint4*)(scr + n * 36 + 4 * (lane & 7));
        *(uint4*)(WT + (size_t)(dst_row0 + n) * ldk + k0 + 8 * (lane & 7)) = o; }
    asm volatile("s_waitcnt lgkmcnt(0)" ::: "memory");
}

constexpr int CV_IG = NE * 16 * 16, CV_ID = NE * 8 * 32, CV_PREP = 10;
__device__ __forceinline__ void conv_item(int r, const float* w_gate, const float* w_up, const float* w_down, bf16_t* wgu_t, bf16_t* wd_t, float* scr, int lane) {
    if (r < 2 * CV_IG) { const int up = r >= CV_IG; if (up) r -= CV_IG; const int e = r >> 8, kb = (r >> 4) & 15, nb = r & 15, n0 = nb * 32;
        transpose_item((up ? w_up : w_gate) + (size_t)e * DM * FF, FF, kb * 64, n0, wgu_t + (size_t)e * DM * DM, DM, (n0 >> 7) * 256 + (n0 & 127) + (up ? 128 : 0), scr, lane); return; }
    r -= 2 * CV_IG;
    { const int e = r >> 8, kb = (r >> 5) & 7, nb = r & 31; transpose_item(w_down + (size_t)e * FF * DM, DM, kb * 64, nb * 32, wd_t + (size_t)e * DM * FF, FF, nb * 32, scr, lane); }
}

#define XB_TMO      128
#define XB_XCNT(j)  (256  + 64 * (j))
#define XB_XSUB(j)  (1280 + 64 * (j))
#define XB_XGEN(j)  (2304 + 64 * (j))
#define XB_TOP      3328
#define XB_TOPGEN   3392
#define XCD_BAR_WORDS 3456
#define XB_SPIN_CAP (1u << 18)
#define XLAS __attribute__((address_space(3)))
__device__ __forceinline__ unsigned xb_ld(unsigned* p)              { return __hip_atomic_load(p, __ATOMIC_RELAXED, __HIP_MEMORY_SCOPE_AGENT); }
__device__ __forceinline__ unsigned xb_add(unsigned* p, unsigned v) { return __hip_atomic_fetch_add(p, v, __ATOMIC_RELAXED, __HIP_MEMORY_SCOPE_AGENT); }
__device__ __forceinline__ unsigned xb_xcc_id() { return (unsigned)__builtin_amdgcn_s_getreg((3 << 11) | 20) & 0xFu; }
#define XB_SPIN(cond, bar) do { unsigned _sp = 0; while (cond) { if (_sp < 32u) __builtin_amdgcn_s_sleep(1); else __builtin_amdgcn_s_sleep(24); \
    if ((++_sp & 255u) == 0u) { if (xb_ld(&(bar)[XB_TMO])) break; if (_sp > XB_SPIN_CAP) { atomicAdd(&(bar)[XB_TMO], 1u); break; } } } } while (0)
struct XcdBarrier { unsigned* bar; unsigned x; volatile XLAS unsigned* st; };
__device__ __forceinline__ XcdBarrier xcd_barrier_post(unsigned* bar, volatile XLAS unsigned* st) {
    XcdBarrier b; b.bar = bar; b.x = xb_xcc_id(); b.st = st;
    if (threadIdx.x == 0) (void)xb_add(&bar[XB_XCNT(b.x)], 1u);
    return b;
}
__device__ __forceinline__ void xcd_barrier_complete(unsigned* bar, unsigned x, unsigned& nloc, unsigned& nx) {
    const unsigned G = gridDim.x * gridDim.y * gridDim.z;
    unsigned sum, cnt, mine, sp = 0u;
    for (;;) {
        sum = 0u; cnt = 0u; mine = 0u;
#pragma unroll
        for (unsigned j = 0; j < 16; ++j) { const unsigned c = xb_ld(&bar[XB_XCNT(j)]); sum += c; cnt += (c > 0u) ? 1u : 0u; mine = (j == x) ? c : mine; }
        if (sum == G) break;
        __builtin_amdgcn_s_sleep(1);
        if ((++sp & 255u) == 0u) { if (xb_ld(&bar[XB_TMO])) break; if (sp > XB_SPIN_CAP) { atomicAdd(&bar[XB_TMO], 1u); break; } }
    }
    nloc = mine > 0u ? mine : 1u; nx = cnt > 0u ? cnt : 1u;
}
__device__ __forceinline__ void xcd_barrier(const XcdBarrier& b) {
    asm volatile("s_waitcnt vmcnt(0)" ::: "memory");
    __syncthreads();
    if (threadIdx.x == 0) {
        unsigned* bar = b.bar;
        __builtin_amdgcn_s_waitcnt(0);
        unsigned nloc = b.st[0], nx = b.st[1];
        if (nloc == 0u) { xcd_barrier_complete(bar, b.x, nloc, nx); b.st[0] = nloc; b.st[1] = nx; }
        const unsigned old = xb_add(&bar[XB_XSUB(b.x)], 1u);
        const unsigned gen = old / nloc;
        if (old + 1u == (gen + 1u) * nloc) {
            __builtin_amdgcn_fence(__ATOMIC_RELEASE, "agent");
            asm volatile("s_waitcnt vmcnt(0)" ::: "memory");
            const unsigned og = xb_add(&bar[XB_TOP], 1u);
            const unsigned tg = og / nx;
            if (og + 1u == (tg + 1u) * nx) xb_add(&bar[XB_TOPGEN], 1u);
            else XB_SPIN(xb_ld(&bar[XB_TOPGEN]) == tg, bar);
            __builtin_amdgcn_fence(__ATOMIC_ACQUIRE, "agent");
            xb_add(&bar[XB_XGEN(b.x)], 1u);
            asm volatile("s_waitcnt vmcnt(0)" ::: "memory");
        } else {
            XB_SPIN(xb_ld(&bar[XB_XGEN(b.x)]) == gen, bar);
            __builtin_amdgcn_fence(__ATOMIC_ACQUIRE, "agent");
            asm volatile("s_waitcnt vmcnt(0)" ::: "memory");
        }
    }
    __syncthreads();
}

__global__ void __launch_bounds__(NT, 2) fwd_kernel(Params p) {
    extern __shared__ __attribute__((aligned(16))) unsigned char lds_raw[];
    float* lds = (float*)lds_raw;
    int tid = threadIdx.x, lane = tid & 63, wave = tid >> 6;
    const int G = gridDim.x, bid = blockIdx.x;
    int gw = bid * 8 + wave; const int NGW = G * 8;
#define FRESH() do { tid = threadIdx.x; asm volatile("" : "+v"(tid)); lane = tid & 63; wave = tid >> 6; gw = bid * 8 + wave; } while (0)
#define GRID_SYNC() do { \
        const __attribute__((address_space(4))) Params* Pb_ = (const __attribute__((address_space(4))) Params*)__builtin_amdgcn_kernarg_segment_ptr(); asm volatile("" : "+s"(Pb_)); \
        XcdBarrier xb_; xb_.bar = (unsigned*)(Pb_->ws + WS_BAR); xb_.x = xb_xcc_id(); xb_.st = (volatile XLAS unsigned*)((XLAS unsigned char*)lds_raw + LDS_BYTES - 64); xcd_barrier(xb_); } while (0)
#define SEAM() } GRID_SYNC(); FRESH(); { LOADP();

#define LOADP() \
    const __attribute__((address_space(4))) Params* P_ = (const __attribute__((address_space(4))) Params*)__builtin_amdgcn_kernarg_segment_ptr(); asm volatile("" : "+s"(P_)); \
    const float* x = P_->in[0]; const float* mix_g = P_->in[1]; const float* w_in = P_->in[2]; const float* conv_a_w = P_->in[3]; \
    const float* conv_a_g = P_->in[4]; const float* dn_conv_w = P_->in[5]; const float* dn_a_log = P_->in[6]; const float* dn_dt_bias = P_->in[7]; \
    const float* dn_norm_g = P_->in[8]; const float* w_out = P_->in[9]; const float* ffn_g = P_->in[10]; const float* r_group_w = P_->in[11]; \
    const float* r_exp_w = P_->in[12]; const float* w_gate = P_->in[13]; const float* w_up = P_->in[14]; const float* w_down = P_->in[15]; \
    const float* final_g = P_->in[16]; unsigned char* ws = P_->ws; float* outp = P_->out; \
    int* cnt = (int*)(ws + WS_CTL); float* rstd2 = (float*)(ws + WS_RSTD2); \
    int* tok_e = (int*)(ws + WS_TOKE); float* tok_g = (float*)(ws + WS_TOKG); int* tok_p = (int*)(ws + WS_TOKP); int* slot_tok = (int*)(ws + WS_SLOTTOK); \
    float* bg = (float*)(ws + WS_BG); bf16_t* win_t = (bf16_t*)(ws + WS_WIN); bf16_t* wout_t = (bf16_t*)(ws + WS_WOUT); \
    bf16_t* proj = (bf16_t*)(ws + WS_PROJ); bf16_t* hb = (bf16_t*)(ws + WS_HB); bf16_t* ymix = (bf16_t*)(ws + WS_YMIX); \
    bf16_t* act = (bf16_t*)(ws + WS_ACT); bf16_t* yexp = (bf16_t*)(ws + WS_YEXP); bf16_t* h2b = (bf16_t*)(ws + WS_H2B); \
    bf16_t* wgu_t = (bf16_t*)(ws + WS_WGU); bf16_t* wd_t = (bf16_t*)(ws + WS_WD); float* x1 = outp; \
    dn::DnBufs DB{(bf16_t*)outp, (bf16_t*)outp + (size_t)8 * 1024 * 1024, (bf16_t*)outp + (size_t)16 * 1024 * 1024, (bf16_t*)outp + (size_t)24 * 1024 * 1024, (bf16_t*)(ws + WS_AQK), (float*)(ws + WS_GL)}; \
    (void)x; (void)mix_g; (void)w_in; (void)conv_a_w; (void)conv_a_g; (void)dn_conv_w; (void)dn_a_log; (void)dn_dt_bias; (void)dn_norm_g; (void)w_out; (void)ffn_g; (void)r_group_w; (void)r_exp_w; \
    (void)w_gate; (void)w_up; (void)w_down; (void)final_g; (void)cnt; (void)rstd2; (void)tok_e; (void)tok_g; (void)tok_p; (void)slot_tok; (void)bg; (void)win_t; (void)wout_t; (void)proj; (void)hb; (void)ymix; \
    (void)act; (void)yexp; (void)h2b; (void)wgu_t; (void)wd_t; (void)x1; (void)DB
    {
        volatile XLAS unsigned* xst_ = (volatile XLAS unsigned*)((XLAS unsigned char*)lds_raw + LDS_BYTES - 64);
        if (tid == 0) { xst_[0] = 0u; xst_[1] = 0u; }
        __syncthreads();
        (void)xcd_barrier_post((unsigned*)(p.ws + WS_BAR), xst_);
    }
#define MIXA_ROWS(first_, stride_) do { typedef unsigned u32x4_t __attribute__((ext_vector_type(4))); const int c0 = lane * 8; \
        for (int r0_ = (first_); r0_ < NTOK; r0_ += 2 * (stride_)) { \
            u32x4_t ahv[2][3], acv[2][3], abv[2]; float mk[2][3]; int rr_[2]; \
            _Pragma("unroll") for (int t = 0; t < 2; ++t) { const int r = (r0_ + t * (stride_) < NTOK) ? r0_ + t * (stride_) : r0_; rr_[t] = r; const int sq = r % SEQ; const bf16_t* pr = proj + (size_t)r * NPB; \
                _Pragma("unroll") for (int j = 0; j < 3; ++j) { const bool ok = sq + j - 2 >= 0; const bf16_t* pj = pr + (ok ? (ptrdiff_t)(j - 2) * NPB : 0); mk[t][j] = ok ? 1.f : 0.f; \
                    ahv[t][j] = *(const u32x4_t*)(pj + C_AH + c0); acv[t][j] = *(const u32x4_t*)(pj + C_AC + c0); } \
                abv[t] = *(const u32x4_t*)(pr + C_AB + c0); } \
            _Pragma("unroll") for (int t = 0; t < 2; ++t) { if (t == 1 && r0_ + (stride_) >= NTOK) break; const int r = rr_[t]; \
                float conv[8]; _Pragma("unroll") for (int i = 0; i < 8; ++i) conv[i] = 0.f; \
                _Pragma("unroll") for (int j = 0; j < 3; ++j) { const u32x4_t ah = ahv[t][j], ac = acv[t][j]; const float m_ = mk[t][j]; \
                    float4 w0 = *(const float4*)(conv_a_w + j * 512 + c0), w1 = *(const float4*)(conv_a_w + j * 512 + c0 + 4); \
                    w0.x *= m_; w0.y *= m_; w0.z *= m_; w0.w *= m_; w1.x *= m_; w1.y *= m_; w1.z *= m_; w1.w *= m_; \
                    conv[0] += dn::lo_f(ah.x) * dn::lo_f(ac.x) * w0.x; conv[1] += dn::hi_f(ah.x) * dn::hi_f(ac.x) * w0.y; conv[2] += dn::lo_f(ah.y) * dn::lo_f(ac.y) * w0.z; conv[3] += dn::hi_f(ah.y) * dn::hi_f(ac.y) * w0.w; \
                    conv[4] += dn::lo_f(ah.z) * dn::lo_f(ac.z) * w1.x; conv[5] += dn::hi_f(ah.z) * dn::hi_f(ac.z) * w1.y; conv[6] += dn::lo_f(ah.w) * dn::lo_f(ac.w) * w1.z; conv[7] += dn::hi_f(ah.w) * dn::hi_f(ac.w) * w1.w; } \
                const u32x4_t ab = abv[t]; \
                float yv[8] = {dn::lo_f(ab.x) * conv[0], dn::hi_f(ab.x) * conv[1], dn::lo_f(ab.y) * conv[2], dn::hi_f(ab.y) * conv[3], dn::lo_f(ab.z) * conv[4], dn::hi_f(ab.z) * conv[5], dn::lo_f(ab.w) * conv[6], dn::hi_f(ab.w) * conv[7]}; \
                float ss = 0.f; _Pragma("unroll") for (int i = 0; i < 8; ++i) ss += yv[i] * yv[i]; \
                ss += __shfl_xor(ss, 1); ss += __shfl_xor(ss, 2); ss += __shfl_xor(ss, 4); \
                const float rs = rsqrtf(ss * (1.f / 64.f) + EPS); \
                const float4 g0 = *(const float4*)(conv_a_g + c0), g1 = *(const float4*)(conv_a_g + c0 + 4); \
                u32x4_t w; w.x = dn::pkbf(yv[0] * rs * g0.x, yv[1] * rs * g0.y); w.y = dn::pkbf(yv[2] * rs * g0.z, yv[3] * rs * g0.w); w.z = dn::pkbf(yv[4] * rs * g1.x, yv[5] * rs * g1.y); w.w = dn::pkbf(yv[6] * rs * g1.z, yv[7] * rs * g1.w); \
                *(u32x4_t*)(ymix + (size_t)r * DM + c0) = w; } } } while (0)
    int* Loff = (int*)(lds_raw + LDS_TAB);
    int* Ltile = Loff + 64;
    int* Lend = Loff + 128;
    int* LsmE = Loff + 192;
    {
    LOADP();
    REP(0) {
    {
        float* scr = lds + wave * (64 * 33);
        constexpr int I_IN = (DM / 64) * (NPB / 32), I_OUT = (DM / 64) * (DM / 32);
        constexpr int I_G = NE * 16 * 16, I_D = NE * 8 * 32;
        for (int it = gw; it < I_IN + I_OUT; it += NGW) {
            int r = it;
            if (r < I_IN) { const int kb = r / (NPB / 32), nb = r % (NPB / 32); transpose_item(w_in, NPROJ, kb * 64, nb * 32, win_t, DM, nb * 32, scr, lane); continue; } r -= I_IN;
            { const int kb = r / (DM / 32), nb = r % (DM / 32); transpose_item(w_out, DM, kb * 64, nb * 32, wout_t, DM, nb * 32, scr, lane); }
        }
        float wx[4][4][8];
#pragma unroll
        for (int j = 0; j < 4; ++j)
#pragma unroll
            for (int i = 0; i < 4; ++i) { const float* wr_ = w_in + (size_t)(4 * lane + 256 * j + i) * NPROJ + NPB; const float4 w0 = *(const float4*)wr_, w1 = *(const float4*)(wr_ + 4);
                wx[j][i][0] = w0.x; wx[j][i][1] = w0.y; wx[j][i][2] = w0.z; wx[j][i][3] = w0.w; wx[j][i][4] = w1.x; wx[j][i][5] = w1.y; wx[j][i][6] = w1.z; wx[j][i][7] = w1.w; }
        const int hsel = (lane >> 3) & 3; const bool is_alpha = lane >= 32;
        const float aneg = -expf(dn_a_log[hsel]), dtb = dn_dt_bias[hsel];
        float4 vnx[4];
        if (gw < NTOK) {
#pragma unroll
            for (int j = 0; j < 4; ++j) vnx[j] = ((const float4*)(x + (size_t)gw * DM) + lane)[64 * j]; }
        for (int r = gw; r < NTOK; r += NGW) {
            float4 v[4]; float s = 0.f;
#pragma unroll
            for (int j = 0; j < 4; ++j) { v[j] = vnx[j]; s += v[j].x * v[j].x + v[j].y * v[j].y + v[j].z * v[j].z + v[j].w * v[j].w; }
            if (r + NGW < NTOK) {
#pragma unroll
                for (int j = 0; j < 4; ++j) vnx[j] = ((const float4*)(x + (size_t)(r + NGW) * DM) + lane)[64 * j]; }
            const float rs = rsqrtf(wave_sum(s) * (1.f / DM) + EPS);
            float dots[8];
#pragma unroll
            for (int c = 0; c < 8; ++c) dots[c] = 0.f;
            unsigned long long* o8 = (unsigned long long*)(hb + (size_t)r * DM) + lane;
#pragma unroll
            for (int j = 0; j < 4; ++j) { const float4 g = ((const float4*)mix_g)[lane + 64 * j];
                v[j].x *= rs * g.x; v[j].y *= rs * g.y; v[j].z *= rs * g.z; v[j].w *= rs * g.w;
                o8[64 * j] = (unsigned long long)pk2(v[j].x, v[j].y) | ((unsigned long long)pk2(v[j].z, v[j].w) << 32);
                const float hv[4] = {v[j].x, v[j].y, v[j].z, v[j].w};
#pragma unroll
                for (int i = 0; i < 4; ++i)
#pragma unroll
                    for (int c = 0; c < 8; ++c) dots[c] += hv[i] * wx[j][i][c]; }
            const float tot = reduce8_tr(dots, lane);
            if ((lane & 7) == 0) bg[(size_t)r * 8 + (lane >> 3)] = is_alpha ? aneg * softplus_f(tot + dtb) : sigmoid_f(tot);
        }
    }
    }
    SEAM()
    REP(1) {
        pg8::Gemm g{hb, DM, nullptr}; pg8::DenseOrder S; S.init(NTOK, NPB, DM, win_t, G, bid);
        pg8::EpiBf16 E{proj, NPB};
        pg8::gemm_phase<pg8::EpiBf16, pg8::DenseOrder, false, true>((PG8_LAS unsigned char*)lds_raw, g, S, E);
    }
    SEAM()
    REP(3) dn::prep(lds_raw, tid, bid, G, proj, bg, dn_conv_w, DB, [&](int item, int w4, int lane_) {
        const __attribute__((address_space(4))) Params* Q_ = (const __attribute__((address_space(4))) Params*)__builtin_amdgcn_kernarg_segment_ptr(); asm volatile("" : "+s"(Q_));
        unsigned char* ws_ = Q_->ws;
        float* scr_ = (float*)(lds_raw + dn::P2_END + w4 * 4608);
        const int s0 = (w4 < 2) ? 2 * w4 : 3 * w4 - 2, ns = (w4 < 2) ? 2 : 3;
        for (int s_ = 0; s_ < ns; ++s_) conv_item(item * CV_PREP + s0 + s_, Q_->in[13], Q_->in[14], Q_->in[15], (bf16_t*)(ws_ + WS_WGU), (bf16_t*)(ws_ + WS_WD), scr_, lane_);
    });
    SEAM()
    REP(4) {
    constexpr int NSU = 2 * BATCH * NH;
    if (bid >= NSU || G <= NSU) {
        float* scr = lds + wave * (64 * 33);
        constexpr int I_G = NE * 16 * 16, I_D = NE * 8 * 32;
        const int nw = (G <= NSU) ? NGW : (G - NSU) * 8, w0 = (G <= NSU) ? gw : gw - NSU * 8;
        for (int it = CV_PREP * (BATCH * NH * (SEQ / 64)) + w0; it < 2 * I_G + I_D; it += nw) conv_item(it, w_gate, w_up, w_down, wgu_t, wd_t, scr, lane);
        if (G > NSU) MIXA_ROWS(w0, nw);
    }
    unsigned* dnflags = (unsigned*)(ws + WS_CTL);
    if (bid < NSU || G <= NSU) dn::scan(lds_raw, tid, bid, G, DB, ymix, dnflags);
    if (bid >= NSU || G <= NSU) {
        typedef unsigned u32x4_t __attribute__((ext_vector_type(4)));
        const int c0 = lane * 8;
        const int nw = (G <= NSU) ? NGW : (G - NSU) * 8, w0 = (G <= NSU) ? gw : gw - NSU * 8;
        if (G <= NSU) MIXA_ROWS(gw, NGW);
        const int wq0 = ((G <= NSU) ? bid : bid - NSU) * 8;
        for (int q0 = wq0; q0 < NTOK / 4; q0 += nw) {
            const int q = q0 + wave;
            const int ch = q >> 7, bb = (q >> 4) & 7, i4 = q & 15;
            const int rbase = bb * SEQ + ch * 64 + i4 * 4;
            u32x4_t ovv[4], zvv[4];
#pragma unroll
            for (int t = 0; t < 4; ++t) zvv[t] = *(const u32x4_t*)(proj + (size_t)(rbase + t) * NPB + C_Z + c0);
            if (wave == 0) {
                unsigned* fl = dnflags + (bb * 32 + ch) * 32;
                for (unsigned spins = 0; spins < (1u << 21); ++spins) {
                    if ((unsigned)__builtin_amdgcn_readfirstlane(__hip_atomic_load(fl, __ATOMIC_RELAXED, __HIP_MEMORY_SCOPE_AGENT)) >= 32u) break;
                    __builtin_amdgcn_s_sleep(32);
                }
                __builtin_amdgcn_fence(__ATOMIC_ACQUIRE, "agent");
                asm volatile("s_waitcnt vmcnt(0)" ::: "memory");
            }
            __syncthreads();
#pragma unroll
            for (int t = 0; t < 4; ++t) {
                const int r = rbase + t;
                const int oi_ = r & 63, oitem_ = ((r / SEQ) * NH + (c0 >> 7)) * (SEQ / 64) + ((r % SEQ) >> 6);
                ovv[t] = *(const u32x4_t*)(DB.UT + ((size_t)oitem_ * 128 + (c0 & 112)) * 64 + (((oi_ >> 4) * 4 + (oi_ & 3)) * 4 + ((oi_ >> 2) & 3)) * 16 + (c0 & 15));
            }
#pragma unroll
            for (int t = 0; t < 4; ++t) {
                const int r = rbase + t;
                const u32x4_t ov = ovv[t], zv = zvv[t];
                float o[8] = {dn::lo_f(ov.x), dn::hi_f(ov.x), dn::lo_f(ov.y), dn::hi_f(ov.y), dn::lo_f(ov.z), dn::hi_f(ov.z), dn::lo_f(ov.w), dn::hi_f(ov.w)};
                const float z[8] = {dn::lo_f(zv.x), dn::hi_f(zv.x), dn::lo_f(zv.y), dn::hi_f(zv.y), dn::lo_f(zv.z), dn::hi_f(zv.z), dn::lo_f(zv.w), dn::hi_f(zv.w)};
                float ss = 0.f;
#pragma unroll
                for (int i = 0; i < 8; ++i) ss += o[i] * o[i];
                ss += __shfl_xor(ss, 1); ss += __shfl_xor(ss, 2); ss += __shfl_xor(ss, 4); ss += __shfl_xor(ss, 8);
                const float rs = rsqrtf(ss * (1.f / 128.f) + EPS);
                const float4 g0 = *(const float4*)(dn_norm_g + (c0 & 127)), g1 = *(const float4*)(dn_norm_g + (c0 & 127) + 4);
                const float gv[8] = {g0.x, g0.y, g0.z, g0.w, g1.x, g1.y, g1.z, g1.w};
#pragma unroll
                for (int i = 0; i < 8; ++i) o[i] = o[i] * rs * gv[i] * dn::silu_fast(z[i]);
                u32x4_t w; w.x = dn::pkbf(o[0], o[1]); w.y = dn::pkbf(o[2], o[3]); w.z = dn::pkbf(o[4], o[5]); w.w = dn::pkbf(o[6], o[7]);
                *(u32x4_t*)(ymix + (size_t)r * DM + 512 + c0) = w;
            }
        }
    }
    }
    SEAM()
    REP(5) {
        pg8::Gemm g{ymix, DM, nullptr}; pg8::DenseOrder S; S.init(NTOK, DM, DM, wout_t, G, bid);
        pg8::EpiResid E{x, x1, DM};
        pg8::gemm_phase<pg8::EpiResid, pg8::DenseOrder, false, false>((PG8_LAS unsigned char*)lds_raw, g, S, E);
    }
    SEAM()
    {
        {
            const float4* src = (const float4*)r_exp_w; float4* dst = (float4*)lds_raw;
            for (int i = tid; i < DM * 8; i += NT) { const int k = i >> 3, sl = i & 7; dst[k * 8 + (sl ^ (k & 7))] = src[i]; }
        }
        float4 wg[16];
#pragma unroll
        for (int j = 0; j < 16; ++j) wg[j] = *(const float4*)(r_group_w + (size_t)(lane + 64 * j) * 4);
        float gf[16];
#pragma unroll
        for (int j = 0; j < 16; ++j) gf[j] = ffn_g[lane + 64 * j];
        int* lcnt = (int*)(lds_raw + LDS_TAB + 2048);
        if (tid < NE) lcnt[tid] = 0;
        __syncthreads();
        float hnx[16];
        if (gw < NTOK) {
#pragma unroll
            for (int j = 0; j < 16; ++j) hnx[j] = x1[(size_t)gw * DM + lane + 64 * j]; }
        for (int r = gw; r < NTOK; r += NGW) {
            float hv[16]; float s = 0.f;
#pragma unroll
            for (int j = 0; j < 16; ++j) { hv[j] = hnx[j]; s += hv[j] * hv[j]; }
            if (r + NGW < NTOK) {
#pragma unroll
                for (int j = 0; j < 16; ++j) hnx[j] = x1[(size_t)(r + NGW) * DM + lane + 64 * j]; }
            const float rs = rsqrtf(wave_sum(s) * (1.f / DM) + EPS);
            float gl4[4] = {0.f, 0.f, 0.f, 0.f};
#pragma unroll
            for (int j = 0; j < 16; ++j) { hv[j] *= rs * gf[j]; h2b[(size_t)r * DM + lane + 64 * j] = (bf16_t)f2bf(hv[j]);
                gl4[0] += hv[j] * wg[j].x; gl4[1] += hv[j] * wg[j].y; gl4[2] += hv[j] * wg[j].z; gl4[3] += hv[j] * wg[j].w; }
            const float gt = reduce4_tr(gl4, lane);
            const float gl[4] = {lane_bcast(gt, 0), lane_bcast(gt, 16), lane_bcast(gt, 32), lane_bcast(gt, 48)};
            int gi = 0; float gm = gl[0];
#pragma unroll
            for (int g = 1; g < 4; ++g) if (gl[g] > gm) { gm = gl[g]; gi = g; }
            float gs = 0.f;
#pragma unroll
            for (int g = 0; g < 4; ++g) gs += expf(gl[g] - gm);
            const float gprob = 1.f / gs;
            float ed[8] = {0.f, 0.f, 0.f, 0.f, 0.f, 0.f, 0.f, 0.f};
#pragma unroll
            for (int j = 0; j < 16; ++j) { const int k = lane + 64 * j; const float4* row = (const float4*)lds_raw + k * 8;
                const float4 w0 = row[(2 * gi) ^ (k & 7)], w1 = row[(2 * gi + 1) ^ (k & 7)];
                ed[0] += hv[j] * w0.x; ed[1] += hv[j] * w0.y; ed[2] += hv[j] * w0.z; ed[3] += hv[j] * w0.w; ed[4] += hv[j] * w1.x; ed[5] += hv[j] * w1.y; ed[6] += hv[j] * w1.z; ed[7] += hv[j] * w1.w; }
            const float et = reduce8_tr(ed, lane);
            float el[8];
#pragma unroll
            for (int e = 0; e < 8; ++e) el[e] = lane_bcast(et, 8 * e);
            int i1 = 0; float m1 = el[0];
#pragma unroll
            for (int e = 1; e < 8; ++e) if (el[e] > m1) { m1 = el[e]; i1 = e; }
            int i2 = -1; float m2 = -INFINITY;
#pragma unroll
            for (int e = 0; e < 8; ++e) if (e != i1 && el[e] > m2) { m2 = el[e]; i2 = e; }
            const float p2 = expf(m2 - m1), inv = 1.f / (1.f + p2);
            if (lane == 0) {
                const int e1 = gi * 8 + i1, e2 = gi * 8 + i2;
                tok_e[2 * r] = e1; tok_e[2 * r + 1] = e2;
                tok_g[2 * r] = gprob * inv; tok_g[2 * r + 1] = gprob * p2 * inv;
                tok_p[2 * r] = atomicAdd(&lcnt[e1], 1); tok_p[2 * r + 1] = atomicAdd(&lcnt[e2], 1);
            }
        }
        __syncthreads();
        if (tid < NE) ((int*)(ws + WS_CNTB))[bid * NE + tid] = lcnt[tid];
    }
    SEAM()
    {
        const int* cntb = (const int*)(ws + WS_CNTB);
        int* red = (int*)(lds_raw + LDS_TAB + 4096);
        int* Lbase = (int*)(lds_raw + LDS_TAB + 2048);
        { const int e = tid & 31, part = tid >> 5; int sall = 0, sbef = 0;
          for (int b_ = part; b_ < G; b_ += 16) { const int v = cntb[b_ * NE + e]; sall += v; sbef += (b_ < bid) ? v : 0; }
          red[part * 32 + e] = sall; red[512 + part * 32 + e] = sbef; }
        __syncthreads();
        if (tid < NE) { int a = 0, b_ = 0; for (int q = 0; q < 16; ++q) { a += red[q * 32 + tid]; b_ += red[512 + q * 32 + tid]; } red[1024 + tid] = a; Lbase[tid] = b_; }
        __syncthreads();
        if (tid == 0) { int o = 0, tl = 0, ns = 0;
            for (int e = 0; e < NE; ++e) { Loff[e] = o; Ltile[e] = tl; const int c = red[1024 + e], full = c >> 8, rem = c & 255;
                if (rem > 128 || rem == 0) { tl += full + (rem ? 1 : 0); Lend[e] = o + c; }
                else { tl += full; Lend[e] = o + 256 * full; LsmE[ns++] = e; }
                o += c; }
            Loff[NE] = o; Ltile[NE] = tl; LsmE[63] = ns; }
        __syncthreads();
        for (int q = tid; q < 16 * (NTOK / (8 * G) + 1); q += NT) {
            const int w = (q >> 1) & 7, k = q >> 4, r = bid * 8 + w + NGW * k, i = 2 * r + (q & 1);
            if (r < NTOK) { const int e = tok_e[i]; const int sl = Loff[e] + Lbase[e] + tok_p[i]; slot_tok[sl] = r; tok_p[i] = sl; }
        }
    }
    SEAM()
    REP(7) {
        pg8::Gemm g{h2b, DM, slot_tok};
        pg8::GroupedOrder S{Loff, Ltile, Lend, LsmE, Ltile[NE] * 4, (Ltile[NE] + LsmE[63]) * 4, G, bid, (const char*)wgu_t, (size_t)DM * DM * 2, (size_t)256 * DM * 2};
        pg8::EpiAct E{act};
        pg8::gemm_phase<pg8::EpiAct, pg8::GroupedOrder, true, true>((PG8_LAS unsigned char*)lds_raw, g, S, E);
    }
    SEAM()
    REP(8) {
        pg8::Gemm g{act, FF, nullptr};
        pg8::GroupedOrder S{Loff, Ltile, Lend, LsmE, Ltile[NE] * 4, (Ltile[NE] + LsmE[63]) * 4, G, bid, (const char*)wd_t, (size_t)DM * FF * 2, (size_t)256 * FF * 2};
        pg8::EpiBf16 E{yexp, DM};
        pg8::gemm_phase<pg8::EpiBf16, pg8::GroupedOrder, false, true>((PG8_LAS unsigned char*)lds_raw, g, S, E);
    }
    SEAM()
    {
        const int nmine = (NTOK - gw + NGW - 1) / NGW;
        const float4* fg = (const float4*)final_g + lane;
        float4 gfin[4];
#pragma unroll
        for (int j = 0; j < 4; ++j) gfin[j] = fg[64 * j];
        for (int k0 = 0; k0 < nmine; k0 += 16) {
            const int kk = k0 + (lane & 15), rr = gw + NGW * (kk < nmine ? kk : k0);
            const int2 sv = *(const int2*)(tok_p + 2 * rr); const float2 gv = *(const float2*)(tok_g + 2 * rr);
            for (int k = k0; k < nmine && k < k0 + 16; k += 4) {
                int rT[4]; bool has[4]; int s0[4], s1[4]; float g0[4], g1[4];
#pragma unroll
                for (int t = 0; t < 4; ++t) { has[t] = k + t < nmine; const int l_ = has[t] ? k + t - k0 : k - k0; rT[t] = gw + NGW * (has[t] ? k + t : k);
                    s0[t] = __shfl(sv.x, l_); s1[t] = __shfl(sv.y, l_); g0[t] = __shfl(gv.x, l_); g1[t] = __shfl(gv.y, l_); }
                float4 xv[4][4]; uint2 ya[4][4], yb[4][4];
#pragma unroll
                for (int t = 0; t < 4; ++t)
#pragma unroll
                    for (int j = 0; j < 4; ++j) { xv[t][j] = ((const float4*)(x1 + (size_t)rT[t] * DM) + lane)[64 * j]; ya[t][j] = ((const uint2*)(yexp + (size_t)s0[t] * DM) + lane)[64 * j]; yb[t][j] = ((const uint2*)(yexp + (size_t)s1[t] * DM) + lane)[64 * j]; }
                float ssum[4];
#pragma unroll
                for (int t = 0; t < 4; ++t) { float a_ = 0.f;
#pragma unroll
                    for (int j = 0; j < 4; ++j) {
                        xv[t][j] = make_float4(xv[t][j].x + g0[t] * dn::lo_f(ya[t][j].x) + g1[t] * dn::lo_f(yb[t][j].x), xv[t][j].y + g0[t] * dn::hi_f(ya[t][j].x) + g1[t] * dn::hi_f(yb[t][j].x),
                                               xv[t][j].z + g0[t] * dn::lo_f(ya[t][j].y) + g1[t] * dn::lo_f(yb[t][j].y), xv[t][j].w + g0[t] * dn::hi_f(ya[t][j].y) + g1[t] * dn::hi_f(yb[t][j].y));
                        a_ += xv[t][j].x * xv[t][j].x + xv[t][j].y * xv[t][j].y + xv[t][j].z * xv[t][j].z + xv[t][j].w * xv[t][j].w; }
                    ssum[t] = a_; }
#pragma unroll
                for (int o = 1; o < 64; o <<= 1) {
#pragma unroll
                    for (int t = 0; t < 4; ++t) ssum[t] += __shfl_xor(ssum[t], o); }
#pragma unroll
                for (int t = 0; t < 4; ++t) { if (has[t]) { const float rs = rsqrtf(ssum[t] * (1.f / DM) + EPS); float4* od = (float4*)(outp + (size_t)rT[t] * DM) + lane;
#pragma unroll
                    for (int j = 0; j < 4; ++j) od[64 * j] = make_float4(xv[t][j].x * rs * gfin[j].x, xv[t][j].y * rs * gfin[j].y, xv[t][j].z * rs * gfin[j].z, xv[t][j].w * rs * gfin[j].w); } }
            }
        }
    }
    }
}

extern "C" void kernel_launch(void* const* d_in, const int* in_sizes, int n_in, void* d_out, int out_size, void* d_ws, size_t ws_size, hipStream_t stream) {
    static int grid_blocks = 0;
    if (!grid_blocks) {
        int dev = 0, cus = 0, per_cu = 0;
        (void)hipGetDevice(&dev);
        (void)hipDeviceGetAttribute(&cus, hipDeviceAttributeMultiprocessorCount, dev);
        (void)hipFuncSetAttribute((const void*)fwd_kernel, hipFuncAttributeMaxDynamicSharedMemorySize, LDS_BYTES);
        (void)hipOccupancyMaxActiveBlocksPerMultiprocessor(&per_cu, (const void*)fwd_kernel, NT, LDS_BYTES);
        if (per_cu < 1) per_cu = 1;
        if (per_cu > 1 && 2 * LDS_BYTES > 160 * 1024) per_cu = 1;
        grid_blocks = cus * per_cu;
        fprintf(stderr, "kernel_launch: cus %d per_cu %d grid %d ws_size %zu\n", cus, per_cu, grid_blocks, ws_size);
    }
    (void)hipMemsetAsync((char*)d_ws + WS_CTL, 0, CTL_ZERO_BYTES, stream);
    Params p{};
    for (int i = 0; i < 17; ++i) p.in[i] = (const float*)d_in[i];
    p.out = (float*)d_out; p.ws = (unsigned char*)d_ws;
    hipLaunchKernelGGL(fwd_kernel, dim3(grid_blocks), dim3(NT), LDS_BYTES, stream, p);
    hipError_t e = hipPeekAtLastError();
    if (e != hipSuccess) fprintf(stderr, "launch failed: %s (grid %d)\n", hipGetErrorString(e), grid_blocks);
}
```

```cpp
#include <hip/hip_runtime.h>
#include <cstdio>
#include <cstdint>

constexpr int BATCH = 8, SEQ = 2048, DM = 1024, NTOK = BATCH * SEQ;
constexpr int NH = 4, HD = 128, NPROJ = 3592, NPB = 3584;
constexpr int C_AH = 0, C_AB = 512, C_AC = 1024, C_Q = 1536, C_K = 2048, C_V = 2560, C_Z = 3072;
constexpr int NE = 32, FF = 512;
constexpr float EPS = 1e-6f;
constexpr int NT = 512;
#ifndef REP_PHASE
#define REP_PHASE -1
#endif
#define REP(k) for (int rep_ = 0; rep_ < ((REP_PHASE == (k)) ? 2 : 1); ++rep_)
constexpr int LDS_BYTES = 144 * 1024;
constexpr int LDS_TAB = 131072;

typedef unsigned short bf16_t;
constexpr size_t MiB = 1u << 20;
constexpr size_t WS_CTL = 0;
constexpr size_t WS_BAR = 65536;
constexpr size_t CTL_ZERO_BYTES = 131072;
constexpr size_t WS_RSTD2 = 1 * MiB;
constexpr size_t WS_TOKE = WS_RSTD2 + 65536;
constexpr size_t WS_TOKG = WS_TOKE + 131072;
constexpr size_t WS_TOKP = WS_TOKG + 131072;
constexpr size_t WS_SLOTTOK = WS_TOKP + 131072;
constexpr size_t WS_GL = WS_SLOTTOK + 131072;
constexpr size_t WS_CNTB = WS_GL + 8192;
constexpr size_t WS_BG = 2 * MiB;
constexpr size_t WS_WIN = 3 * MiB;
constexpr size_t WS_WOUT = 10 * MiB;
constexpr size_t WS_WGU = 12 * MiB;
constexpr size_t WS_WD = 76 * MiB;
constexpr size_t WS_PROJ = 108 * MiB;
constexpr size_t WS_HB = 220 * MiB;
constexpr size_t WS_YMIX = 220 * MiB;
constexpr size_t WS_AQK = 252 * MiB;
constexpr size_t WS_X1B = 108 * MiB;
constexpr size_t WS_ACT = 140 * MiB;
constexpr size_t WS_YEXP = 173 * MiB;

struct Params { const float* in[17]; float* out; unsigned char* ws; };

__device__ __forceinline__ float wave_sum(float v) {
#pragma unroll
    for (int o = 1; o < 64; o <<= 1) v += __shfl_xor(v, o);
    return v;
}
__device__ __forceinline__ float silu_f(float x) { return x / (1.f + expf(-x)); }
__device__ __forceinline__ float sigmoid_f(float x) { return 1.f / (1.f + expf(-x)); }
__device__ __forceinline__ float softplus_f(float x) { return fmaxf(x, 0.f) + log1pf(expf(-fabsf(x))); }
__device__ __forceinline__ float bf2f(bf16_t h) { return __uint_as_float((unsigned)h << 16); }
__device__ __forceinline__ unsigned f2bf(float f) { unsigned u = __float_as_uint(f); return (u + 0x7fffu + ((u >> 16) & 1u)) >> 16; }
__device__ __forceinline__ unsigned pk2(float lo, float hi) { return f2bf(lo) | (f2bf(hi) << 16); }


__device__ __forceinline__ float reduce8_tr(const float (&v)[8], int lane) {
    float a[4], b[2];
#pragma unroll
    for (int i = 0; i < 4; ++i) { const bool hi = lane & 32; const float send = hi ? v[i] : v[i + 4], keep = hi ? v[i + 4] : v[i]; a[i] = keep + __shfl_xor(send, 32); }
#pragma unroll
    for (int i = 0; i < 2; ++i) { const bool hi = lane & 16; const float send = hi ? a[i] : a[i + 2], keep = hi ? a[i + 2] : a[i]; b[i] = keep + __shfl_xor(send, 16); }
    const bool hi = lane & 8; const float send = hi ? b[0] : b[1], keep = hi ? b[1] : b[0];
    float c = keep + __shfl_xor(send, 8);
    c += __shfl_xor(c, 4); c += __shfl_xor(c, 2); c += __shfl_xor(c, 1);
    return c;
}
__device__ __forceinline__ float reduce4_tr(const float (&v)[4], int lane) {
    float a[2];
#pragma unroll
    for (int i = 0; i < 2; ++i) { const bool hi = lane & 32; const float send = hi ? v[i] : v[i + 2], keep = hi ? v[i + 2] : v[i]; a[i] = keep + __shfl_xor(send, 32); }
    const bool hi = lane & 16; const float send = hi ? a[0] : a[1], keep = hi ? a[1] : a[0];
    float c = keep + __shfl_xor(send, 16);
    c += __shfl_xor(c, 8); c += __shfl_xor(c, 4); c += __shfl_xor(c, 2); c += __shfl_xor(c, 1);
    return c;
}
__device__ __forceinline__ float lane_bcast(float v, int src) { return __int_as_float(__builtin_amdgcn_readlane(__float_as_int(v), src)); }

namespace pg8 {
#define PG8_LAS __attribute__((address_space(3)))
typedef short bf16x8 __attribute__((ext_vector_type(8)));
typedef float f32x4 __attribute__((ext_vector_type(4)));
typedef unsigned u32x4 __attribute__((ext_vector_type(4)));
constexpr int BM = 256, BK = 64, HALF = 128, HTB = HALF * BK * 2, STAGE_BYTES = 8 * HTB, NXCD = 8, WGM = 8;

__host__ __device__ __forceinline__ int lds_byte(int r, int c) { const int st = (r >> 4) * 2 + (c >> 5), rr = r & 15, cc = c & 31, ob = rr * 64 + cc * 2; return st * 1024 + (ob ^ (((ob >> 9) & 1) << 5)); }
__host__ __device__ __forceinline__ void stage_rc(int b, int& R, int& C) { const int st = b / 1024, sb = b % 1024, swz = sb ^ (((sb >> 9) & 1) << 5); R = (st >> 1) * 16 + swz / 64; C = (st & 1) * 32 + (swz % 64) / 2; }
__host__ __device__ __forceinline__ int perm32(int rho) { const int n = rho >> 4, i = rho & 15; return 8 * (i >> 2) + 4 * n + (i & 3); }

struct Unit { int arow0, rowend, pn, half; const char* B; };
struct Gemm { const bf16_t* A; int K; const int* gidx; };

struct DenseOrder {
    int nM, nN, nwg, G, c, M, nfull, tail; const char* Bt; size_t tstep;
    __device__ void init(int M_, int N, int K, const bf16_t* Bt_, int G_, int c_) { M = M_; nM = M / BM; nN = N / BM; nwg = nM * nN; G = G_; c = c_; Bt = (const char*)Bt_; tstep = (size_t)BM * K * 2;
        nfull = (nwg / G) * G; tail = nwg - nfull; if (2 * tail > G) { nfull = nwg; tail = 0; } }
    __device__ bool next(int i, Unit& u) const {
        const long L = (long)i * G + c; int wgid, hs = -1;
        if (L < nfull) wgid = (int)L;
        else { const long hu = L - nfull; if (hu >= 2 * tail) return false; wgid = nfull + (int)(hu % tail); hs = (int)(hu / tail); }
        { const int q = nwg / NXCD, r = nwg % NXCD, xcd = wgid % NXCD, off = wgid / NXCD; wgid = (xcd < r ? xcd * (q + 1) : r * (q + 1) + (xcd - r) * q) + off; }
        const int nig = WGM * nN, gid = wgid / nig, fm = gid * WGM, gsz = (nM - fm) < WGM ? (nM - fm) : WGM;
        const int pm = fm + ((wgid % nig) % gsz); u.pn = (wgid % nig) / gsz; u.B = Bt + (size_t)u.pn * tstep;
        if (hs < 0) { u.arow0 = pm * BM; u.rowend = M; u.half = 0; } else { u.arow0 = pm * BM + HALF * hs; u.rowend = u.arow0 + HALF; u.half = 1; }
        return true;
    }
};

typedef __bf16 bf16x2_t __attribute__((ext_vector_type(2)));
typedef float f32x2_t __attribute__((ext_vector_type(2)));
__device__ __forceinline__ unsigned cvt_pk_bf16(float lo, float hi) { const f32x2_t v = {lo, hi}; return __builtin_bit_cast(unsigned, __builtin_convertvector(v, bf16x2_t)); }

struct EpiBf16 {
    static constexpr bool PERM = true;
    bf16_t* O; int ldc;
    __device__ __forceinline__ void operator()(const f32x4 (&acc)[2][2][4][2], const Unit& u, int wr, int wc, int fr, int fq) const {
        const int row0 = u.arow0 + wr * 64 + fr, col0 = u.pn * BM + wc * 32 + 8 * fq;
#pragma unroll
        for (int ai = 0; ai < 2; ++ai)
#pragma unroll
            for (int m = 0; m < 4; ++m) { const int row = row0 + ai * HALF + m * 16; bf16_t* rowp = O + (size_t)row * ldc + col0;
                if (row < u.rowend) {
#pragma unroll
                    for (int bj = 0; bj < 2; ++bj) { const f32x4 v0 = acc[ai][bj][m][0], v1 = acc[ai][bj][m][1];
                        u32x4 w; w.x = cvt_pk_bf16(v0[0], v0[1]); w.y = cvt_pk_bf16(v0[2], v0[3]); w.z = cvt_pk_bf16(v1[0], v1[1]); w.w = cvt_pk_bf16(v1[2], v1[3]);
                        *(u32x4*)(rowp + bj * HALF) = w; } } }
    }
};
struct EpiResid {
    static constexpr bool PERM = false;
    const float* base; bf16_t* C; int ldc;
    __device__ __forceinline__ void operator()(const f32x4 (&acc)[2][2][4][2], const Unit& u, int wr, int wc, int fr, int fq) const {
        const int row0 = u.arow0 + wr * 64 + fr, col0 = u.pn * BM + wc * 32 + 4 * fq;
#pragma unroll
        for (int ai = 0; ai < 2; ++ai) {
            f32x4 bv[4][2][2];
#pragma unroll
            for (int m = 0; m < 4; ++m) { const size_t off = (size_t)(row0 + ai * HALF + m * 16) * ldc + col0;
#pragma unroll
                for (int bj = 0; bj < 2; ++bj)
#pragma unroll
                    for (int n = 0; n < 2; ++n) bv[m][bj][n] = *(const f32x4*)(base + off + bj * HALF + n * 16); }
#pragma unroll
            for (int m = 0; m < 4; ++m) { const size_t off = (size_t)(row0 + ai * HALF + m * 16) * ldc + col0;
#pragma unroll
                for (int bj = 0; bj < 2; ++bj)
#pragma unroll
                    for (int n = 0; n < 2; ++n) { const f32x4 v = bv[m][bj][n] + acc[ai][bj][m][n]; uint2 w; w.x = cvt_pk_bf16(v[0], v[1]); w.y = cvt_pk_bf16(v[2], v[3]); *(uint2*)(C + off + bj * HALF + n * 16) = w; } }
        }
    }
};
struct EpiAct {
    static constexpr bool PERM = true;
    bf16_t* O;
    __device__ __forceinline__ void operator()(const f32x4 (&acc)[2][2][4][2], const Unit& u, int wr, int wc, int fr, int fq) const {
        const int row0 = u.arow0 + wr * 64 + fr, col0 = u.pn * HALF + wc * 32 + 8 * fq;
#pragma unroll
        for (int ai = 0; ai < 2; ++ai)
#pragma unroll
            for (int m = 0; m < 4; ++m) { const int row = row0 + ai * HALF + m * 16;
                if (row < u.rowend) { float v[8];
#pragma unroll
                    for (int n = 0; n < 2; ++n)
#pragma unroll
                        for (int j = 0; j < 4; ++j) { const float gt = acc[ai][0][m][n][j], up = acc[ai][1][m][n][j]; v[n * 4 + j] = gt * __builtin_amdgcn_rcpf(1.f + __builtin_amdgcn_exp2f(-1.4426950408889634f * gt)) * up; }
                    u32x4 w; w.x = cvt_pk_bf16(v[0], v[1]); w.y = cvt_pk_bf16(v[2], v[3]); w.z = cvt_pk_bf16(v[4], v[5]); w.w = cvt_pk_bf16(v[6], v[7]);
                    *(u32x4*)(O + (size_t)row * 512 + col0) = w; } }
    }
};
struct GroupedOrder {
    const int* Loff; const int* Ttile; const int* Lend; const int* LsmE; int nfullu, nunits, G, c; const char* Bt; size_t estride, tstep;
    __device__ bool next(int i, Unit& u) const {
        const int L = (G == 256) ? ((i * 8 + (c & 7)) * 32 + (c >> 3)) : (i * G + c);
        if (L >= nunits) return false;
        u.pn = L & 3;
        if (L < nfullu) { const int tile = L >> 2; int e = 0; while (Ttile[e + 1] <= tile) ++e;
            u.arow0 = Loff[e] + (tile - Ttile[e]) * BM; u.rowend = Lend[e]; u.half = 0; u.B = Bt + (size_t)e * estride + (size_t)u.pn * tstep; }
        else { const int e = LsmE[(L - nfullu) >> 2]; u.arow0 = Lend[e]; u.rowend = Loff[e + 1]; u.half = 1; u.B = Bt + (size_t)e * estride + (size_t)u.pn * tstep; }
        return true;
    }
};

template <class Epi, class Sched, bool GATHER, bool ALIGN_EPI>
__device__ __forceinline__ void gemm_phase(PG8_LAS unsigned char* lds, const Gemm g, const Sched& S, const Epi& E) {
    const int tid = threadIdx.x, wid = __builtin_amdgcn_readfirstlane(tid >> 6), lane = tid & 63, wr = wid >> 2, wc = wid & 3, fr = lane & 15, fq = lane >> 4;
    const int K = g.K, nt = K / BK;
    int RA[2], CA[2]; unsigned voffB[2];
#pragma unroll
    for (int i = 0; i < 2; ++i) { int R, C; stage_rc(tid * 16 + i * 8192, R, C); const int Rb = Epi::PERM ? ((R & ~31) + perm32(R & 31)) : R;
        RA[i] = R; CA[i] = C; voffB[i] = (unsigned)(Rb * K + C) * 2u; }
    const size_t kstep = (size_t)(BK * 2);
    const size_t hstep = (size_t)HALF * K * 2;
    const unsigned ldsw = (unsigned)wid * 1024u;
    const int aoff = lds_byte(wr * 64 + fr, fq * 8), boff = lds_byte(wc * 32 + fr, fq * 8);
    const char* A0 = (const char*)g.A;
#define PG8_SA(b, h) (((b) * 2 + (h)) * HTB)
#define PG8_SB(b, h) ((4 + (b) * 2 + (h)) * HTB)
#define PG8_STAGE(bufoff, gbase, voff) do { _Pragma("unroll") for (int _i = 0; _i < 2; ++_i) \
        __builtin_amdgcn_global_load_lds((const unsigned*)((const char*)(gbase) + (voff)[_i]), (PG8_LAS unsigned*)(lds + (bufoff) + ldsw + _i * 8192), 16, 0, 0); } while (0)
#define PG8_LDA(dst, b, h) do { _Pragma("unroll") for (int m = 0; m < 4; ++m) _Pragma("unroll") for (int k = 0; k < 2; ++k) dst[m][k] = *(const PG8_LAS bf16x8*)(lds + PG8_SA(b, h) + aoff + m * 2048 + k * 1024); } while (0)
#define PG8_LDB(dst, b, h) do { _Pragma("unroll") for (int n = 0; n < 2; ++n) _Pragma("unroll") for (int k = 0; k < 2; ++k) dst[n][k] = *(const PG8_LAS bf16x8*)(lds + PG8_SB(b, h) + boff + n * 2048 + k * 1024); } while (0)
#define PG8_MMA(ai, bj, At, Bt) do { __builtin_amdgcn_s_setprio(1); _Pragma("unroll") for (int m = 0; m < 4; ++m) _Pragma("unroll") for (int n = 0; n < 2; ++n) _Pragma("unroll") for (int k = 0; k < 2; ++k) \
        acc[ai][bj][m][n] = __builtin_amdgcn_mfma_f32_16x16x32_bf16(Bt[n][k], At[m][k], acc[ai][bj][m][n], 0, 0, 0); __builtin_amdgcn_s_setprio(0); } while (0)
#define PG8_WAIT_V(n) asm volatile("s_waitcnt vmcnt(" #n ")" ::: "memory")
#define PG8_WAIT_L(n) asm volatile("s_waitcnt lgkmcnt(" #n ")" ::: "memory")
#define PG8_BAR __builtin_amdgcn_s_barrier()
#define PG8_SCHED __builtin_amdgcn_sched_barrier(0)
#define PG8_AOFF(dst, u) do { _Pragma("unroll") for (int _h = 0; _h < 2; ++_h) _Pragma("unroll") for (int _i = 0; _i < 2; ++_i) { int _r = (u).arow0 + _h * HALF + RA[_i]; _r = _r < (u).rowend ? _r : (u).rowend - 1; \
        if (GATHER) _r = g.gidx[_r]; dst[_h][_i] = (unsigned)(_r * K + CA[_i]) * 2u; } } while (0)
    Unit cur, nxt; int ui = 0;
    if (!S.next(0, cur)) return;
    f32x4 acc[2][2][4][2];
#pragma unroll
    for (int a = 0; a < 2; ++a)
#pragma unroll
        for (int b = 0; b < 2; ++b)
#pragma unroll
            for (int m = 0; m < 4; ++m)
#pragma unroll
                for (int n = 0; n < 2; ++n) acc[a][b][m][n] = (f32x4){0.f, 0.f, 0.f, 0.f};
    bf16x8 At[4][2], B0[2][2], B1[2][2];
    unsigned cvA[2][2], nvA[2][2];
    PG8_AOFF(cvA, cur);
    const char* cB = cur.B;
    PG8_STAGE(PG8_SB(0, 0), cB, voffB); PG8_STAGE(PG8_SB(0, 1), cB + hstep, voffB); PG8_STAGE(PG8_SA(0, 0), A0, cvA[0]); PG8_STAGE(PG8_SA(0, 1), A0, cvA[1]);
    if (wr == 1) PG8_BAR;
    PG8_WAIT_V(2); PG8_BAR;
    PG8_STAGE(PG8_SB(1, 0), cB + kstep, voffB); PG8_STAGE(PG8_SA(1, 0), A0 + kstep, cvA[0]); PG8_STAGE(PG8_SB(1, 1), cB + hstep + kstep, voffB);
    PG8_WAIT_V(6); PG8_BAR;
    for (;;) {
        const bool has_next = S.next(ui + 1, nxt);
        if (has_next) { PG8_AOFF(nvA, nxt); } else {
#pragma unroll
            for (int h = 0; h < 2; ++h)
#pragma unroll
                for (int i = 0; i < 2; ++i) nvA[h][i] = cvA[h][i]; }
        const char* nB = has_next ? nxt.B : cB;
        for (int t = 0; t < nt; t += 2) {
            const bool last = (t == nt - 2);
            const char* a1 = A0 + (size_t)(t + 1) * kstep;
            const char* a2 = last ? A0 : A0 + (size_t)(t + 2) * kstep; const char* b2 = last ? nB : cB + (size_t)(t + 2) * kstep;
            const char* a3 = a2 + kstep; const char* b3 = b2 + kstep;
            unsigned s2[2][2];
#pragma unroll
            for (int h = 0; h < 2; ++h)
#pragma unroll
                for (int i = 0; i < 2; ++i) s2[h][i] = last ? nvA[h][i] : cvA[h][i];
            PG8_LDB(B0, 0, 0); PG8_LDB(B1, 0, 1); PG8_SCHED; PG8_LDA(At, 0, 0); PG8_STAGE(PG8_SA(1, 1), a1, cvA[1]);
            PG8_WAIT_V(8); PG8_WAIT_L(0); PG8_BAR; PG8_MMA(0, 0, At, B0); PG8_MMA(0, 1, At, B1); PG8_BAR; PG8_SCHED;
            PG8_LDA(At, 0, 1); PG8_STAGE(PG8_SB(0, 0), b2, voffB); PG8_STAGE(PG8_SB(0, 1), b2 + hstep, voffB); PG8_STAGE(PG8_SA(0, 0), a2, s2[0]);
            PG8_WAIT_V(8); PG8_WAIT_L(0); PG8_BAR; if (!cur.half) { PG8_MMA(1, 0, At, B0); PG8_MMA(1, 1, At, B1); } PG8_BAR; PG8_SCHED;
            PG8_LDB(B0, 1, 0); PG8_LDB(B1, 1, 1); PG8_SCHED; PG8_LDA(At, 1, 0); PG8_STAGE(PG8_SA(0, 1), a2, s2[1]);
            PG8_WAIT_V(8); PG8_WAIT_L(0); PG8_BAR; PG8_MMA(0, 0, At, B0); PG8_MMA(0, 1, At, B1); PG8_BAR; PG8_SCHED;
            PG8_LDA(At, 1, 1); PG8_STAGE(PG8_SB(1, 0), b3, voffB); PG8_STAGE(PG8_SB(1, 1), b3 + hstep, voffB); PG8_STAGE(PG8_SA(1, 0), a3, s2[0]);
            PG8_WAIT_V(8); PG8_WAIT_L(0); PG8_BAR; if (!cur.half) { PG8_MMA(1, 0, At, B0); PG8_MMA(1, 1, At, B1); } PG8_BAR; PG8_SCHED;
        }
        if constexpr (ALIGN_EPI) { if (wr == 0) PG8_BAR; }
        E(acc, cur, wr, wc, fr, fq);
        if (!has_next) break;
#pragma unroll
        for (int a = 0; a < 2; ++a)
#pragma unroll
            for (int b = 0; b < 2; ++b)
#pragma unroll
                for (int m = 0; m < 4; ++m)
#pragma unroll
                    for (int n = 0; n < 2; ++n) acc[a][b][m][n] = (f32x4){0.f, 0.f, 0.f, 0.f};
        cur = nxt; cB = nB; ++ui;
#pragma unroll
        for (int h = 0; h < 2; ++h)
#pragma unroll
            for (int i = 0; i < 2; ++i) cvA[h][i] = nvA[h][i];
        if constexpr (ALIGN_EPI) { if (wr == 1) PG8_BAR; }
    }
    PG8_WAIT_V(0);
    if constexpr (!ALIGN_EPI) { if (wr == 0) PG8_BAR; }
    PG8_BAR;
#undef PG8_SA
#undef PG8_SB
#undef PG8_STAGE
#undef PG8_LDA
#undef PG8_LDB
#undef PG8_MMA
#undef PG8_WAIT_V
#undef PG8_WAIT_L
#undef PG8_BAR
#undef PG8_SCHED
#undef PG8_AOFF
}
}


namespace dn {
typedef short bf16x8 __attribute__((ext_vector_type(8)));
typedef float f32x4 __attribute__((ext_vector_type(4)));
typedef unsigned u32x4 __attribute__((ext_vector_type(4)));
typedef unsigned u32x2 __attribute__((ext_vector_type(2)));
__device__ __forceinline__ int perm_pos(int kl) { return 8 * ((kl >> 2) & 3) + 4 * (kl >> 4) + (kl & 3); }
__device__ __forceinline__ int perm_inv(int p) { return 16 * ((p >> 2) & 1) + 4 * (p >> 3) + (p & 3); }
typedef __bf16 bf16x2_t __attribute__((ext_vector_type(2)));
typedef float f32x2_t __attribute__((ext_vector_type(2)));
__device__ __forceinline__ unsigned pkbf(float lo, float hi) { const f32x2_t v = {lo, hi}; return __builtin_bit_cast(unsigned, __builtin_convertvector(v, bf16x2_t)); }
__device__ __forceinline__ float lo_f(unsigned u) { return __uint_as_float(u << 16); }
__device__ __forceinline__ float hi_f(unsigned u) { return __uint_as_float(u & 0xffff0000u); }
constexpr int P2_LT = 0, P2_G = 16384, P2_QB = 17408, P2_KB = P2_QB + 17408, P2_RU = P2_KB + 17408, P2_RW = P2_RU + 32768;
constexpr int ROWB = 272;

struct DnBufs { bf16_t* UT; bf16_t* WN; bf16_t* QD; bf16_t* KDT; bf16_t* AQK; float* GL; };

__device__ __forceinline__ float silu_fast(float a) { return a * __builtin_amdgcn_rcpf(1.f + __builtin_amdgcn_exp2f(-1.4426950408889634f * a)); }
constexpr int P2_END = P2_RW + 32768;
template <class Hook>
__device__ __forceinline__ void prep(unsigned char* lds, int tid, int bid, int G, const bf16_t* proj, const float* bg, const float* dn_conv_w, const DnBufs B, Hook hook) {
    const int lane = tid & 63, wave = tid >> 6;
    float* RU = (float*)(lds + P2_RU); float* RW = (float*)(lds + P2_RW); float* LT = (float*)(lds + P2_LT); float* GS = (float*)(lds + P2_G);
    const int nitems = BATCH * NH * (SEQ / 64);
    const int r0 = wave * 8;
    unsigned xin[11][3]; float gin, bin;
#define DN_PREP_LOAD(item_) do { const int bh_ = (item_) >> 5, c_ = (item_) & 31, b_ = bh_ >> 2, h_ = bh_ & 3, t0_ = c_ * 64; \
        _Pragma("unroll") for (int rr = 0; rr < 11; ++rr) { const int t = t0_ + r0 + rr - 3; \
            _Pragma("unroll") for (int wh = 0; wh < 3; ++wh) { const unsigned v_ = *(const unsigned*)(proj + ((size_t)b_ * SEQ + (t >= 0 ? t : 0)) * NPB + C_Q + wh * 512 + h_ * 128 + 2 * lane); xin[rr][wh] = (t >= 0) ? v_ : 0u; } } \
        gin = bg[((size_t)b_ * SEQ + t0_ + lane) * 8 + 4 + h_]; bin = bg[((size_t)b_ * SEQ + t0_ + lane) * 8 + h_]; } while (0)
    for (int item = bid; item < nitems; item += G) {
        const int bh = item >> 5, h = bh & 3;
        DN_PREP_LOAD(item);
        float cw[3][4][2];
#pragma unroll
        for (int wh = 0; wh < 3; ++wh)
#pragma unroll
            for (int j = 0; j < 4; ++j) { const float2 w2 = *(const float2*)(dn_conv_w + j * 1536 + wh * 512 + h * 128 + 2 * lane); cw[wh][j][0] = w2.x; cw[wh][j][1] = w2.y; }
        float Gc = gin;
#pragma unroll
        for (int o = 1; o < 64; o <<= 1) { const float t = __shfl_up(Gc, o); if (lane >= o) Gc += t; }
        const float glast = __shfl(Gc, 63), eGl = __expf(Gc), bel = bin;
        if (wave == 0) { GS[lane] = Gc; GS[64 + lane] = eGl; GS[128 + lane] = bel; GS[192 + lane] = __expf(glast - Gc); if (lane == 0) B.GL[item] = glast; }
#pragma unroll
        for (int rr = 0; rr < 8; ++rr) {
            const int i = r0 + rr;
            float val[3][2];
#pragma unroll
            for (int wh = 0; wh < 3; ++wh) { float a0 = 0.f, a1 = 0.f;
#pragma unroll
                for (int j = 0; j < 4; ++j) { a0 += lo_f(xin[rr + j][wh]) * cw[wh][j][0]; a1 += hi_f(xin[rr + j][wh]) * cw[wh][j][1]; }
                val[wh][0] = silu_fast(a0); val[wh][1] = silu_fast(a1); }
            float sq = val[0][0] * val[0][0] + val[0][1] * val[0][1], sk = val[1][0] * val[1][0] + val[1][1] * val[1][1];
#pragma unroll
            for (int o = 1; o < 64; o <<= 1) { sq += __shfl_xor(sq, o); sk += __shfl_xor(sk, o); }
            const float fq = rsqrtf(sq + EPS) * 0.08838834764831845f, fk = rsqrtf(sk + EPS);
            const float eG = __shfl(eGl, i), be = __shfl(bel, i);
            const float q0 = val[0][0] * fq, q1 = val[0][1] * fq, k0 = val[1][0] * fk, k1 = val[1][1] * fk;
            *(unsigned*)(lds + P2_QB + i * ROWB + 4 * lane) = pkbf(q0, q1);
            *(unsigned*)(lds + P2_KB + i * ROWB + 4 * lane) = pkbf(k0, k1);
            const int kl = (2 * lane) & 31, pos = ((2 * lane) & ~31) + perm_pos(kl);
            *(unsigned*)(B.QD + ((size_t)item * 64 + i) * 128 + pos) = pkbf(q0 * eG, q1 * eG);
            *(float2*)(RW + i * 128 + 2 * lane) = make_float2(be * eG * k0, be * eG * k1);
            *(float2*)(RU + i * 128 + 2 * lane) = make_float2(be * val[2][0], be * val[2][1]);
        }
        __syncthreads();
        {
            const int g = lane >> 4, cl = lane & 15, mi = wave >> 1, nj0 = 2 * (wave & 1);
            bf16x8 ka[4], qa[4];
#pragma unroll
            for (int s_ = 0; s_ < 4; ++s_) { ka[s_] = *(const bf16x8*)(lds + P2_KB + (16 * mi + cl) * ROWB + (32 * s_ + 8 * g) * 2); qa[s_] = *(const bf16x8*)(lds + P2_QB + (16 * mi + cl) * ROWB + (32 * s_ + 8 * g) * 2); }
#pragma unroll
            for (int nn = 0; nn < 2; ++nn) {
                const int nj = nj0 + nn;
                f32x4 akk = {0.f, 0.f, 0.f, 0.f}, aqk = {0.f, 0.f, 0.f, 0.f};
#pragma unroll
                for (int s_ = 0; s_ < 4; ++s_) { const bf16x8 kb = *(const bf16x8*)(lds + P2_KB + (16 * nj + cl) * ROWB + (32 * s_ + 8 * g) * 2);
                    akk = __builtin_amdgcn_mfma_f32_16x16x32_bf16(ka[s_], kb, akk, 0, 0, 0); aqk = __builtin_amdgcn_mfma_f32_16x16x32_bf16(qa[s_], kb, aqk, 0, 0, 0); }
                const int j = 16 * nj + cl; const float Gj = GS[j];
                float lt[4];
                const int jpos = (j & ~31) + perm_pos(j & 31);
#pragma unroll
                for (int x_ = 0; x_ < 4; ++x_) { const int i = 16 * mi + 4 * g + x_; const float dec = __expf(fminf(GS[i] - Gj, 0.f));
                    lt[x_] = (i > j) ? GS[128 + i] * akk[x_] * dec : 0.f;
                    const float a = (i >= j) ? aqk[x_] * dec : 0.f;
                    B.AQK[((size_t)item * 64 + i) * 64 + jpos] = (bf16_t)(pkbf(a, 0.f) & 0xffffu); }
                *(float4*)(LT + j * 64 + 16 * mi + 4 * g) = make_float4(lt[0], lt[1], lt[2], lt[3]);
            }
        }
        __syncthreads();
        if (tid < 256) {
            const float* src = (tid < 128) ? (RU + tid) : (RW + (tid - 128));
            typedef __attribute__((address_space(3))) float lds_f32;
            const lds_f32* LTp = (const lds_f32*)(LT); asm volatile("" : "+v"(LTp));
            float acc[64];
#pragma unroll
            for (int i = 0; i < 64; ++i) acc[i] = src[i * 128];
#pragma unroll
            for (int j = 0; j < 63; ++j) {
                const float xj = acc[j];
#pragma unroll
                for (int q = (j + 1) >> 2; q < 16; ++q) {
                    const f32x4 l4 = *(const __attribute__((address_space(3))) f32x4*)(LTp + j * 64 + 4 * q);
                    if (4 * q + 0 > j) acc[4 * q + 0] -= l4.x * xj;
                    if (4 * q + 1 > j) acc[4 * q + 1] -= l4.y * xj;
                    if (4 * q + 2 > j) acc[4 * q + 2] -= l4.z * xj;
                    if (4 * q + 3 > j) acc[4 * q + 3] -= l4.w * xj;
                }
            }
            if (tid < 128) {
                u32x4* dst = (u32x4*)(B.UT + ((size_t)item * 128 + tid) * 64);
#pragma unroll
                for (int q = 0; q < 8; ++q) { u32x4 w; w.x = pkbf(acc[8 * q], acc[8 * q + 1]); w.y = pkbf(acc[8 * q + 2], acc[8 * q + 3]); w.z = pkbf(acc[8 * q + 4], acc[8 * q + 5]); w.w = pkbf(acc[8 * q + 6], acc[8 * q + 7]); dst[q] = w; }
            } else {
                const int dk = tid - 128, pos = (dk & ~31) + perm_pos(dk & 31);
                bf16_t* dst = B.WN + (size_t)item * 64 * 128 + pos;
#pragma unroll
                for (int i = 0; i < 64; ++i) dst[i * 128] = (bf16_t)(pkbf(-acc[i], 0.f) & 0xffffu);
            }
        } else if (tid < 384) {
            const int dk = tid - 256;
            u32x4* dst = (u32x4*)(B.KDT + ((size_t)item * 128 + dk) * 64);
#pragma unroll
            for (int q = 0; q < 8; ++q) { float v[8];
#pragma unroll
                for (int e = 0; e < 8; ++e) { const int p_ = 8 * q + e, i = (p_ & ~31) + perm_inv(p_ & 31); v[e] = bf2f(*(const bf16_t*)(lds + P2_KB + i * ROWB + 2 * dk)) * GS[192 + i]; }
                u32x4 w; w.x = pkbf(v[0], v[1]); w.y = pkbf(v[2], v[3]); w.z = pkbf(v[4], v[5]); w.w = pkbf(v[6], v[7]); dst[q] = w; }
        }
        if (tid >= 256) hook(item, wave - 4, lane);
        __syncthreads();
    }
#undef DN_PREP_LOAD
}

constexpr int SROW = 288, SKROW = 160;
constexpr int SC_WN = 0, SC_QD = 64 * SROW, SC_KDT = 128 * SROW, SC_AQK = SC_KDT + 128 * SKROW, SC_BUF = SC_AQK + 64 * SKROW  , SC_OT = 2048;
__device__ __forceinline__ void scan(unsigned char* lds, int tid, int bid, int G, const DnBufs B, bf16_t* ymix, unsigned* flags) {
    const int lane = tid & 63, wave = __builtin_amdgcn_readfirstlane(tid >> 6), g = lane >> 4, cl = lane & 15;
#define DN_BAR() do { asm volatile("s_waitcnt lgkmcnt(0)" ::: "memory"); __builtin_amdgcn_s_barrier(); asm volatile("" ::: "memory"); } while (0)
    for (int unit = bid; unit < 2 * BATCH * NH; unit += G) {
        const int bh = (unit & 7) | ((unit >> 4) << 3), uhalf = (unit >> 3) & 1;
        __syncthreads();
        if (wave < 4) {
            const int wdv = 4 * uhalf + wave, dv = 16 * wdv + cl;
            f32x4 S[8]; bf16x8 Sb[4];
#pragma unroll
            for (int r = 0; r < 8; ++r) S[r] = (f32x4){0.f, 0.f, 0.f, 0.f};
#pragma unroll
            for (int s_ = 0; s_ < 4; ++s_) Sb[s_] = (bf16x8){0, 0, 0, 0, 0, 0, 0, 0};
            const float eglv = __expf(B.GL[bh * 32 + (lane & 31)]);
            u32x2 uA[4], uB[4];
            f32x4 vn[4];
#define DN_LOAD_U(upre, c_) do { const size_t it_ = (size_t)(bh * 32 + (c_)); \
            _Pragma("unroll") for (int m_ = 0; m_ < 4; ++m_) upre[m_] = *(const u32x2*)(B.UT + (it_ * 128 + dv) * 64 + 16 * m_ + 4 * g); } while (0)
#define DN_VN(upre) do { _Pragma("unroll") for (int m = 0; m < 4; ++m) vn[m] = (f32x4){lo_f(upre[m].x), hi_f(upre[m].x), lo_f(upre[m].y), hi_f(upre[m].y)}; } while (0)
#define DN_SB() __builtin_amdgcn_sched_barrier(0)
#define DN_LDW(f, off_, m0_) do { _Pragma("unroll") for (int m = 0; m < 2; ++m) _Pragma("unroll") for (int s_ = 0; s_ < 4; ++s_) f[m * 4 + s_] = *(const bf16x8*)(buf + (off_) + (16 * ((m0_) + m) + cl) * SROW + (32 * s_ + 8 * g) * 2); } while (0)
#define DN_LDK(f, off_, r0_) do { _Pragma("unroll") for (int r = 0; r < 4; ++r) _Pragma("unroll") for (int s_ = 0; s_ < 2; ++s_) f[r * 2 + s_] = *(const bf16x8*)(buf + (off_) + (16 * ((r0_) + r) + cl) * SKROW + (32 * s_ + 8 * g) * 2); } while (0)
#define DN_MMW(acc, m0_, f) do { _Pragma("unroll") for (int s_ = 0; s_ < 4; ++s_) _Pragma("unroll") for (int m = 0; m < 2; ++m) acc[(m0_) + m] = __builtin_amdgcn_mfma_f32_16x16x32_bf16(f[m * 4 + s_], Sb[s_], acc[(m0_) + m], 0, 0, 0); } while (0)
#define DN_MMK(acc, r0_, f) do { _Pragma("unroll") for (int s_ = 0; s_ < 2; ++s_) _Pragma("unroll") for (int r = 0; r < 4; ++r) acc[(r0_) + r] = __builtin_amdgcn_mfma_f32_16x16x32_bf16(f[r * 2 + s_], Vb[s_], acc[(r0_) + r], 0, 0, 0); } while (0)
#define DN_CHUNK(bufoff_, c_) do { \
            const unsigned char* buf = lds + (bufoff_); const int item = bh * 32 + (c_); \
            const float egl = __shfl(eglv, (c_)); \
            f32x4 o[4]; \
            _Pragma("unroll") for (int m = 0; m < 4; ++m) o[m] = (f32x4){0.f, 0.f, 0.f, 0.f}; \
            bf16x8 fA[8], fB[8]; \
            DN_LDW(fA, SC_WN, 0); DN_LDW(fB, SC_WN, 2); DN_SB(); \
            DN_MMW(vn, 0, fA); DN_SB(); DN_LDW(fA, SC_QD, 0); DN_SB(); \
            DN_MMW(vn, 2, fB); DN_SB(); DN_LDW(fB, SC_QD, 2); DN_SB(); \
            bf16x8 Vb[2]; \
            _Pragma("unroll") for (int s_ = 0; s_ < 2; ++s_) { u32x4 w; w.x = pkbf(vn[2 * s_][0], vn[2 * s_][1]); w.y = pkbf(vn[2 * s_][2], vn[2 * s_][3]); w.z = pkbf(vn[2 * s_ + 1][0], vn[2 * s_ + 1][1]); w.w = pkbf(vn[2 * s_ + 1][2], vn[2 * s_ + 1][3]); \
                Vb[s_] = __builtin_bit_cast(bf16x8, w); } \
            DN_MMW(o, 0, fA); DN_SB(); DN_LDK(fA, SC_KDT, 0); DN_SB(); \
            DN_MMW(o, 2, fB); DN_SB(); DN_LDK(fB, SC_KDT, 4); DN_SB(); \
            _Pragma("unroll") for (int r = 0; r < 8; ++r) S[r] = S[r] * egl; \
            DN_MMK(S, 0, fA); DN_SB(); DN_LDK(fA, SC_AQK, 0); DN_SB(); \
            DN_MMK(S, 4, fB); DN_SB(); \
            DN_MMK(o, 0, fA); DN_SB(); \
            _Pragma("unroll") for (int s_ = 0; s_ < 4; ++s_) { u32x4 w; w.x = pkbf(S[2 * s_][0], S[2 * s_][1]); w.y = pkbf(S[2 * s_][2], S[2 * s_][3]); w.z = pkbf(S[2 * s_ + 1][0], S[2 * s_ + 1][1]); w.w = pkbf(S[2 * s_ + 1][2], S[2 * s_ + 1][3]); \
                Sb[s_] = __builtin_bit_cast(bf16x8, w); } \
            { unsigned char* sc_ = lds + 2 * SC_BUF + wave * SC_OT; \
              _Pragma("unroll") for (int m = 0; m < 4; ++m) _Pragma("unroll") for (int x_ = 0; x_ < 4; ++x_) *(bf16_t*)(sc_ + (m * 4 + x_) * 128 + 2 * lane) = (bf16_t)(pkbf(o[m][x_], 0.f) & 0xffffu); \
              if ((c_) < 30) asm volatile("s_waitcnt vmcnt(11)" ::: "memory");     \
              else asm volatile("s_waitcnt vmcnt(3)" ::: "memory");                \
              if ((c_) > 1 && lane == 0) __hip_atomic_fetch_add(flagp + ((c_) - 2) * 32, 1u, __ATOMIC_RELAXED, __HIP_MEMORY_SCOPE_AGENT); \
              _Pragma("unroll") for (int q_ = 0; q_ < 2; ++q_) { \
                  const u32x4 w_ = *(const u32x4*)(sc_ + q_ * 1024 + lane * 16); \
                  const bf16_t* p_ = B.UT + ((size_t)item * 128 + 16 * wdv) * 64 + q_ * 512 + lane * 8; \
                  asm volatile("global_store_dwordx4 %0, %1, off sc1" :: "v"(p_), "v"(w_) : "memory"); } } \
        } while (0)
            unsigned* flagp = flags + (size_t)(bh >> 2) * 32 * 32;
            DN_LOAD_U(uA, 0); DN_LOAD_U(uB, 1);
            DN_BAR();
            for (int c = 0; c < SEQ / 64; c += 2) {
                DN_VN(uA); if (c + 2 < SEQ / 64) DN_LOAD_U(uA, c + 2);
                DN_CHUNK(0, c);
                DN_BAR();
                DN_VN(uB); if (c + 3 < SEQ / 64) DN_LOAD_U(uB, c + 3);
                DN_CHUNK(SC_BUF, c + 1);
                DN_BAR();
            }
            asm volatile("s_waitcnt vmcnt(0)" ::: "memory");
            if (lane == 0) { __hip_atomic_fetch_add(flagp + (SEQ / 64 - 2) * 32, 1u, __ATOMIC_RELAXED, __HIP_MEMORY_SCOPE_AGENT); __hip_atomic_fetch_add(flagp + (SEQ / 64 - 1) * 32, 1u, __ATOMIC_RELAXED, __HIP_MEMORY_SCOPE_AGENT); }
#undef DN_LOAD_U
#undef DN_VN
#undef DN_SB
#undef DN_LDW
#undef DN_LDK
#undef DN_MMW
#undef DN_MMK
#undef DN_CHUNK
        } else {
            const int lt = tid - 256;
            const int o_w = (lt >> 4) * SROW + (lt & 15) * 16, o_k = (lt >> 3) * SKROW + (lt & 7) * 16;
            u32x4 p0[14], p1[14], p2[14];
#define DN_LOADP(pre, c_) do { const size_t it_ = (size_t)(bh * 32 + (c_)); \
            _Pragma("unroll") for (int q = 0; q < 4; ++q) { pre[q] = *(const u32x4*)(B.WN + it_ * 8192 + (size_t)(lt + 256 * q) * 8); pre[4 + q] = *(const u32x4*)(B.QD + it_ * 8192 + (size_t)(lt + 256 * q) * 8); \
                pre[8 + q] = *(const u32x4*)(B.KDT + it_ * 8192 + (size_t)(lt + 256 * q) * 8); } \
            _Pragma("unroll") for (int q = 0; q < 2; ++q) pre[12 + q] = *(const u32x4*)(B.AQK + it_ * 4096 + (size_t)(lt + 256 * q) * 8); } while (0)
#define DN_WRITEP(pre, bufoff_) do { unsigned char* d_ = lds + (bufoff_); \
            _Pragma("unroll") for (int q = 0; q < 4; ++q) { *(u32x4*)(d_ + SC_WN + o_w + q * 16 * SROW) = pre[q]; *(u32x4*)(d_ + SC_QD + o_w + q * 16 * SROW) = pre[4 + q]; *(u32x4*)(d_ + SC_KDT + o_k + q * 32 * SKROW) = pre[8 + q]; } \
            _Pragma("unroll") for (int q = 0; q < 2; ++q) *(u32x4*)(d_ + SC_AQK + o_k + q * 32 * SKROW) = pre[12 + q]; } while (0)
            DN_LOADP(p0, 0); DN_LOADP(p1, 1); DN_LOADP(p2, 2);
            DN_WRITEP(p0, 0);
            DN_BAR();
            DN_LOADP(p0, 3);
#define DN_STEP(j_, set_, bufoff_) do { const int cc_ = c + (j_); if (cc_ < SEQ / 64) { if (cc_ + 1 < SEQ / 64) DN_WRITEP(set_, bufoff_); DN_BAR(); if (cc_ + 4 < SEQ / 64) DN_LOADP(set_, cc_ + 4); } } while (0)
            for (int c = 0; c < SEQ / 64; c += 6) {
                DN_STEP(0, p1, SC_BUF); DN_STEP(1, p2, 0); DN_STEP(2, p0, SC_BUF); DN_STEP(3, p1, 0); DN_STEP(4, p2, SC_BUF); DN_STEP(5, p0, 0);
            }
#undef DN_STEP
#undef DN_LOADP
#undef DN_WRITEP
        }
        __syncthreads();
    }
#undef DN_BAR
}
}

__device__ __forceinline__ void transpose_item(const float* W, int ldw, int k0, int n0, bf16_t* WT, int ldk, int dst_row0, float* scr_f, int lane) {
    unsigned* scr = (unsigned*)scr_f;
    const int c4 = (lane & 7) * 4, rq = lane >> 3;
    float4 lo[4], hi[4];
#pragma unroll
    for (int i = 0; i < 4; ++i) { const float* src = W + (size_t)(k0 + 2 * (rq + 8 * i)) * ldw + n0 + c4; lo[i] = *(const float4*)src; hi[i] = *(const float4*)(src + ldw); }
#pragma unroll
    for (int i = 0; i < 4; ++i) { const int kp = rq + 8 * i; unsigned* d = scr + c4 * 36 + kp;
        d[0] = dn::pkbf(lo[i].x, hi[i].x); d[36] = dn::pkbf(lo[i].y, hi[i].y); d[72] = dn::pkbf(lo[i].z, hi[i].z); d[108] = dn::pkbf(lo[i].w, hi[i].w); }
    asm volatile("s_waitcnt lgkmcnt(0)" ::: "memory");
#pragma unroll
    for (int j = 0; j < 4; ++j) { const int n = rq + 8 * j; const uint4 o = *(const uint4*)(scr + n * 36 + 4 * (lane & 7));
        *(uint4*)(WT + (size_t)(dst_row0 + n) * ldk + k0 + 8 * (lane & 7)) = o; }
    asm volatile("s_waitcnt lgkmcnt(0)" ::: "memory");
}

constexpr int CV_IG = NE * 16 * 16, CV_ID = NE * 8 * 32, CV_PREP = 10;
__device__ __forceinline__ void conv_item(int r, const float* w_gate, const float* w_up, const float* w_down, bf16_t* wgu_t, bf16_t* wd_t, float* scr, int lane) {
    if (r < 2 * CV_IG) { const int up = r >= CV_IG; if (up) r -= CV_IG; const int e = r >> 8, kb = (r >> 4) & 15, nb = r & 15, n0 = nb * 32;
        transpose_item((up ? w_up : w_gate) + (size_t)e * DM * FF, FF, kb * 64, n0, wgu_t + (size_t)e * DM * DM, DM, (n0 >> 7) * 256 + (n0 & 127) + (up ? 128 : 0), scr, lane); return; }
    r -= 2 * CV_IG;
    { const int e = r >> 8, kb = (r >> 5) & 7, nb = r & 31; transpose_item(w_down + (size_t)e * FF * DM, DM, kb * 64, nb * 32, wd_t + (size_t)e * DM * FF, FF, nb * 32, scr, lane); }
}

#define XB_TMO      128
#define XB_XCNT(j)  (256  + 64 * (j))
#define XB_XSUB(j)  (1280 + 64 * (j))
#define XB_XGEN(j)  (2304 + 64 * (j))
#define XB_TOP      3328
#define XB_TOPGEN   3392
#define XCD_BAR_WORDS 3456
#define XB_SPIN_CAP (1u << 18)
#define XLAS __attribute__((address_space(3)))
__device__ __forceinline__ unsigned xb_ld(unsigned* p)              { return __hip_atomic_load(p, __ATOMIC_RELAXED, __HIP_MEMORY_SCOPE_AGENT); }
__device__ __forceinline__ unsigned xb_add(unsigned* p, unsigned v) { return __hip_atomic_fetch_add(p, v, __ATOMIC_RELAXED, __HIP_MEMORY_SCOPE_AGENT); }
__device__ __forceinline__ unsigned xb_xcc_id() { return (unsigned)__builtin_amdgcn_s_getreg((3 << 11) | 20) & 0xFu; }
#define XB_SPIN(cond, bar) do { unsigned _sp = 0; while (cond) { if (_sp < 32u) __builtin_amdgcn_s_sleep(1); else __builtin_amdgcn_s_sleep(24); \
    if ((++_sp & 255u) == 0u) { if (xb_ld(&(bar)[XB_TMO])) break; if (_sp > XB_SPIN_CAP) { atomicAdd(&(bar)[XB_TMO], 1u); break; } } } } while (0)
struct XcdBarrier { unsigned* bar; unsigned x; volatile XLAS unsigned* st; };
__device__ __forceinline__ XcdBarrier xcd_barrier_post(unsigned* bar, volatile XLAS unsigned* st) {
    XcdBarrier b; b.bar = bar; b.x = xb_xcc_id(); b.st = st;
    if (threadIdx.x == 0) (void)xb_add(&bar[XB_XCNT(b.x)], 1u);
    return b;
}
__device__ __forceinline__ void xcd_barrier_complete(unsigned* bar, unsigned x, unsigned& nloc, unsigned& nx) {
    const unsigned G = gridDim.x * gridDim.y * gridDim.z;
    unsigned sum, cnt, mine, sp = 0u;
    for (;;) {
        sum = 0u; cnt = 0u; mine = 0u;
#pragma unroll
        for (unsigned j = 0; j < 16; ++j) { const unsigned c = xb_ld(&bar[XB_XCNT(j)]); sum += c; cnt += (c > 0u) ? 1u : 0u; mine = (j == x) ? c : mine; }
        if (sum == G) break;
        __builtin_amdgcn_s_sleep(1);
        if ((++sp & 255u) == 0u) { if (xb_ld(&bar[XB_TMO])) break; if (sp > XB_SPIN_CAP) { atomicAdd(&bar[XB_TMO], 1u); break; } }
    }
    nloc = mine > 0u ? mine : 1u; nx = cnt > 0u ? cnt : 1u;
}
__device__ __forceinline__ void xcd_barrier(const XcdBarrier& b) {
    asm volatile("s_waitcnt vmcnt(0)" ::: "memory");
    __syncthreads();
    if (threadIdx.x == 0) {
        unsigned* bar = b.bar;
        __builtin_amdgcn_s_waitcnt(0);
        unsigned nloc = b.st[0], nx = b.st[1];
        if (nloc == 0u) { xcd_barrier_complete(bar, b.x, nloc, nx); b.st[0] = nloc; b.st[1] = nx; }
        const unsigned old = xb_add(&bar[XB_XSUB(b.x)], 1u);
        const unsigned gen = old / nloc;
        if (old + 1u == (gen + 1u) * nloc) {
            __builtin_amdgcn_fence(__ATOMIC_RELEASE, "agent");
            asm volatile("s_waitcnt vmcnt(0)" ::: "memory");
            const unsigned og = xb_add(&bar[XB_TOP], 1u);
            const unsigned tg = og / nx;
            if (og + 1u == (tg + 1u) * nx) xb_add(&bar[XB_TOPGEN], 1u);
            else XB_SPIN(xb_ld(&bar[XB_TOPGEN]) == tg, bar);
            __builtin_amdgcn_fence(__ATOMIC_ACQUIRE, "agent");
            xb_add(&bar[XB_XGEN(b.x)], 1u);
            asm volatile("s_waitcnt vmcnt(0)" ::: "memory");
        } else {
            XB_SPIN(xb_ld(&bar[XB_XGEN(b.x)]) == gen, bar);
            __builtin_amdgcn_fence(__ATOMIC_ACQUIRE, "agent");
            asm volatile("s_waitcnt vmcnt(0)" ::: "memory");
        }
    }
    __syncthreads();
}

__global__ void __launch_bounds__(NT, 2) fwd_kernel(Params p) {
    extern __shared__ __attribute__((aligned(16))) unsigned char lds_raw[];
    float* lds = (float*)lds_raw;
    int tid = threadIdx.x, lane = tid & 63, wave = tid >> 6;
    const int G = gridDim.x, bid = blockIdx.x;
    int gw = bid * 8 + wave; const int NGW = G * 8;
#define FRESH() do { tid = threadIdx.x; asm volatile("" : "+v"(tid)); lane = tid & 63; wave = tid >> 6; gw = bid * 8 + wave; } while (0)
#define GRID_SYNC() do { \
        const __attribute__((address_space(4))) Params* Pb_ = (const __attribute__((address_space(4))) Params*)__builtin_amdgcn_kernarg_segment_ptr(); asm volatile("" : "+s"(Pb_)); \
        XcdBarrier xb_; xb_.bar = (unsigned*)(Pb_->ws + WS_BAR); xb_.x = xb_xcc_id(); xb_.st = (volatile XLAS unsigned*)((XLAS unsigned char*)lds_raw + LDS_BYTES - 64); xcd_barrier(xb_); } while (0)
#define SEAM() } GRID_SYNC(); FRESH(); { LOADP();

#define LOADP() \
    const __attribute__((address_space(4))) Params* P_ = (const __attribute__((address_space(4))) Params*)__builtin_amdgcn_kernarg_segment_ptr(); asm volatile("" : "+s"(P_)); \
    const float* x = P_->in[0]; const float* mix_g = P_->in[1]; const float* w_in = P_->in[2]; const float* conv_a_w = P_->in[3]; \
    const float* conv_a_g = P_->in[4]; const float* dn_conv_w = P_->in[5]; const float* dn_a_log = P_->in[6]; const float* dn_dt_bias = P_->in[7]; \
    const float* dn_norm_g = P_->in[8]; const float* w_out = P_->in[9]; const float* ffn_g = P_->in[10]; const float* r_group_w = P_->in[11]; \
    const float* r_exp_w = P_->in[12]; const float* w_gate = P_->in[13]; const float* w_up = P_->in[14]; const float* w_down = P_->in[15]; \
    const float* final_g = P_->in[16]; unsigned char* ws = P_->ws; float* outp = P_->out; \
    int* cnt = (int*)(ws + WS_CTL); float* rstd2 = (float*)(ws + WS_RSTD2); \
    int* tok_e = (int*)(ws + WS_TOKE); float* tok_g = (float*)(ws + WS_TOKG); int* tok_p = (int*)(ws + WS_TOKP); int* slot_tok = (int*)(ws + WS_SLOTTOK); \
    float* bg = (float*)(ws + WS_BG); bf16_t* win_t = (bf16_t*)(ws + WS_WIN); bf16_t* wout_t = (bf16_t*)(ws + WS_WOUT); \
    bf16_t* proj = (bf16_t*)(ws + WS_PROJ); bf16_t* hb = (bf16_t*)(ws + WS_HB); bf16_t* ymix = (bf16_t*)(ws + WS_YMIX); \
    bf16_t* act = (bf16_t*)(ws + WS_ACT); bf16_t* yexp = (bf16_t*)(ws + WS_YEXP); bf16_t* h2b = (bf16_t*)outp; \
    bf16_t* wgu_t = (bf16_t*)(ws + WS_WGU); bf16_t* wd_t = (bf16_t*)(ws + WS_WD); bf16_t* x1 = (bf16_t*)(ws + WS_X1B); \
    dn::DnBufs DB{(bf16_t*)outp, (bf16_t*)outp + (size_t)8 * 1024 * 1024, (bf16_t*)outp + (size_t)16 * 1024 * 1024, (bf16_t*)outp + (size_t)24 * 1024 * 1024, (bf16_t*)(ws + WS_AQK), (float*)(ws + WS_GL)}; \
    (void)x; (void)mix_g; (void)w_in; (void)conv_a_w; (void)conv_a_g; (void)dn_conv_w; (void)dn_a_log; (void)dn_dt_bias; (void)dn_norm_g; (void)w_out; (void)ffn_g; (void)r_group_w; (void)r_exp_w; \
    (void)w_gate; (void)w_up; (void)w_down; (void)final_g; (void)cnt; (void)rstd2; (void)tok_e; (void)tok_g; (void)tok_p; (void)slot_tok; (void)bg; (void)win_t; (void)wout_t; (void)proj; (void)hb; (void)ymix; \
    (void)act; (void)yexp; (void)h2b; (void)wgu_t; (void)wd_t; (void)x1; (void)DB
    {
        volatile XLAS unsigned* xst_ = (volatile XLAS unsigned*)((XLAS unsigned char*)lds_raw + LDS_BYTES - 64);
        if (tid == 0) { xst_[0] = 0u; xst_[1] = 0u; }
        __syncthreads();
        (void)xcd_barrier_post((unsigned*)(p.ws + WS_BAR), xst_);
    }
#define MIXA_ROWS(first_, stride_) do { typedef unsigned u32x4_t __attribute__((ext_vector_type(4))); const int c0 = lane * 8; \
        for (int r0_ = (first_); r0_ < NTOK; r0_ += 2 * (stride_)) { \
            u32x4_t ahv[2][3], acv[2][3], abv[2]; float mk[2][3]; int rr_[2]; \
            _Pragma("unroll") for (int t = 0; t < 2; ++t) { const int r = (r0_ + t * (stride_) < NTOK) ? r0_ + t * (stride_) : r0_; rr_[t] = r; const int sq = r % SEQ; const bf16_t* pr = proj + (size_t)r * NPB; \
                _Pragma("unroll") for (int j = 0; j < 3; ++j) { const bool ok = sq + j - 2 >= 0; const bf16_t* pj = pr + (ok ? (ptrdiff_t)(j - 2) * NPB : 0); mk[t][j] = ok ? 1.f : 0.f; \
                    ahv[t][j] = *(const u32x4_t*)(pj + C_AH + c0); acv[t][j] = *(const u32x4_t*)(pj + C_AC + c0); } \
                abv[t] = *(const u32x4_t*)(pr + C_AB + c0); } \
            _Pragma("unroll") for (int t = 0; t < 2; ++t) { if (t == 1 && r0_ + (stride_) >= NTOK) break; const int r = rr_[t]; \
                float conv[8]; _Pragma("unroll") for (int i = 0; i < 8; ++i) conv[i] = 0.f; \
                _Pragma("unroll") for (int j = 0; j < 3; ++j) { const u32x4_t ah = ahv[t][j], ac = acv[t][j]; const float m_ = mk[t][j]; \
                    float4 w0 = *(const float4*)(conv_a_w + j * 512 + c0), w1 = *(const float4*)(conv_a_w + j * 512 + c0 + 4); \
                    w0.x *= m_; w0.y *= m_; w0.z *= m_; w0.w *= m_; w1.x *= m_; w1.y *= m_; w1.z *= m_; w1.w *= m_; \
                    conv[0] += dn::lo_f(ah.x) * dn::lo_f(ac.x) * w0.x; conv[1] += dn::hi_f(ah.x) * dn::hi_f(ac.x) * w0.y; conv[2] += dn::lo_f(ah.y) * dn::lo_f(ac.y) * w0.z; conv[3] += dn::hi_f(ah.y) * dn::hi_f(ac.y) * w0.w; \
                    conv[4] += dn::lo_f(ah.z) * dn::lo_f(ac.z) * w1.x; conv[5] += dn::hi_f(ah.z) * dn::hi_f(ac.z) * w1.y; conv[6] += dn::lo_f(ah.w) * dn::lo_f(ac.w) * w1.z; conv[7] += dn::hi_f(ah.w) * dn::hi_f(ac.w) * w1.w; } \
                const u32x4_t ab = abv[t]; \
                float yv[8] = {dn::lo_f(ab.x) * conv[0], dn::hi_f(ab.x) * conv[1], dn::lo_f(ab.y) * conv[2], dn::hi_f(ab.y) * conv[3], dn::lo_f(ab.z) * conv[4], dn::hi_f(ab.z) * conv[5], dn::lo_f(ab.w) * conv[6], dn::hi_f(ab.w) * conv[7]}; \
                float ss = 0.f; _Pragma("unroll") for (int i = 0; i < 8; ++i) ss += yv[i] * yv[i]; \
                ss += __shfl_xor(ss, 1); ss += __shfl_xor(ss, 2); ss += __shfl_xor(ss, 4); \
                const float rs = rsqrtf(ss * (1.f / 64.f) + EPS); \
                const float4 g0 = *(const float4*)(conv_a_g + c0), g1 = *(const float4*)(conv_a_g + c0 + 4); \
                u32x4_t w; w.x = dn::pkbf(yv[0] * rs * g0.x, yv[1] * rs * g0.y); w.y = dn::pkbf(yv[2] * rs * g0.z, yv[3] * rs * g0.w); w.z = dn::pkbf(yv[4] * rs * g1.x, yv[5] * rs * g1.y); w.w = dn::pkbf(yv[6] * rs * g1.z, yv[7] * rs * g1.w); \
                *(u32x4_t*)(ymix + (size_t)r * DM + c0) = w; } } } while (0)
    int* Loff = (int*)(lds_raw + LDS_TAB);
    int* Ltile = Loff + 64;
    int* Lend = Loff + 128;
    int* LsmE = Loff + 192;
    {
    LOADP();
    REP(0) {
    {
        float* scr = lds + wave * (64 * 33);
        constexpr int I_IN = (DM / 64) * (NPB / 32), I_OUT = (DM / 64) * (DM / 32);
        constexpr int I_G = NE * 16 * 16, I_D = NE * 8 * 32;
        for (int it = gw; it < I_IN + I_OUT; it += NGW) {
            int r = it;
            if (r < I_IN) { const int kb = r / (NPB / 32), nb = r % (NPB / 32); transpose_item(w_in, NPROJ, kb * 64, nb * 32, win_t, DM, nb * 32, scr, lane); continue; } r -= I_IN;
            { const int kb = r / (DM / 32), nb = r % (DM / 32); transpose_item(w_out, DM, kb * 64, nb * 32, wout_t, DM, nb * 32, scr, lane); }
        }
        float wx[4][4][8];
#pragma unroll
        for (int j = 0; j < 4; ++j)
#pragma unroll
            for (int i = 0; i < 4; ++i) { const float* wr_ = w_in + (size_t)(4 * lane + 256 * j + i) * NPROJ + NPB; const float4 w0 = *(const float4*)wr_, w1 = *(const float4*)(wr_ + 4);
                wx[j][i][0] = w0.x; wx[j][i][1] = w0.y; wx[j][i][2] = w0.z; wx[j][i][3] = w0.w; wx[j][i][4] = w1.x; wx[j][i][5] = w1.y; wx[j][i][6] = w1.z; wx[j][i][7] = w1.w; }
        const int hsel = (lane >> 3) & 3; const bool is_alpha = lane >= 32;
        const float aneg = -expf(dn_a_log[hsel]), dtb = dn_dt_bias[hsel];
        float4 vnx[4];
        if (gw < NTOK) {
#pragma unroll
            for (int j = 0; j < 4; ++j) vnx[j] = ((const float4*)(x + (size_t)gw * DM) + lane)[64 * j]; }
        for (int r = gw; r < NTOK; r += NGW) {
            float4 v[4]; float s = 0.f;
#pragma unroll
            for (int j = 0; j < 4; ++j) { v[j] = vnx[j]; s += v[j].x * v[j].x + v[j].y * v[j].y + v[j].z * v[j].z + v[j].w * v[j].w; }
            if (r + NGW < NTOK) {
#pragma unroll
                for (int j = 0; j < 4; ++j) vnx[j] = ((const float4*)(x + (size_t)(r + NGW) * DM) + lane)[64 * j]; }
            const float rs = rsqrtf(wave_sum(s) * (1.f / DM) + EPS);
            float dots[8];
#pragma unroll
            for (int c = 0; c < 8; ++c) dots[c] = 0.f;
            unsigned long long* o8 = (unsigned long long*)(hb + (size_t)r * DM) + lane;
#pragma unroll
            for (int j = 0; j < 4; ++j) { const float4 g = ((const float4*)mix_g)[lane + 64 * j];
                v[j].x *= rs * g.x; v[j].y *= rs * g.y; v[j].z *= rs * g.z; v[j].w *= rs * g.w;
                o8[64 * j] = (unsigned long long)pk2(v[j].x, v[j].y) | ((unsigned long long)pk2(v[j].z, v[j].w) << 32);
                const float hv[4] = {v[j].x, v[j].y, v[j].z, v[j].w};
#pragma unroll
                for (int i = 0; i < 4; ++i)
#pragma unroll
                    for (int c = 0; c < 8; ++c) dots[c] += hv[i] * wx[j][i][c]; }
            const float tot = reduce8_tr(dots, lane);
            if ((lane & 7) == 0) bg[(size_t)r * 8 + (lane >> 3)] = is_alpha ? aneg * softplus_f(tot + dtb) : sigmoid_f(tot);
        }
    }
    }
    SEAM()
    REP(1) {
        pg8::Gemm g{hb, DM, nullptr}; pg8::DenseOrder S; S.init(NTOK, NPB, DM, win_t, G, bid);
        pg8::EpiBf16 E{proj, NPB};
        pg8::gemm_phase<pg8::EpiBf16, pg8::DenseOrder, false, true>((PG8_LAS unsigned char*)lds_raw, g, S, E);
    }
    SEAM()
    REP(3) dn::prep(lds_raw, tid, bid, G, proj, bg, dn_conv_w, DB, [&](int item, int w4, int lane_) {
        const __attribute__((address_space(4))) Params* Q_ = (const __attribute__((address_space(4))) Params*)__builtin_amdgcn_kernarg_segment_ptr(); asm volatile("" : "+s"(Q_));
        unsigned char* ws_ = Q_->ws;
        float* scr_ = (float*)(lds_raw + dn::P2_END + w4 * 4608);
        const int s0 = (w4 < 2) ? 2 * w4 : 3 * w4 - 2, ns = (w4 < 2) ? 2 : 3;
        for (int s_ = 0; s_ < ns; ++s_) conv_item(item * CV_PREP + s0 + s_, Q_->in[13], Q_->in[14], Q_->in[15], (bf16_t*)(ws_ + WS_WGU), (bf16_t*)(ws_ + WS_WD), scr_, lane_);
    });
    SEAM()
    REP(4) {
    constexpr int NSU = 2 * BATCH * NH;
    if (bid >= NSU || G <= NSU) {
        float* scr = lds + wave * (64 * 33);
        constexpr int I_G = NE * 16 * 16, I_D = NE * 8 * 32;
        const int nw = (G <= NSU) ? NGW : (G - NSU) * 8, w0 = (G <= NSU) ? gw : gw - NSU * 8;
        for (int it = CV_PREP * (BATCH * NH * (SEQ / 64)) + w0; it < 2 * I_G + I_D; it += nw) conv_item(it, w_gate, w_up, w_down, wgu_t, wd_t, scr, lane);
        if (G > NSU) MIXA_ROWS(w0, nw);
    }
    unsigned* dnflags = (unsigned*)(ws + WS_CTL);
    if (bid < NSU || G <= NSU) dn::scan(lds_raw, tid, bid, G, DB, ymix, dnflags);
    if (bid >= NSU || G <= NSU) {
        typedef unsigned u32x4_t __attribute__((ext_vector_type(4)));
        const int c0 = lane * 8;
        const int nw = (G <= NSU) ? NGW : (G - NSU) * 8, w0 = (G <= NSU) ? gw : gw - NSU * 8;
        if (G <= NSU) MIXA_ROWS(gw, NGW);
        const int wq0 = ((G <= NSU) ? bid : bid - NSU) * 8;
        for (int q0 = wq0; q0 < NTOK / 4; q0 += nw) {
            const int q = q0 + wave;
            const int ch = q >> 7, bb = (q >> 4) & 7, i4 = q & 15;
            const int rbase = bb * SEQ + ch * 64 + i4 * 4;
            u32x4_t ovv[4], zvv[4];
#pragma unroll
            for (int t = 0; t < 4; ++t) zvv[t] = *(const u32x4_t*)(proj + (size_t)(rbase + t) * NPB + C_Z + c0);
            if (wave == 0) {
                unsigned* fl = dnflags + (bb * 32 + ch) * 32;
                for (unsigned spins = 0; spins < (1u << 21); ++spins) {
                    if ((unsigned)__builtin_amdgcn_readfirstlane(__hip_atomic_load(fl, __ATOMIC_RELAXED, __HIP_MEMORY_SCOPE_AGENT)) >= 32u) break;
                    __builtin_amdgcn_s_sleep(32);
                }
                __builtin_amdgcn_fence(__ATOMIC_ACQUIRE, "agent");
                asm volatile("s_waitcnt vmcnt(0)" ::: "memory");
            }
            __syncthreads();
#pragma unroll
            for (int t = 0; t < 4; ++t) {
                const int r = rbase + t;
                const int oi_ = r & 63, oitem_ = ((r / SEQ) * NH + (c0 >> 7)) * (SEQ / 64) + ((r % SEQ) >> 6);
                ovv[t] = *(const u32x4_t*)(DB.UT + ((size_t)oitem_ * 128 + (c0 & 112)) * 64 + (((oi_ >> 4) * 4 + (oi_ & 3)) * 4 + ((oi_ >> 2) & 3)) * 16 + (c0 & 15));
            }
#pragma unroll
            for (int t = 0; t < 4; ++t) {
                const int r = rbase + t;
                const u32x4_t ov = ovv[t], zv = zvv[t];
                float o[8] = {dn::lo_f(ov.x), dn::hi_f(ov.x), dn::lo_f(ov.y), dn::hi_f(ov.y), dn::lo_f(ov.z), dn::hi_f(ov.z), dn::lo_f(ov.w), dn::hi_f(ov.w)};
                const float z[8] = {dn::lo_f(zv.x), dn::hi_f(zv.x), dn::lo_f(zv.y), dn::hi_f(zv.y), dn::lo_f(zv.z), dn::hi_f(zv.z), dn::lo_f(zv.w), dn::hi_f(zv.w)};
                float ss = 0.f;
#pragma unroll
                for (int i = 0; i < 8; ++i) ss += o[i] * o[i];
                ss += __shfl_xor(ss, 1); ss += __shfl_xor(ss, 2); ss += __shfl_xor(ss, 4); ss += __shfl_xor(ss, 8);
                const float rs = rsqrtf(ss * (1.f / 128.f) + EPS);
                const float4 g0 = *(const float4*)(dn_norm_g + (c0 & 127)), g1 = *(const float4*)(dn_norm_g + (c0 & 127) + 4);
                const float gv[8] = {g0.x, g0.y, g0.z, g0.w, g1.x, g1.y, g1.z, g1.w};
#pragma unroll
                for (int i = 0; i < 8; ++i) o[i] = o[i] * rs * gv[i] * dn::silu_fast(z[i]);
                u32x4_t w; w.x = dn::pkbf(o[0], o[1]); w.y = dn::pkbf(o[2], o[3]); w.z = dn::pkbf(o[4], o[5]); w.w = dn::pkbf(o[6], o[7]);
                *(u32x4_t*)(ymix + (size_t)r * DM + 512 + c0) = w;
            }
        }
    }
    }
    SEAM()
    REP(5) {
        pg8::Gemm g{ymix, DM, nullptr}; pg8::DenseOrder S; S.init(NTOK, DM, DM, wout_t, G, bid);
        pg8::EpiResid E{x, x1, DM};
        pg8::gemm_phase<pg8::EpiResid, pg8::DenseOrder, false, false>((PG8_LAS unsigned char*)lds_raw, g, S, E);
    }
    SEAM()
    {
        {
            const float4* src = (const float4*)r_exp_w; float4* dst = (float4*)lds_raw;
            for (int i = tid; i < DM * 8; i += NT) { const int k = i >> 3, sl = i & 7; dst[k * 8 + (sl ^ (k & 7))] = src[i]; }
        }
        float4 wg[16];
#pragma unroll
        for (int j = 0; j < 16; ++j) wg[j] = *(const float4*)(r_group_w + (size_t)(lane + 64 * j) * 4);
        float gf[16];
#pragma unroll
        for (int j = 0; j < 16; ++j) gf[j] = ffn_g[lane + 64 * j];
        int* lcnt = (int*)(lds_raw + LDS_TAB + 2048);
        if (tid < NE) lcnt[tid] = 0;
        __syncthreads();
        float hnx[16];
        if (gw < NTOK) {
#pragma unroll
            for (int j = 0; j < 16; ++j) hnx[j] = bf2f(x1[(size_t)gw * DM + lane + 64 * j]); }
        for (int r = gw; r < NTOK; r += NGW) {
            float hv[16]; float s = 0.f;
#pragma unroll
            for (int j = 0; j < 16; ++j) { hv[j] = hnx[j]; s += hv[j] * hv[j]; }
            if (r + NGW < NTOK) {
#pragma unroll
                for (int j = 0; j < 16; ++j) hnx[j] = bf2f(x1[(size_t)(r + NGW) * DM + lane + 64 * j]); }
            const float rs = rsqrtf(wave_sum(s) * (1.f / DM) + EPS);
            float gl4[4] = {0.f, 0.f, 0.f, 0.f};
#pragma unroll
            for (int j = 0; j < 16; ++j) { hv[j] *= rs * gf[j]; h2b[(size_t)r * DM + lane + 64 * j] = (bf16_t)f2bf(hv[j]);
                gl4[0] += hv[j] * wg[j].x; gl4[1] += hv[j] * wg[j].y; gl4[2] += hv[j] * wg[j].z; gl4[3] += hv[j] * wg[j].w; }
            const float gt = reduce4_tr(gl4, lane);
            const float gl[4] = {lane_bcast(gt, 0), lane_bcast(gt, 16), lane_bcast(gt, 32), lane_bcast(gt, 48)};
            int gi = 0; float gm = gl[0];
#pragma unroll
            for (int g = 1; g < 4; ++g) if (gl[g] > gm) { gm = gl[g]; gi = g; }
            float gs = 0.f;
#pragma unroll
            for (int g = 0; g < 4; ++g) gs += expf(gl[g] - gm);
            const float gprob = 1.f / gs;
            float ed[8] = {0.f, 0.f, 0.f, 0.f, 0.f, 0.f, 0.f, 0.f};
#pragma unroll
            for (int j = 0; j < 16; ++j) { const int k = lane + 64 * j; const float4* row = (const float4*)lds_raw + k * 8;
                const float4 w0 = row[(2 * gi) ^ (k & 7)], w1 = row[(2 * gi + 1) ^ (k & 7)];
                ed[0] += hv[j] * w0.x; ed[1] += hv[j] * w0.y; ed[2] += hv[j] * w0.z; ed[3] += hv[j] * w0.w; ed[4] += hv[j] * w1.x; ed[5] += hv[j] * w1.y; ed[6] += hv[j] * w1.z; ed[7] += hv[j] * w1.w; }
            const float et = reduce8_tr(ed, lane);
            float el[8];
#pragma unroll
            for (int e = 0; e < 8; ++e) el[e] = lane_bcast(et, 8 * e);
            int i1 = 0; float m1 = el[0];
#pragma unroll
            for (int e = 1; e < 8; ++e) if (el[e] > m1) { m1 = el[e]; i1 = e; }
            int i2 = -1; float m2 = -INFINITY;
#pragma unroll
            for (int e = 0; e < 8; ++e) if (e != i1 && el[e] > m2) { m2 = el[e]; i2 = e; }
            const float p2 = expf(m2 - m1), inv = 1.f / (1.f + p2);
            if (lane == 0) {
                const int e1 = gi * 8 + i1, e2 = gi * 8 + i2;
                tok_e[2 * r] = e1; tok_e[2 * r + 1] = e2;
                tok_g[2 * r] = gprob * inv; tok_g[2 * r + 1] = gprob * p2 * inv;
                tok_p[2 * r] = atomicAdd(&lcnt[e1], 1); tok_p[2 * r + 1] = atomicAdd(&lcnt[e2], 1);
            }
        }
        __syncthreads();
        if (tid < NE) ((int*)(ws + WS_CNTB))[bid * NE + tid] = lcnt[tid];
    }
    SEAM()
    {
        const int* cntb = (const int*)(ws + WS_CNTB);
        int* red = (int*)(lds_raw + LDS_TAB + 4096);
        int* Lbase = (int*)(lds_raw + LDS_TAB + 2048);
        { const int e = tid & 31, part = tid >> 5; int sall = 0, sbef = 0;
          for (int b_ = part; b_ < G; b_ += 16) { const int v = cntb[b_ * NE + e]; sall += v; sbef += (b_ < bid) ? v : 0; }
          red[part * 32 + e] = sall; red[512 + part * 32 + e] = sbef; }
        __syncthreads();
        if (tid < NE) { int a = 0, b_ = 0; for (int q = 0; q < 16; ++q) { a += red[q * 32 + tid]; b_ += red[512 + q * 32 + tid]; } red[1024 + tid] = a; Lbase[tid] = b_; }
        __syncthreads();
        if (tid == 0) { int o = 0, tl = 0, ns = 0;
            for (int e = 0; e < NE; ++e) { Loff[e] = o; Ltile[e] = tl; const int c = red[1024 + e], full = c >> 8, rem = c & 255;
                if (rem > 128 || rem == 0) { tl += full + (rem ? 1 : 0); Lend[e] = o + c; }
                else { tl += full; Lend[e] = o + 256 * full; LsmE[ns++] = e; }
                o += c; }
            Loff[NE] = o; Ltile[NE] = tl; LsmE[63] = ns; }
        __syncthreads();
        for (int q = tid; q < 16 * (NTOK / (8 * G) + 1); q += NT) {
            const int w = (q >> 1) & 7, k = q >> 4, r = bid * 8 + w + NGW * k, i = 2 * r + (q & 1);
            if (r < NTOK) { const int e = tok_e[i]; const int sl = Loff[e] + Lbase[e] + tok_p[i]; slot_tok[sl] = r; tok_p[i] = sl; }
        }
    }
    SEAM()
    REP(7) {
        pg8::Gemm g{h2b, DM, slot_tok};
        pg8::GroupedOrder S{Loff, Ltile, Lend, LsmE, Ltile[NE] * 4, (Ltile[NE] + LsmE[63]) * 4, G, bid, (const char*)wgu_t, (size_t)DM * DM * 2, (size_t)256 * DM * 2};
        pg8::EpiAct E{act};
        pg8::gemm_phase<pg8::EpiAct, pg8::GroupedOrder, true, true>((PG8_LAS unsigned char*)lds_raw, g, S, E);
    }
    SEAM()
    REP(8) {
        pg8::Gemm g{act, FF, nullptr};
        pg8::GroupedOrder S{Loff, Ltile, Lend, LsmE, Ltile[NE] * 4, (Ltile[NE] + LsmE[63]) * 4, G, bid, (const char*)wd_t, (size_t)DM * FF * 2, (size_t)256 * FF * 2};
        pg8::EpiBf16 E{yexp, DM};
        pg8::gemm_phase<pg8::EpiBf16, pg8::GroupedOrder, false, true>((PG8_LAS unsigned char*)lds_raw, g, S, E);
    }
    SEAM()
    {
        const int nmine = (NTOK - gw + NGW - 1) / NGW;
        const float4* fg = (const float4*)final_g + lane;
        float4 gfin[4];
#pragma unroll
        for (int j = 0; j < 4; ++j) gfin[j] = fg[64 * j];
        for (int k0 = 0; k0 < nmine; k0 += 16) {
            const int kk = k0 + (lane & 15), rr = gw + NGW * (kk < nmine ? kk : k0);
            const int2 sv = *(const int2*)(tok_p + 2 * rr); const float2 gv = *(const float2*)(tok_g + 2 * rr);
            for (int k = k0; k < nmine && k < k0 + 16; k += 4) {
                int rT[4]; bool has[4]; int s0[4], s1[4]; float g0[4], g1[4];
#pragma unroll
                for (int t = 0; t < 4; ++t) { has[t] = k + t < nmine; const int l_ = has[t] ? k + t - k0 : k - k0; rT[t] = gw + NGW * (has[t] ? k + t : k);
                    s0[t] = __shfl(sv.x, l_); s1[t] = __shfl(sv.y, l_); g0[t] = __shfl(gv.x, l_); g1[t] = __shfl(gv.y, l_); }
                float4 xv[4][4]; uint2 ya[4][4], yb[4][4];
#pragma unroll
                for (int t = 0; t < 4; ++t)
#pragma unroll
                    for (int j = 0; j < 4; ++j) { { const uint2 xr_ = ((const uint2*)(x1 + (size_t)rT[t] * DM) + lane)[64 * j]; xv[t][j] = make_float4(dn::lo_f(xr_.x), dn::hi_f(xr_.x), dn::lo_f(xr_.y), dn::hi_f(xr_.y)); } ya[t][j] = ((const uint2*)(yexp + (size_t)s0[t] * DM) + lane)[64 * j]; yb[t][j] = ((const uint2*)(yexp + (size_t)s1[t] * DM) + lane)[64 * j]; }
                float ssum[4];
#pragma unroll
                for (int t = 0; t < 4; ++t) { float a_ = 0.f;
#pragma unroll
                    for (int j = 0; j < 4; ++j) {
                        xv[t][j] = make_float4(xv[t][j].x + g0[t] * dn::lo_f(ya[t][j].x) + g1[t] * dn::lo_f(yb[t][j].x), xv[t][j].y + g0[t] * dn::hi_f(ya[t][j].x) + g1[t] * dn::hi_f(yb[t][j].x),
                                               xv[t][j].z + g0[t] * dn::lo_f(ya[t][j].y) + g1[t] * dn::lo_f(yb[t][j].y), xv[t][j].w + g0[t] * dn::hi_f(ya[t][j].y) + g1[t] * dn::hi_f(yb[t][j].y));
                        a_ += xv[t][j].x * xv[t][j].x + xv[t][j].y * xv[t][j].y + xv[t][j].z * xv[t][j].z + xv[t][j].w * xv[t][j].w; }
                    ssum[t] = a_; }
#pragma unroll
                for (int o = 1; o < 64; o <<= 1) {
#pragma unroll
                    for (int t = 0; t < 4; ++t) ssum[t] += __shfl_xor(ssum[t], o); }
#pragma unroll
                for (int t = 0; t < 4; ++t) { if (has[t]) { const float rs = rsqrtf(ssum[t] * (1.f / DM) + EPS); float4* od = (float4*)(outp + (size_t)rT[t] * DM) + lane;
#pragma unroll
                    for (int j = 0; j < 4; ++j) od[64 * j] = make_float4(xv[t][j].x * rs * gfin[j].x, xv[t][j].y * rs * gfin[j].y, xv[t][j].z * rs * gfin[j].z, xv[t][j].w * rs * gfin[j].w); } }
            }
        }
    }
    }
}

extern "C" void kernel_launch(void* const* d_in, const int* in_sizes, int n_in, void* d_out, int out_size, void* d_ws, size_t ws_size, hipStream_t stream) {
    static int grid_blocks = 0;
    if (!grid_blocks) {
        int dev = 0, cus = 0, per_cu = 0;
        (void)hipGetDevice(&dev);
        (void)hipDeviceGetAttribute(&cus, hipDeviceAttributeMultiprocessorCount, dev);
        (void)hipFuncSetAttribute((const void*)fwd_kernel, hipFuncAttributeMaxDynamicSharedMemorySize, LDS_BYTES);
        (void)hipOccupancyMaxActiveBlocksPerMultiprocessor(&per_cu, (const void*)fwd_kernel, NT, LDS_BYTES);
        if (per_cu < 1) per_cu = 1;
        if (per_cu > 1 && 2 * LDS_BYTES > 160 * 1024) per_cu = 1;
        grid_blocks = cus * per_cu;
        fprintf(stderr, "kernel_launch: cus %d per_cu %d grid %d ws_size %zu\n", cus, per_cu, grid_blocks, ws_size);
    }
    (void)hipMemsetAsync((char*)d_ws + WS_CTL, 0, CTL_ZERO_BYTES, stream);
    Params p{};
    for (int i = 0; i < 17; ++i) p.in[i] = (const float*)d_in[i];
    p.out = (float*)d_out; p.ws = (unsigned char*)d_ws;
    hipLaunchKernelGGL(fwd_kernel, dim3(grid_blocks), dim3(NT), LDS_BYTES, stream, p);
    hipError_t e = hipPeekAtLastError();
    if (e != hipSuccess) fprintf(stderr, "launch failed: %s (grid %d)\n", hipGetErrorString(e), grid_blocks);
}
```

```cpp
#include <hip/hip_runtime.h>
#include <cstdio>
#include <cstdint>

constexpr int BATCH = 8, SEQ = 2048, DM = 1024, NTOK = BATCH * SEQ;
constexpr int NH = 4, HD = 128, NPROJ = 3592, NPB = 3584;
constexpr int C_AH = 0, C_AB = 512, C_AC = 1024, C_Q = 1536, C_K = 2048, C_V = 2560, C_Z = 3072;
constexpr int NE = 32, FF = 512;
constexpr float EPS = 1e-6f;
constexpr int NT = 512;
#ifndef REP_PHASE
#define REP_PHASE -1
#endif
#define REP(k) for (int rep_ = 0; rep_ < ((REP_PHASE == (k)) ? 2 : 1); ++rep_)
constexpr int LDS_BYTES = 144 * 1024;
constexpr int LDS_TAB = 131072;

typedef unsigned short bf16_t;
constexpr size_t MiB = 1u << 20;
constexpr size_t WS_CTL = 0;
constexpr size_t WS_BAR = 65536;
constexpr size_t CTL_ZERO_BYTES = 131072;
constexpr size_t WS_RSTD2 = 1 * MiB;
constexpr size_t WS_TOKE = WS_RSTD2 + 65536;
constexpr size_t WS_TOKG = WS_TOKE + 131072;
constexpr size_t WS_TOKP = WS_TOKG + 131072;
constexpr size_t WS_SLOTTOK = WS_TOKP + 131072;
constexpr size_t WS_GL = WS_SLOTTOK + 131072;
constexpr size_t WS_CNTB = WS_GL + 8192;
constexpr size_t WS_BG = 2 * MiB;
constexpr size_t WS_WIN = 3 * MiB;
constexpr size_t WS_WOUT = 10 * MiB;
constexpr size_t WS_WGU = 12 * MiB;
constexpr size_t WS_WD = 76 * MiB;
constexpr size_t WS_PROJ = 108 * MiB;
constexpr size_t WS_HB = 220 * MiB;
constexpr size_t WS_YMIX = 220 * MiB;
constexpr size_t WS_AQK = 252 * MiB;
constexpr size_t WS_X1B = 108 * MiB;
constexpr size_t WS_ACT = 140 * MiB;
constexpr size_t WS_YEXP = 173 * MiB;

struct Params { const float* in[17]; float* out; unsigned char* ws; };

__device__ __forceinline__ float wave_sum(float v) {
#pragma unroll
    for (int o = 1; o < 64; o <<= 1) v += __shfl_xor(v, o);
    return v;
}
__device__ __forceinline__ float silu_f(float x) { return x / (1.f + expf(-x)); }
__device__ __forceinline__ float sigmoid_f(float x) { return 1.f / (1.f + expf(-x)); }
__device__ __forceinline__ float softplus_f(float x) { return fmaxf(x, 0.f) + log1pf(expf(-fabsf(x))); }
__device__ __forceinline__ float bf2f(bf16_t h) { return __uint_as_float((unsigned)h << 16); }
typedef float f32x4_nt_t __attribute__((ext_vector_type(4)));
__device__ __forceinline__ float4 ldnt4(const float* p) { const f32x4_nt_t v = __builtin_nontemporal_load((const f32x4_nt_t*)p); return make_float4(v.x, v.y, v.z, v.w); }
__device__ __forceinline__ unsigned f2bf(float f) { unsigned u = __float_as_uint(f); return (u + 0x7fffu + ((u >> 16) & 1u)) >> 16; }
__device__ __forceinline__ unsigned pk2(float lo, float hi) { return f2bf(lo) | (f2bf(hi) << 16); }


__device__ __forceinline__ float reduce8_tr(const float (&v)[8], int lane) {
    float a[4], b[2];
#pragma unroll
    for (int i = 0; i < 4; ++i) { const bool hi = lane & 32; const float send = hi ? v[i] : v[i + 4], keep = hi ? v[i + 4] : v[i]; a[i] = keep + __shfl_xor(send, 32); }
#pragma unroll
    for (int i = 0; i < 2; ++i) { const bool hi = lane & 16; const float send = hi ? a[i] : a[i + 2], keep = hi ? a[i + 2] : a[i]; b[i] = keep + __shfl_xor(send, 16); }
    const bool hi = lane & 8; const float send = hi ? b[0] : b[1], keep = hi ? b[1] : b[0];
    float c = keep + __shfl_xor(send, 8);
    c += __shfl_xor(c, 4); c += __shfl_xor(c, 2); c += __shfl_xor(c, 1);
    return c;
}
__device__ __forceinline__ float reduce4_tr(const float (&v)[4], int lane) {
    float a[2];
#pragma unroll
    for (int i = 0; i < 2; ++i) { const bool hi = lane & 32; const float send = hi ? v[i] : v[i + 2], keep = hi ? v[i + 2] : v[i]; a[i] = keep + __shfl_xor(send, 32); }
    const bool hi = lane & 16; const float send = hi ? a[0] : a[1], keep = hi ? a[1] : a[0];
    float c = keep + __shfl_xor(send, 16);
    c += __shfl_xor(c, 8); c += __shfl_xor(c, 4); c += __shfl_xor(c, 2); c += __shfl_xor(c, 1);
    return c;
}
__device__ __forceinline__ float lane_bcast(float v, int src) { return __int_as_float(__builtin_amdgcn_readlane(__float_as_int(v), src)); }

namespace pg8 {
#define PG8_LAS __attribute__((address_space(3)))
typedef short bf16x8 __attribute__((ext_vector_type(8)));
typedef float f32x4 __attribute__((ext_vector_type(4)));
typedef unsigned u32x4 __attribute__((ext_vector_type(4)));
constexpr int BM = 256, BK = 64, HALF = 128, HTB = HALF * BK * 2, STAGE_BYTES = 8 * HTB, NXCD = 8, WGM = 4;

__host__ __device__ __forceinline__ int lds_byte(int r, int c) { const int st = (r >> 4) * 2 + (c >> 5), rr = r & 15, cc = c & 31, ob = rr * 64 + cc * 2; return st * 1024 + (ob ^ (((ob >> 9) & 1) << 5)); }
__host__ __device__ __forceinline__ void stage_rc(int b, int& R, int& C) { const int st = b / 1024, sb = b % 1024, swz = sb ^ (((sb >> 9) & 1) << 5); R = (st >> 1) * 16 + swz / 64; C = (st & 1) * 32 + (swz % 64) / 2; }
__host__ __device__ __forceinline__ int perm32(int rho) { const int n = rho >> 4, i = rho & 15; return 8 * (i >> 2) + 4 * n + (i & 3); }

struct Unit { int arow0, rowend, pn, half; const char* B; };
struct Gemm { const bf16_t* A; int K; const int* gidx; };

struct DenseOrder {
    int nM, nN, nwg, G, c, M, nfull, tail; const char* Bt; size_t tstep;
    __device__ void init(int M_, int N, int K, const bf16_t* Bt_, int G_, int c_) { M = M_; nM = M / BM; nN = N / BM; nwg = nM * nN; G = G_; c = c_; Bt = (const char*)Bt_; tstep = (size_t)BM * K * 2;
        nfull = (nwg / G) * G; tail = nwg - nfull; if (2 * tail > G) { nfull = nwg; tail = 0; } }
    __device__ bool next(int i, Unit& u) const {
        const long L = (long)i * G + c; int wgid, hs = -1;
        if (L < nfull) wgid = (int)L;
        else { const long hu = L - nfull; if (hu >= 2 * tail) return false; wgid = nfull + (int)(hu % tail); hs = (int)(hu / tail); }
        { const int q = nwg / NXCD, r = nwg % NXCD, xcd = wgid % NXCD, off = wgid / NXCD; wgid = (xcd < r ? xcd * (q + 1) : r * (q + 1) + (xcd - r) * q) + off; }
        const int nig = WGM * nN, gid = wgid / nig, fm = gid * WGM, gsz = (nM - fm) < WGM ? (nM - fm) : WGM;
        const int pm = fm + ((wgid % nig) % gsz); u.pn = (wgid % nig) / gsz; u.B = Bt + (size_t)u.pn * tstep;
        if (hs < 0) { u.arow0 = pm * BM; u.rowend = M; u.half = 0; } else { u.arow0 = pm * BM + HALF * hs; u.rowend = u.arow0 + HALF; u.half = 1; }
        return true;
    }
};

typedef __bf16 bf16x2_t __attribute__((ext_vector_type(2)));
typedef float f32x2_t __attribute__((ext_vector_type(2)));
__device__ __forceinline__ unsigned cvt_pk_bf16(float lo, float hi) { const f32x2_t v = {lo, hi}; return __builtin_bit_cast(unsigned, __builtin_convertvector(v, bf16x2_t)); }

struct EpiBf16 {
    static constexpr bool PERM = true;
    bf16_t* O; int ldc;
    __device__ __forceinline__ void operator()(const f32x4 (&acc)[2][2][4][2], const Unit& u, int wr, int wc, int fr, int fq) const {
        const int row0 = u.arow0 + wr * 64 + fr, col0 = u.pn * BM + wc * 32 + 8 * fq;
#pragma unroll
        for (int ai = 0; ai < 2; ++ai)
#pragma unroll
            for (int m = 0; m < 4; ++m) { const int row = row0 + ai * HALF + m * 16; bf16_t* rowp = O + (size_t)row * ldc + col0;
                if (row < u.rowend) {
#pragma unroll
                    for (int bj = 0; bj < 2; ++bj) { const f32x4 v0 = acc[ai][bj][m][0], v1 = acc[ai][bj][m][1];
                        u32x4 w; w.x = cvt_pk_bf16(v0[0], v0[1]); w.y = cvt_pk_bf16(v0[2], v0[3]); w.z = cvt_pk_bf16(v1[0], v1[1]); w.w = cvt_pk_bf16(v1[2], v1[3]);
                        *(u32x4*)(rowp + bj * HALF) = w; } } }
    }
};
struct EpiResid {
    static constexpr bool PERM = true;
    const float* base; bf16_t* C; int ldc;
    __device__ __forceinline__ void operator()(const f32x4 (&acc)[2][2][4][2], const Unit& u, int wr, int wc, int fr, int fq) const {
        const int row0 = u.arow0 + wr * 64 + fr, col0 = u.pn * BM + wc * 32 + 8 * fq;
#pragma unroll
        for (int ai = 0; ai < 2; ++ai) {
            f32x4 bv[4][2][2];
#pragma unroll
            for (int m = 0; m < 4; ++m) { const size_t off = (size_t)(row0 + ai * HALF + m * 16) * ldc + col0;
#pragma unroll
                for (int bj = 0; bj < 2; ++bj)
#pragma unroll
                    for (int n = 0; n < 2; ++n) bv[m][bj][n] = __builtin_nontemporal_load((const f32x4*)(base + off + bj * HALF + n * 4)); }
#pragma unroll
            for (int m = 0; m < 4; ++m) { const size_t off = (size_t)(row0 + ai * HALF + m * 16) * ldc + col0;
#pragma unroll
                for (int bj = 0; bj < 2; ++bj) { const f32x4 v0 = bv[m][bj][0] + acc[ai][bj][m][0], v1 = bv[m][bj][1] + acc[ai][bj][m][1];
                    u32x4 w; w.x = cvt_pk_bf16(v0[0], v0[1]); w.y = cvt_pk_bf16(v0[2], v0[3]); w.z = cvt_pk_bf16(v1[0], v1[1]); w.w = cvt_pk_bf16(v1[2], v1[3]);
                    *(u32x4*)(C + off + bj * HALF) = w; } }
        }
    }
};
struct EpiAct {
    static constexpr bool PERM = true;
    bf16_t* O;
    __device__ __forceinline__ void operator()(const f32x4 (&acc)[2][2][4][2], const Unit& u, int wr, int wc, int fr, int fq) const {
        const int row0 = u.arow0 + wr * 64 + fr, col0 = u.pn * HALF + wc * 32 + 8 * fq;
        const __amdgpu_buffer_rsrc_t orsrc = __builtin_amdgcn_make_buffer_rsrc(O, 0, (32768 + 256) * 512 * 2, 0x00020000);
#pragma unroll
        for (int ai = 0; ai < 2; ++ai)
#pragma unroll
            for (int m = 0; m < 4; ++m) { const int row = row0 + ai * HALF + m * 16;
                if (row < u.rowend) { float v[8];
#pragma unroll
                    for (int n = 0; n < 2; ++n)
#pragma unroll
                        for (int j = 0; j < 4; ++j) { const float gt = acc[ai][0][m][n][j], up = acc[ai][1][m][n][j]; v[n * 4 + j] = gt * __builtin_amdgcn_rcpf(1.f + __builtin_amdgcn_exp2f(-1.4426950408889634f * gt)) * up; }
                    u32x4 w; w.x = cvt_pk_bf16(v[0], v[1]); w.y = cvt_pk_bf16(v[2], v[3]); w.z = cvt_pk_bf16(v[4], v[5]); w.w = cvt_pk_bf16(v[6], v[7]);
                    __builtin_amdgcn_raw_buffer_store_b128(w, orsrc, (unsigned)(row * 512 + col0) * 2u, 0, 16  ); } }
    }
};
struct GroupedOrder {
    const int* Loff; const int* Ttile; const int* Lend; const int* LsmE; int nfullu, nunits, G, c; const char* Bt; size_t estride, tstep; int mode;
    __device__ bool next(int i, Unit& u) const {
        int L = (G == 256) ? ((i * 8 + (c & 7)) * 32 + (c >> 3)) : (i * G + c);
        if (mode == 2) { if (i > 0) return false; L = nfullu + (7 - (c & 7)) * 32 + (c >> 3); }
        if (L >= (mode == 1 ? nfullu : nunits)) return false;
        u.pn = L & 3;
        if (L < nfullu) { const int tile = L >> 2; int e = 0; while (Ttile[e + 1] <= tile) ++e;
            u.arow0 = Loff[e] + (tile - Ttile[e]) * BM; u.rowend = Lend[e]; u.half = 0; u.B = Bt + (size_t)e * estride + (size_t)u.pn * tstep; }
        else { const int e = LsmE[(L - nfullu) >> 2]; u.arow0 = Lend[e]; u.rowend = Loff[e + 1]; u.half = 1; u.B = Bt + (size_t)e * estride + (size_t)u.pn * tstep; }
        return true;
    }
};

template <class Epi, class Sched, bool GATHER, bool ALIGN_EPI>
__device__ __forceinline__ void gemm_phase(PG8_LAS unsigned char* lds, const Gemm g, const Sched& S, const Epi& E) {
    int tid = threadIdx.x; asm volatile("" : "+v"(tid));
    const int wid = __builtin_amdgcn_readfirstlane(tid >> 6), lane = tid & 63, wr = wid >> 2, wc = wid & 3, fr = lane & 15, fq = lane >> 4;
    const int K = g.K, nt = K / BK;
    int RA[2], CA[2]; unsigned voffB[2];
#pragma unroll
    for (int i = 0; i < 2; ++i) { int R, C; stage_rc(tid * 16 + i * 8192, R, C); const int Rb = Epi::PERM ? ((R & ~31) + perm32(R & 31)) : R;
        RA[i] = R; CA[i] = C; voffB[i] = (unsigned)(Rb * K + C) * 2u; }
    const size_t kstep = (size_t)(BK * 2);
    const size_t hstep = (size_t)HALF * K * 2;
    const unsigned ldsw = (unsigned)wid * 1024u;
    const int aoff = lds_byte(wr * 64 + fr, fq * 8), boff = lds_byte(wc * 32 + fr, fq * 8);
    const char* A0 = (const char*)g.A;
#define PG8_SA(b, h) (((b) * 2 + (h)) * HTB)
#define PG8_SB(b, h) ((4 + (b) * 2 + (h)) * HTB)
#define PG8_STAGE(bufoff, gbase, voff) do { _Pragma("unroll") for (int _i = 0; _i < 2; ++_i) \
        __builtin_amdgcn_global_load_lds((const unsigned*)((const char*)(gbase) + (voff)[_i]), (PG8_LAS unsigned*)(lds + (bufoff) + ldsw + _i * 8192), 16, 0, 0); } while (0)
#define PG8_LDA(dst, b, h) do { _Pragma("unroll") for (int m = 0; m < 4; ++m) _Pragma("unroll") for (int k = 0; k < 2; ++k) dst[m][k] = *(const PG8_LAS bf16x8*)(lds + PG8_SA(b, h) + aoff + m * 2048 + k * 1024); } while (0)
#define PG8_LDB(dst, b, h) do { _Pragma("unroll") for (int n = 0; n < 2; ++n) _Pragma("unroll") for (int k = 0; k < 2; ++k) dst[n][k] = *(const PG8_LAS bf16x8*)(lds + PG8_SB(b, h) + boff + n * 2048 + k * 1024); } while (0)
#define PG8_MMA(ai, bj, At, Bt) do { __builtin_amdgcn_s_setprio(1); _Pragma("unroll") for (int m = 0; m < 4; ++m) _Pragma("unroll") for (int n = 0; n < 2; ++n) _Pragma("unroll") for (int k = 0; k < 2; ++k) \
        acc[ai][bj][m][n] = __builtin_amdgcn_mfma_f32_16x16x32_bf16(Bt[n][k], At[m][k], acc[ai][bj][m][n], 0, 0, 0); __builtin_amdgcn_s_setprio(0); } while (0)
#define PG8_WAIT_V(n) asm volatile("s_waitcnt vmcnt(" #n ")" ::: "memory")
#define PG8_WAIT_L(n) asm volatile("s_waitcnt lgkmcnt(" #n ")" ::: "memory")
#define PG8_BAR __builtin_amdgcn_s_barrier()
#define PG8_SCHED __builtin_amdgcn_sched_barrier(0)
#define PG8_AOFF(dst, u) do { _Pragma("unroll") for (int _h = 0; _h < 2; ++_h) _Pragma("unroll") for (int _i = 0; _i < 2; ++_i) { int _r = (u).arow0 + _h * HALF + RA[_i]; _r = _r < (u).rowend ? _r : (u).rowend - 1; \
        if (GATHER) _r = g.gidx[_r]; dst[_h][_i] = (unsigned)(_r * K + CA[_i]) * 2u; } } while (0)
    Unit cur, nxt; int ui = 0;
    if (!S.next(0, cur)) return;
    f32x4 acc[2][2][4][2];
#pragma unroll
    for (int a = 0; a < 2; ++a)
#pragma unroll
        for (int b = 0; b < 2; ++b)
#pragma unroll
            for (int m = 0; m < 4; ++m)
#pragma unroll
                for (int n = 0; n < 2; ++n) acc[a][b][m][n] = (f32x4){0.f, 0.f, 0.f, 0.f};
    bf16x8 At[4][2], B0[2][2], B1[2][2];
    unsigned cvA[2][2], nvA[2][2];
    PG8_AOFF(cvA, cur);
    const char* cB = cur.B;
    PG8_STAGE(PG8_SB(0, 0), cB, voffB); PG8_STAGE(PG8_SB(0, 1), cB + hstep, voffB); PG8_STAGE(PG8_SA(0, 0), A0, cvA[0]); PG8_STAGE(PG8_SA(0, 1), A0, cvA[1]);
    if (wr == 1) PG8_BAR;
    PG8_WAIT_V(2); PG8_BAR;
    PG8_STAGE(PG8_SB(1, 0), cB + kstep, voffB); PG8_STAGE(PG8_SA(1, 0), A0 + kstep, cvA[0]); PG8_STAGE(PG8_SB(1, 1), cB + hstep + kstep, voffB);
    PG8_WAIT_V(6); PG8_BAR;
    for (;;) {
        const bool has_next = S.next(ui + 1, nxt);
        if (has_next) { PG8_AOFF(nvA, nxt); } else {
#pragma unroll
            for (int h = 0; h < 2; ++h)
#pragma unroll
                for (int i = 0; i < 2; ++i) nvA[h][i] = cvA[h][i]; }
        const char* nB = has_next ? nxt.B : cB;
        for (int t = 0; t < nt; t += 2) {
            const bool last = (t == nt - 2);
            const char* a1 = A0 + (size_t)(t + 1) * kstep;
            const char* a2 = last ? A0 : A0 + (size_t)(t + 2) * kstep; const char* b2 = last ? nB : cB + (size_t)(t + 2) * kstep;
            const char* a3 = a2 + kstep; const char* b3 = b2 + kstep;
            unsigned s2[2][2];
#pragma unroll
            for (int h = 0; h < 2; ++h)
#pragma unroll
                for (int i = 0; i < 2; ++i) s2[h][i] = last ? nvA[h][i] : cvA[h][i];
            PG8_LDB(B0, 0, 0); PG8_LDB(B1, 0, 1); PG8_SCHED; PG8_LDA(At, 0, 0); PG8_STAGE(PG8_SA(1, 1), a1, cvA[1]);
            PG8_WAIT_V(8); PG8_WAIT_L(0); PG8_BAR; PG8_MMA(0, 0, At, B0); PG8_MMA(0, 1, At, B1); PG8_BAR; PG8_SCHED;
            PG8_LDA(At, 0, 1); PG8_STAGE(PG8_SB(0, 0), b2, voffB); PG8_STAGE(PG8_SB(0, 1), b2 + hstep, voffB); PG8_STAGE(PG8_SA(0, 0), a2, s2[0]);
            PG8_WAIT_V(8); PG8_WAIT_L(0); PG8_BAR; if (!cur.half) { PG8_MMA(1, 0, At, B0); PG8_MMA(1, 1, At, B1); } PG8_BAR; PG8_SCHED;
            PG8_LDB(B0, 1, 0); PG8_LDB(B1, 1, 1); PG8_SCHED; PG8_LDA(At, 1, 0); PG8_STAGE(PG8_SA(0, 1), a2, s2[1]);
            PG8_WAIT_V(8); PG8_WAIT_L(0); PG8_BAR; PG8_MMA(0, 0, At, B0); PG8_MMA(0, 1, At, B1); PG8_BAR; PG8_SCHED;
            PG8_LDA(At, 1, 1); PG8_STAGE(PG8_SB(1, 0), b3, voffB); PG8_STAGE(PG8_SB(1, 1), b3 + hstep, voffB); PG8_STAGE(PG8_SA(1, 0), a3, s2[0]);
            PG8_WAIT_V(8); PG8_WAIT_L(0); PG8_BAR; if (!cur.half) { PG8_MMA(1, 0, At, B0); PG8_MMA(1, 1, At, B1); } PG8_BAR; PG8_SCHED;
        }
        if constexpr (ALIGN_EPI) { if (wr == 0) PG8_BAR; }
        E(acc, cur, wr, wc, fr, fq);
        if (!has_next) break;
#pragma unroll
        for (int a = 0; a < 2; ++a)
#pragma unroll
            for (int b = 0; b < 2; ++b)
#pragma unroll
                for (int m = 0; m < 4; ++m)
#pragma unroll
                    for (int n = 0; n < 2; ++n) acc[a][b][m][n] = (f32x4){0.f, 0.f, 0.f, 0.f};
        cur = nxt; cB = nB; ++ui;
#pragma unroll
        for (int h = 0; h < 2; ++h)
#pragma unroll
            for (int i = 0; i < 2; ++i) cvA[h][i] = nvA[h][i];
        if constexpr (ALIGN_EPI) { if (wr == 1) PG8_BAR; }
    }
    PG8_WAIT_V(0);
    if constexpr (!ALIGN_EPI) { if (wr == 0) PG8_BAR; }
    PG8_BAR;
#undef PG8_SA
#undef PG8_SB
#undef PG8_STAGE
#undef PG8_LDA
#undef PG8_LDB
#undef PG8_MMA
#undef PG8_WAIT_V
#undef PG8_WAIT_L
#undef PG8_BAR
#undef PG8_SCHED
#undef PG8_AOFF
}
}


namespace dn {
typedef short bf16x8 __attribute__((ext_vector_type(8)));
typedef float f32x4 __attribute__((ext_vector_type(4)));
typedef unsigned u32x4 __attribute__((ext_vector_type(4)));
typedef unsigned u32x2 __attribute__((ext_vector_type(2)));
__device__ __forceinline__ int perm_pos(int kl) { return 8 * ((kl >> 2) & 3) + 4 * (kl >> 4) + (kl & 3); }
__device__ __forceinline__ int perm_inv(int p) { return 16 * ((p >> 2) & 1) + 4 * (p >> 3) + (p & 3); }
typedef __bf16 bf16x2_t __attribute__((ext_vector_type(2)));
typedef float f32x2_t __attribute__((ext_vector_type(2)));
__device__ __forceinline__ unsigned pkbf(float lo, float hi) { const f32x2_t v = {lo, hi}; return __builtin_bit_cast(unsigned, __builtin_convertvector(v, bf16x2_t)); }
__device__ __forceinline__ float lo_f(unsigned u) { return __uint_as_float(u << 16); }
__device__ __forceinline__ float hi_f(unsigned u) { return __uint_as_float(u & 0xffff0000u); }
constexpr int P2_LT = 0, P2_G = 16384, P2_QB = 17408, P2_KB = P2_QB + 17408, P2_RU = P2_KB + 17408, P2_RW = P2_RU + 32768;
constexpr int ROWB = 272;

struct DnBufs { bf16_t* UT; bf16_t* WN; bf16_t* QD; bf16_t* KDT; bf16_t* AQK; float* GL; };

__device__ __forceinline__ float silu_fast(float a) { return a * __builtin_amdgcn_rcpf(1.f + __builtin_amdgcn_exp2f(-1.4426950408889634f * a)); }
constexpr int P2_END = P2_RW + 32768;
template <class Hook>
__device__ __forceinline__ void prep(unsigned char* lds, int tid, int bid, int G, const bf16_t* proj, const float* bg, const float* dn_conv_w, const DnBufs B, Hook hook) {
    const int lane = tid & 63, wave = tid >> 6;
    float* RU = (float*)(lds + P2_RU); float* RW = (float*)(lds + P2_RW); float* LT = (float*)(lds + P2_LT); float* GS = (float*)(lds + P2_G);
    const int nitems = BATCH * NH * (SEQ / 64);
    const int r0 = wave * 8;
    unsigned xin[11][3]; float gin, bin;
#define DN_PREP_LOAD(item_) do { const int bh_ = (item_) >> 5, c_ = (item_) & 31, b_ = bh_ >> 2, h_ = bh_ & 3, t0_ = c_ * 64; \
        _Pragma("unroll") for (int rr = 0; rr < 11; ++rr) { const int t = t0_ + r0 + rr - 3; \
            _Pragma("unroll") for (int wh = 0; wh < 3; ++wh) { const unsigned v_ = *(const unsigned*)(proj + ((size_t)b_ * SEQ + (t >= 0 ? t : 0)) * NPB + C_Q + wh * 512 + h_ * 128 + 2 * lane); xin[rr][wh] = (t >= 0) ? v_ : 0u; } } \
        gin = bg[((size_t)b_ * SEQ + t0_ + lane) * 8 + 4 + h_]; bin = bg[((size_t)b_ * SEQ + t0_ + lane) * 8 + h_]; } while (0)
    if (bid < nitems) DN_PREP_LOAD(bid);
    for (int item = bid; item < nitems; item += G) {
        const int bh = item >> 5, h = bh & 3;
        float cw[3][4][2];
#pragma unroll
        for (int wh = 0; wh < 3; ++wh)
#pragma unroll
            for (int j = 0; j < 4; ++j) { const float2 w2 = *(const float2*)(dn_conv_w + j * 1536 + wh * 512 + h * 128 + 2 * lane); cw[wh][j][0] = w2.x; cw[wh][j][1] = w2.y; }
        float Gc = gin;
#pragma unroll
        for (int o = 1; o < 64; o <<= 1) { const float t = __shfl_up(Gc, o); if (lane >= o) Gc += t; }
        const float glast = __shfl(Gc, 63), eGl = __expf(Gc), bel = bin;
        if (wave == 0) { GS[lane] = Gc; GS[64 + lane] = eGl; GS[128 + lane] = bel; GS[192 + lane] = __expf(glast - Gc); if (lane == 0) B.GL[item] = glast; }
#pragma unroll
        for (int rr = 0; rr < 8; ++rr) {
            const int i = r0 + rr;
            float val[3][2];
#pragma unroll
            for (int wh = 0; wh < 3; ++wh) { float a0 = 0.f, a1 = 0.f;
#pragma unroll
                for (int j = 0; j < 4; ++j) { a0 += lo_f(xin[rr + j][wh]) * cw[wh][j][0]; a1 += hi_f(xin[rr + j][wh]) * cw[wh][j][1]; }
                val[wh][0] = silu_fast(a0); val[wh][1] = silu_fast(a1); }
            float sq = val[0][0] * val[0][0] + val[0][1] * val[0][1], sk = val[1][0] * val[1][0] + val[1][1] * val[1][1];
#pragma unroll
            for (int o = 1; o < 64; o <<= 1) { sq += __shfl_xor(sq, o); sk += __shfl_xor(sk, o); }
            const float fq = rsqrtf(sq + EPS) * 0.08838834764831845f, fk = rsqrtf(sk + EPS);
            const float eG = __shfl(eGl, i), be = __shfl(bel, i);
            const float q0 = val[0][0] * fq, q1 = val[0][1] * fq, k0 = val[1][0] * fk, k1 = val[1][1] * fk;
            *(unsigned*)(lds + P2_QB + i * ROWB + 4 * lane) = pkbf(q0, q1);
            *(unsigned*)(lds + P2_KB + i * ROWB + 4 * lane) = pkbf(k0, k1);
            const int kl = (2 * lane) & 31, pos = ((2 * lane) & ~31) + perm_pos(kl);
            *(unsigned*)(B.QD + ((size_t)item * 64 + i) * 128 + pos) = pkbf(q0 * eG, q1 * eG);
            *(float2*)(RW + i * 128 + 2 * lane) = make_float2(be * eG * k0, be * eG * k1);
            *(float2*)(RU + i * 128 + 2 * lane) = make_float2(be * val[2][0], be * val[2][1]);
        }
        __syncthreads();
        {
            const int g = lane >> 4, cl = lane & 15, mi = wave >> 1, nj0 = 2 * (wave & 1);
            bf16x8 ka[4], qa[4];
#pragma unroll
            for (int s_ = 0; s_ < 4; ++s_) { ka[s_] = *(const bf16x8*)(lds + P2_KB + (16 * mi + cl) * ROWB + (32 * s_ + 8 * g) * 2); qa[s_] = *(const bf16x8*)(lds + P2_QB + (16 * mi + cl) * ROWB + (32 * s_ + 8 * g) * 2); }
#pragma unroll
            for (int nn = 0; nn < 2; ++nn) {
                const int nj = nj0 + nn;
                f32x4 akk = {0.f, 0.f, 0.f, 0.f}, aqk = {0.f, 0.f, 0.f, 0.f};
#pragma unroll
                for (int s_ = 0; s_ < 4; ++s_) { const bf16x8 kb = *(const bf16x8*)(lds + P2_KB + (16 * nj + cl) * ROWB + (32 * s_ + 8 * g) * 2);
                    akk = __builtin_amdgcn_mfma_f32_16x16x32_bf16(ka[s_], kb, akk, 0, 0, 0); aqk = __builtin_amdgcn_mfma_f32_16x16x32_bf16(qa[s_], kb, aqk, 0, 0, 0); }
                const int j = 16 * nj + cl; const float Gj = GS[j];
                float lt[4];
                const int jpos = (j & ~31) + perm_pos(j & 31);
#pragma unroll
                for (int x_ = 0; x_ < 4; ++x_) { const int i = 16 * mi + 4 * g + x_; const float dec = __expf(fminf(GS[i] - Gj, 0.f));
                    lt[x_] = (i > j) ? GS[128 + i] * akk[x_] * dec : 0.f;
                    const float a = (i >= j) ? aqk[x_] * dec : 0.f;
                    B.AQK[((size_t)item * 64 + i) * 64 + jpos] = (bf16_t)(pkbf(a, 0.f) & 0xffffu); }
                *(float4*)(LT + j * 64 + 16 * mi + 4 * g) = make_float4(lt[0], lt[1], lt[2], lt[3]);
            }
        }
        __syncthreads();
        if (item + G < nitems) DN_PREP_LOAD(item + G);
        if (tid < 256) {
            const float* src = (tid < 128) ? (RU + tid) : (RW + (tid - 128));
            typedef __attribute__((address_space(3))) float lds_f32;
            const lds_f32* LTp = (const lds_f32*)(LT); asm volatile("" : "+v"(LTp));
            typedef float f32x2_s __attribute__((ext_vector_type(2)));
            f32x2_s acc2[32];
#pragma unroll
            for (int i = 0; i < 32; ++i) { acc2[i].x = src[(2 * i) * 128]; acc2[i].y = src[(2 * i + 1) * 128]; }
#pragma unroll
            for (int j = 0; j < 63; ++j) {
                const float xj = (j & 1) ? acc2[j >> 1].y : acc2[j >> 1].x;
                const f32x2_s nx2 = {-xj, -xj};
#pragma unroll
                for (int q = (j + 1) >> 2; q < 16; ++q) {
                    const f32x4 l4 = *(const __attribute__((address_space(3))) f32x4*)(LTp + j * 64 + 4 * q);
                    if (4 * q > j) { acc2[2 * q] = __builtin_elementwise_fma((f32x2_s){l4.x, l4.y}, nx2, acc2[2 * q]); acc2[2 * q + 1] = __builtin_elementwise_fma((f32x2_s){l4.z, l4.w}, nx2, acc2[2 * q + 1]); }
                    else {
                        if (4 * q + 1 > j) acc2[2 * q].y -= l4.y * xj;
                        if (4 * q + 2 > j) acc2[2 * q + 1].x -= l4.z * xj;
                        if (4 * q + 3 > j) acc2[2 * q + 1].y -= l4.w * xj;
                    }
                }
            }
            float acc[64];
#pragma unroll
            for (int i = 0; i < 32; ++i) { acc[2 * i] = acc2[i].x; acc[2 * i + 1] = acc2[i].y; }
            if (tid < 128) {
                u32x4* dst = (u32x4*)(B.UT + ((size_t)item * 128 + tid) * 64);
#pragma unroll
                for (int q = 0; q < 8; ++q) { u32x4 w; w.x = pkbf(acc[8 * q], acc[8 * q + 1]); w.y = pkbf(acc[8 * q + 2], acc[8 * q + 3]); w.z = pkbf(acc[8 * q + 4], acc[8 * q + 5]); w.w = pkbf(acc[8 * q + 6], acc[8 * q + 7]); dst[q] = w; }
            } else {
                const int dk = tid - 128, pos = (dk & ~31) + perm_pos(dk & 31);
                bf16_t* dst = B.WN + (size_t)item * 64 * 128 + pos;
#pragma unroll
                for (int i = 0; i < 64; ++i) dst[i * 128] = (bf16_t)(pkbf(-acc[i], 0.f) & 0xffffu);
            }
        } else if (tid < 384) {
            const int dk = tid - 256;
            u32x4* dst = (u32x4*)(B.KDT + ((size_t)item * 128 + dk) * 64);
#pragma unroll
            for (int q = 0; q < 8; ++q) { float v[8];
#pragma unroll
                for (int e = 0; e < 8; ++e) { const int p_ = 8 * q + e, i = (p_ & ~31) + perm_inv(p_ & 31); v[e] = bf2f(*(const bf16_t*)(lds + P2_KB + i * ROWB + 2 * dk)) * GS[192 + i]; }
                u32x4 w; w.x = pkbf(v[0], v[1]); w.y = pkbf(v[2], v[3]); w.z = pkbf(v[4], v[5]); w.w = pkbf(v[6], v[7]); dst[q] = w; }
        }
        if (tid >= 256) hook(item, wave - 4, lane);
        __syncthreads();
    }
#undef DN_PREP_LOAD
}

constexpr int SROW = 288, SKROW = 160;
constexpr int SC_WN = 0, SC_QD = 64 * SROW, SC_KDT = 128 * SROW, SC_AQK = SC_KDT + 128 * SKROW, SC_BUF = SC_AQK + 64 * SKROW  , SC_OT = 2048;
__device__ __forceinline__ void scan(unsigned char* lds, int tid, int bid, int G, const DnBufs B, bf16_t* ymix, unsigned* flags) {
    const int lane = tid & 63, wave = __builtin_amdgcn_readfirstlane(tid >> 6), g = lane >> 4, cl = lane & 15;
#define DN_BAR() do { asm volatile("s_waitcnt lgkmcnt(0)" ::: "memory"); __builtin_amdgcn_s_barrier(); asm volatile("" ::: "memory"); } while (0)
    for (int unit = bid; unit < 2 * BATCH * NH; unit += G) {
        const int bh = (unit & 7) | ((unit >> 4) << 3), uhalf = (unit >> 3) & 1;
        __syncthreads();
        if (wave < 4) {
            const int wdv = 4 * uhalf + wave, dv = 16 * wdv + cl;
            f32x4 S[8]; bf16x8 Sb[4];
#pragma unroll
            for (int r = 0; r < 8; ++r) S[r] = (f32x4){0.f, 0.f, 0.f, 0.f};
#pragma unroll
            for (int s_ = 0; s_ < 4; ++s_) Sb[s_] = (bf16x8){0, 0, 0, 0, 0, 0, 0, 0};
            const float eglv = __expf(B.GL[bh * 32 + (lane & 31)]);
            u32x2 uA[4], uB[4];
            f32x4 vn[4];
#define DN_LOAD_U(upre, c_) do { const size_t it_ = (size_t)(bh * 32 + (c_)); \
            _Pragma("unroll") for (int m_ = 0; m_ < 4; ++m_) upre[m_] = *(const u32x2*)(B.UT + (it_ * 128 + dv) * 64 + 16 * m_ + 4 * g); } while (0)
#define DN_VN(upre) do { _Pragma("unroll") for (int m = 0; m < 4; ++m) vn[m] = (f32x4){lo_f(upre[m].x), hi_f(upre[m].x), lo_f(upre[m].y), hi_f(upre[m].y)}; } while (0)
#define DN_SB() __builtin_amdgcn_sched_barrier(0)
#define DN_LDW(f, off_, m0_) do { _Pragma("unroll") for (int m = 0; m < 2; ++m) _Pragma("unroll") for (int s_ = 0; s_ < 4; ++s_) f[m * 4 + s_] = *(const bf16x8*)(buf + (off_) + (16 * ((m0_) + m) + cl) * SROW + (32 * s_ + 8 * g) * 2); } while (0)
#define DN_LDK(f, off_, r0_) do { _Pragma("unroll") for (int r = 0; r < 4; ++r) _Pragma("unroll") for (int s_ = 0; s_ < 2; ++s_) f[r * 2 + s_] = *(const bf16x8*)(buf + (off_) + (16 * ((r0_) + r) + cl) * SKROW + (32 * s_ + 8 * g) * 2); } while (0)
#define DN_MMW(acc, m0_, f) do { _Pragma("unroll") for (int s_ = 0; s_ < 4; ++s_) _Pragma("unroll") for (int m = 0; m < 2; ++m) acc[(m0_) + m] = __builtin_amdgcn_mfma_f32_16x16x32_bf16(f[m * 4 + s_], Sb[s_], acc[(m0_) + m], 0, 0, 0); } while (0)
#define DN_MMK(acc, r0_, f) do { _Pragma("unroll") for (int s_ = 0; s_ < 2; ++s_) _Pragma("unroll") for (int r = 0; r < 4; ++r) acc[(r0_) + r] = __builtin_amdgcn_mfma_f32_16x16x32_bf16(f[r * 2 + s_], Vb[s_], acc[(r0_) + r], 0, 0, 0); } while (0)
#define DN_CHUNK(bufoff_, c_) do { \
            const unsigned char* buf = lds + (bufoff_); const int item = bh * 32 + (c_); \
            const float egl = __shfl(eglv, (c_)); \
            f32x4 o[4]; \
            _Pragma("unroll") for (int m = 0; m < 4; ++m) o[m] = (f32x4){0.f, 0.f, 0.f, 0.f}; \
            bf16x8 fA[8], fB[8]; \
            DN_LDW(fA, SC_WN, 0); DN_LDW(fB, SC_WN, 2); DN_SB(); \
            DN_MMW(vn, 0, fA); DN_SB(); DN_LDW(fA, SC_QD, 0); DN_SB(); \
            DN_MMW(vn, 2, fB); DN_SB(); DN_LDW(fB, SC_QD, 2); DN_SB(); \
            bf16x8 Vb[2]; \
            _Pragma("unroll") for (int s_ = 0; s_ < 2; ++s_) { u32x4 w; w.x = pkbf(vn[2 * s_][0], vn[2 * s_][1]); w.y = pkbf(vn[2 * s_][2], vn[2 * s_][3]); w.z = pkbf(vn[2 * s_ + 1][0], vn[2 * s_ + 1][1]); w.w = pkbf(vn[2 * s_ + 1][2], vn[2 * s_ + 1][3]); \
                Vb[s_] = __builtin_bit_cast(bf16x8, w); } \
            DN_MMW(o, 0, fA); DN_SB(); DN_LDK(fA, SC_KDT, 0); DN_SB(); \
            DN_MMW(o, 2, fB); DN_SB(); DN_LDK(fB, SC_KDT, 4); DN_SB(); \
            _Pragma("unroll") for (int r = 0; r < 8; ++r) S[r] = S[r] * egl; \
            DN_MMK(S, 0, fA); DN_SB(); DN_LDK(fA, SC_AQK, 0); DN_SB(); \
            DN_MMK(S, 4, fB); DN_SB(); \
            DN_MMK(o, 0, fA); DN_SB(); \
            _Pragma("unroll") for (int s_ = 0; s_ < 4; ++s_) { u32x4 w; w.x = pkbf(S[2 * s_][0], S[2 * s_][1]); w.y = pkbf(S[2 * s_][2], S[2 * s_][3]); w.z = pkbf(S[2 * s_ + 1][0], S[2 * s_ + 1][1]); w.w = pkbf(S[2 * s_ + 1][2], S[2 * s_ + 1][3]); \
                Sb[s_] = __builtin_bit_cast(bf16x8, w); } \
            { unsigned char* sc_ = lds + 2 * SC_BUF + wave * SC_OT; \
              _Pragma("unroll") for (int m = 0; m < 4; ++m) _Pragma("unroll") for (int x_ = 0; x_ < 4; ++x_) *(bf16_t*)(sc_ + (m * 4 + x_) * 128 + 2 * lane) = (bf16_t)(pkbf(o[m][x_], 0.f) & 0xffffu); \
              if ((c_) < 30) asm volatile("s_waitcnt vmcnt(10)" ::: "memory");     \
              else asm volatile("s_waitcnt vmcnt(3)" ::: "memory");                \
              if ((c_) > 1 && lane == 0) __hip_atomic_fetch_add(flagp + ((c_) - 2) * 32, 1u, __ATOMIC_RELAXED, __HIP_MEMORY_SCOPE_AGENT); \
              _Pragma("unroll") for (int q_ = 0; q_ < 2; ++q_) { \
                  const u32x4 w_ = *(const u32x4*)(sc_ + q_ * 1024 + lane * 16); \
                  __builtin_amdgcn_raw_buffer_store_b128(w_, utrsrc, (unsigned)((item * 128 + 16 * wdv) * 64 + q_ * 512 + lane * 8) * 2u, 0, 16  ); } } \
        } while (0)
            unsigned* flagp = flags + (size_t)(bh >> 2) * 32 * 32;
            const __amdgpu_buffer_rsrc_t utrsrc = __builtin_amdgcn_make_buffer_rsrc(B.UT, 0, 16 * 1024 * 1024, 0x00020000);
            DN_LOAD_U(uA, 0); DN_LOAD_U(uB, 1);
            DN_BAR();
            for (int c = 0; c < SEQ / 64; c += 2) {
                DN_VN(uA); if (c + 2 < SEQ / 64) DN_LOAD_U(uA, c + 2);
                DN_CHUNK(0, c);
                DN_BAR();
                DN_VN(uB); if (c + 3 < SEQ / 64) DN_LOAD_U(uB, c + 3);
                DN_CHUNK(SC_BUF, c + 1);
                DN_BAR();
            }
            asm volatile("s_waitcnt vmcnt(0)" ::: "memory");
            if (lane == 0) { __hip_atomic_fetch_add(flagp + (SEQ / 64 - 2) * 32, 1u, __ATOMIC_RELAXED, __HIP_MEMORY_SCOPE_AGENT); __hip_atomic_fetch_add(flagp + (SEQ / 64 - 1) * 32, 1u, __ATOMIC_RELAXED, __HIP_MEMORY_SCOPE_AGENT); }
#undef DN_LOAD_U
#undef DN_VN
#undef DN_SB
#undef DN_LDW
#undef DN_LDK
#undef DN_MMW
#undef DN_MMK
#undef DN_CHUNK
        } else {
            const int lt = tid - 256;
            const int o_w = (lt >> 4) * SROW + (lt & 15) * 16, o_k = (lt >> 3) * SKROW + (lt & 7) * 16;
            u32x4 p0[14], p1[14], p2[14];
#define DN_LOADP(pre, c_) do { const size_t it_ = (size_t)(bh * 32 + (c_)); \
            _Pragma("unroll") for (int q = 0; q < 4; ++q) { pre[q] = *(const u32x4*)(B.WN + it_ * 8192 + (size_t)(lt + 256 * q) * 8); pre[4 + q] = *(const u32x4*)(B.QD + it_ * 8192 + (size_t)(lt + 256 * q) * 8); \
                pre[8 + q] = *(const u32x4*)(B.KDT + it_ * 8192 + (size_t)(lt + 256 * q) * 8); } \
            _Pragma("unroll") for (int q = 0; q < 2; ++q) pre[12 + q] = *(const u32x4*)(B.AQK + it_ * 4096 + (size_t)(lt + 256 * q) * 8); } while (0)
#define DN_WRITEP(pre, bufoff_) do { unsigned char* d_ = lds + (bufoff_); \
            _Pragma("unroll") for (int q = 0; q < 4; ++q) { *(u32x4*)(d_ + SC_WN + o_w + q * 16 * SROW) = pre[q]; *(u32x4*)(d_ + SC_QD + o_w + q * 16 * SROW) = pre[4 + q]; *(u32x4*)(d_ + SC_KDT + o_k + q * 32 * SKROW) = pre[8 + q]; } \
            _Pragma("unroll") for (int q = 0; q < 2; ++q) *(u32x4*)(d_ + SC_AQK + o_k + q * 32 * SKROW) = pre[12 + q]; } while (0)
            DN_LOADP(p0, 0); DN_LOADP(p1, 1); DN_LOADP(p2, 2);
            DN_WRITEP(p0, 0);
            DN_BAR();
            DN_LOADP(p0, 3);
#define DN_STEP(j_, set_, bufoff_) do { const int cc_ = c + (j_); if (cc_ < SEQ / 64) { if (cc_ + 1 < SEQ / 64) DN_WRITEP(set_, bufoff_); DN_BAR(); if (cc_ + 4 < SEQ / 64) DN_LOADP(set_, cc_ + 4); } } while (0)
            for (int c = 0; c < SEQ / 64; c += 6) {
                DN_STEP(0, p1, SC_BUF); DN_STEP(1, p2, 0); DN_STEP(2, p0, SC_BUF); DN_STEP(3, p1, 0); DN_STEP(4, p2, SC_BUF); DN_STEP(5, p0, 0);
            }
#undef DN_STEP
#undef DN_LOADP
#undef DN_WRITEP
        }
        __syncthreads();
    }
#undef DN_BAR
}
}

__device__ __forceinline__ void transpose_item(const float* W, int ldw, int k0, int n0, bf16_t* WT, int ldk, int dst_row0, float* scr_f, int lane) {
    unsigned* scr = (unsigned*)scr_f;
    const int c4 = (lane & 7) * 4, rq = lane >> 3;
    float4 lo[4], hi[4];
#pragma unroll
    for (int i = 0; i < 4; ++i) { const float* src = W + (size_t)(k0 + 2 * (rq + 8 * i)) * ldw + n0 + c4; lo[i] = ldnt4(src); hi[i] = ldnt4(src + ldw); }
#pragma unroll
    for (int i = 0; i < 4; ++i) { const int kp = rq + 8 * i; unsigned* d = scr + c4 * 36 + kp;
        d[0] = dn::pkbf(lo[i].x, hi[i].x); d[36] = dn::pkbf(lo[i].y, hi[i].y); d[72] = dn::pkbf(lo[i].z, hi[i].z); d[108] = dn::pkbf(lo[i].w, hi[i].w); }
    asm volatile("s_waitcnt lgkmcnt(0)" ::: "memory");
#pragma unroll
    for (int j = 0; j < 4; ++j) { const int n = rq + 8 * j; const uint4 o = *(const uint4*)(scr + n * 36 + 4 * (lane & 7));
        *(uint4*)(WT + (size_t)(dst_row0 + n) * ldk + k0 + 8 * (lane & 7)) = o; }
    asm volatile("s_waitcnt lgkmcnt(0)" ::: "memory");
}

constexpr int CV_IG = NE * 16 * 16, CV_ID = NE * 8 * 32, CV_PREP = 20;
struct CvDesc { const float* W; bf16_t* WT; int ldw, k0, n0, ldk, dst_row0; };
__device__ __forceinline__ CvDesc conv_desc(int r, const float* w_gate, const float* w_up, const float* w_down, bf16_t* wgu_t, bf16_t* wd_t) {
    CvDesc d;
    if (r < 2 * CV_IG) { const int up = r >= CV_IG; if (up) r -= CV_IG; const int e = r >> 8, kb = (r >> 4) & 15, nb = r & 15, n0 = nb * 32;
        d.W = (up ? w_up : w_gate) + (size_t)e * DM * FF; d.ldw = FF; d.k0 = kb * 64; d.n0 = n0; d.WT = wgu_t + (size_t)e * DM * DM; d.ldk = DM; d.dst_row0 = (n0 >> 7) * 256 + (n0 & 127) + (up ? 128 : 0); return d; }
    r -= 2 * CV_IG;
    { const int e = r >> 8, kb = (r >> 5) & 7, nb = r & 31; d.W = w_down + (size_t)e * FF * DM; d.ldw = DM; d.k0 = kb * 64; d.n0 = nb * 32; d.WT = wd_t + (size_t)e * DM * FF; d.ldk = FF; d.dst_row0 = nb * 32; }
    return d;
}
struct CvRegs { float4 l0, l1, l2, l3, h0, h1, h2, h3; };
#define CV_LOAD1(dst_lo, dst_hi, i_) do { const float* src_ = d.W + (size_t)(d.k0 + 2 * (rq + 8 * (i_))) * d.ldw + d.n0 + c4; dst_lo = ldnt4(src_); dst_hi = ldnt4(src_ + d.ldw); } while (0)
__device__ __forceinline__ CvRegs cv_load(const CvDesc d, int lane) {
    const int c4 = (lane & 7) * 4, rq = lane >> 3; CvRegs r;
    CV_LOAD1(r.l0, r.h0, 0); CV_LOAD1(r.l1, r.h1, 1); CV_LOAD1(r.l2, r.h2, 2); CV_LOAD1(r.l3, r.h3, 3);
    return r;
}
#undef CV_LOAD1
#define CV_PACK1(lo_, hi_, i_) do { unsigned* p_ = scr + c4 * 36 + rq + 8 * (i_); p_[0] = dn::pkbf(lo_.x, hi_.x); p_[36] = dn::pkbf(lo_.y, hi_.y); p_[72] = dn::pkbf(lo_.z, hi_.z); p_[108] = dn::pkbf(lo_.w, hi_.w); } while (0)
__device__ __forceinline__ void cv_finish(const CvDesc d, const CvRegs r, float* scr_f, int lane) {
    unsigned* scr = (unsigned*)scr_f;
    const int c4 = (lane & 7) * 4, rq = lane >> 3;
    CV_PACK1(r.l0, r.h0, 0); CV_PACK1(r.l1, r.h1, 1); CV_PACK1(r.l2, r.h2, 2); CV_PACK1(r.l3, r.h3, 3);
    asm volatile("s_waitcnt lgkmcnt(0)" ::: "memory");
#pragma unroll
    for (int j = 0; j < 4; ++j) { const int n = rq + 8 * j; const uint4 o = *(const uint4*)(scr + n * 36 + 4 * (lane & 7));
        *(uint4*)(d.WT + (size_t)(d.dst_row0 + n) * d.ldk + d.k0 + 8 * (lane & 7)) = o; }
    asm volatile("s_waitcnt lgkmcnt(0)" ::: "memory");
}
#undef CV_PACK1
__device__ __forceinline__ void conv_items(int first, int step, int count, const float* w_gate, const float* w_up, const float* w_down, bf16_t* wgu_t, bf16_t* wd_t, float* scr, int lane) {
    if (count <= 0) return;
    CvDesc dA = conv_desc(first, w_gate, w_up, w_down, wgu_t, wd_t), dB = dA;
    CvRegs rA = cv_load(dA, lane), rB = rA;
    for (int i = 0; i < count; i += 2) {
        if (i + 1 < count) { dB = conv_desc(first + (i + 1) * step, w_gate, w_up, w_down, wgu_t, wd_t); rB = cv_load(dB, lane); }
        cv_finish(dA, rA, scr, lane);
        if (i + 2 < count) { dA = conv_desc(first + (i + 2) * step, w_gate, w_up, w_down, wgu_t, wd_t); rA = cv_load(dA, lane); }
        if (i + 1 < count) cv_finish(dB, rB, scr, lane);
    }
}

#define XB_TMO      128
#define XB_XCNT(j)  (256  + 64 * (j))
#define XB_XSUB(j)  (1280 + 64 * (j))
#define XB_XGEN(j)  (2304 + 64 * (j))
#define XB_TOP      3328
#define XB_TOPGEN   3392
#define XCD_BAR_WORDS 3456
#define XB_SPIN_CAP (1u << 18)
#define XLAS __attribute__((address_space(3)))
__device__ __forceinline__ unsigned xb_ld(unsigned* p)              { return __hip_atomic_load(p, __ATOMIC_RELAXED, __HIP_MEMORY_SCOPE_AGENT); }
__device__ __forceinline__ unsigned xb_add(unsigned* p, unsigned v) { return __hip_atomic_fetch_add(p, v, __ATOMIC_RELAXED, __HIP_MEMORY_SCOPE_AGENT); }
__device__ __forceinline__ unsigned xb_xcc_id() { return (unsigned)__builtin_amdgcn_s_getreg((3 << 11) | 20) & 0xFu; }
#define XB_SPIN(cond, bar) do { unsigned _sp = 0; while (cond) { if (_sp < 32u) __builtin_amdgcn_s_sleep(1); else __builtin_amdgcn_s_sleep(24); \
    if ((++_sp & 255u) == 0u) { if (xb_ld(&(bar)[XB_TMO])) break; if (_sp > XB_SPIN_CAP) { atomicAdd(&(bar)[XB_TMO], 1u); break; } } } } while (0)
struct XcdBarrier { unsigned* bar; unsigned x; volatile XLAS unsigned* st; };
__device__ __forceinline__ XcdBarrier xcd_barrier_post(unsigned* bar, volatile XLAS unsigned* st) {
    XcdBarrier b; b.bar = bar; b.x = xb_xcc_id(); b.st = st;
    if (threadIdx.x == 0) (void)xb_add(&bar[XB_XCNT(b.x)], 1u);
    return b;
}
__device__ __forceinline__ void xcd_barrier_complete(unsigned* bar, unsigned x, unsigned& nloc, unsigned& nx) {
    const unsigned G = gridDim.x * gridDim.y * gridDim.z;
    unsigned sum, cnt, mine, sp = 0u;
    for (;;) {
        sum = 0u; cnt = 0u; mine = 0u;
#pragma unroll
        for (unsigned j = 0; j < 16; ++j) { const unsigned c = xb_ld(&bar[XB_XCNT(j)]); sum += c; cnt += (c > 0u) ? 1u : 0u; mine = (j == x) ? c : mine; }
        if (sum == G) break;
        __builtin_amdgcn_s_sleep(1);
        if ((++sp & 255u) == 0u) { if (xb_ld(&bar[XB_TMO])) break; if (sp > XB_SPIN_CAP) { atomicAdd(&bar[XB_TMO], 1u); break; } }
    }
    nloc = mine > 0u ? mine : 1u; nx = cnt > 0u ? cnt : 1u;
}
__device__ __forceinline__ void xcd_barrier(const XcdBarrier& b) {
    asm volatile("s_waitcnt vmcnt(0)" ::: "memory");
    __syncthreads();
    if (threadIdx.x == 0) {
        unsigned* bar = b.bar;
        __builtin_amdgcn_s_waitcnt(0);
        unsigned nloc = b.st[0], nx = b.st[1];
        if (nloc == 0u) { xcd_barrier_complete(bar, b.x, nloc, nx); b.st[0] = nloc; b.st[1] = nx; }
        const unsigned old = xb_add(&bar[XB_XSUB(b.x)], 1u);
        const unsigned gen = old / nloc;
        if (old + 1u == (gen + 1u) * nloc) {
            __builtin_amdgcn_fence(__ATOMIC_RELEASE, "agent");
            asm volatile("s_waitcnt vmcnt(0)" ::: "memory");
            const unsigned og = xb_add(&bar[XB_TOP], 1u);
            const unsigned tg = og / nx;
            if (og + 1u == (tg + 1u) * nx) xb_add(&bar[XB_TOPGEN], 1u);
            else XB_SPIN(xb_ld(&bar[XB_TOPGEN]) == tg, bar);
            __builtin_amdgcn_fence(__ATOMIC_ACQUIRE, "agent");
            xb_add(&bar[XB_XGEN(b.x)], 1u);
            asm volatile("s_waitcnt vmcnt(0)" ::: "memory");
        } else {
            XB_SPIN(xb_ld(&bar[XB_XGEN(b.x)]) == gen, bar);
            __builtin_amdgcn_fence(__ATOMIC_ACQUIRE, "agent");
            asm volatile("s_waitcnt vmcnt(0)" ::: "memory");
        }
    }
    __syncthreads();
}

__global__ void __launch_bounds__(NT, 2) fwd_kernel(Params p) {
    extern __shared__ __attribute__((aligned(16))) unsigned char lds_raw[];
    float* lds = (float*)lds_raw;
    int tid = threadIdx.x, lane = tid & 63, wave = tid >> 6;
    const int G = gridDim.x, bid = blockIdx.x;
    int gw = bid * 8 + wave; const int NGW = G * 8;
#define FRESH() do { tid = threadIdx.x; asm volatile("" : "+v"(tid)); lane = tid & 63; wave = tid >> 6; gw = bid * 8 + wave; } while (0)
#define GRID_SYNC() do { \
        const __attribute__((address_space(4))) Params* Pb_ = (const __attribute__((address_space(4))) Params*)__builtin_amdgcn_kernarg_segment_ptr(); asm volatile("" : "+s"(Pb_)); \
        XcdBarrier xb_; xb_.bar = (unsigned*)(Pb_->ws + WS_BAR); xb_.x = xb_xcc_id(); xb_.st = (volatile XLAS unsigned*)((XLAS unsigned char*)lds_raw + LDS_BYTES - 64); xcd_barrier(xb_); } while (0)
#define SEAM() } GRID_SYNC(); FRESH(); { LOADP();

#define LOADP() \
    const __attribute__((address_space(4))) Params* P_ = (const __attribute__((address_space(4))) Params*)__builtin_amdgcn_kernarg_segment_ptr(); asm volatile("" : "+s"(P_)); \
    const float* x = P_->in[0]; const float* mix_g = P_->in[1]; const float* w_in = P_->in[2]; const float* conv_a_w = P_->in[3]; \
    const float* conv_a_g = P_->in[4]; const float* dn_conv_w = P_->in[5]; const float* dn_a_log = P_->in[6]; const float* dn_dt_bias = P_->in[7]; \
    const float* dn_norm_g = P_->in[8]; const float* w_out = P_->in[9]; const float* ffn_g = P_->in[10]; const float* r_group_w = P_->in[11]; \
    const float* r_exp_w = P_->in[12]; const float* w_gate = P_->in[13]; const float* w_up = P_->in[14]; const float* w_down = P_->in[15]; \
    const float* final_g = P_->in[16]; unsigned char* ws = P_->ws; float* outp = P_->out; \
    int* cnt = (int*)(ws + WS_CTL); float* rstd2 = (float*)(ws + WS_RSTD2); \
    int* tok_e = (int*)(ws + WS_TOKE); float* tok_g = (float*)(ws + WS_TOKG); int* tok_p = (int*)(ws + WS_TOKP); int* slot_tok = (int*)(ws + WS_SLOTTOK); \
    float* bg = (float*)(ws + WS_BG); bf16_t* win_t = (bf16_t*)(ws + WS_WIN); bf16_t* wout_t = (bf16_t*)(ws + WS_WOUT); \
    bf16_t* proj = (bf16_t*)(ws + WS_PROJ); bf16_t* hb = (bf16_t*)(ws + WS_HB); bf16_t* ymix = (bf16_t*)(ws + WS_YMIX); \
    bf16_t* act = (bf16_t*)(ws + WS_ACT); bf16_t* yexp = (bf16_t*)(ws + WS_YEXP); bf16_t* h2b = (bf16_t*)outp; \
    bf16_t* wgu_t = (bf16_t*)(ws + WS_WGU); bf16_t* wd_t = (bf16_t*)(ws + WS_WD); bf16_t* x1 = (bf16_t*)(ws + WS_X1B); \
    dn::DnBufs DB{(bf16_t*)outp, (bf16_t*)outp + (size_t)8 * 1024 * 1024, (bf16_t*)outp + (size_t)16 * 1024 * 1024, (bf16_t*)outp + (size_t)24 * 1024 * 1024, (bf16_t*)(ws + WS_AQK), (float*)(ws + WS_GL)}; \
    (void)x; (void)mix_g; (void)w_in; (void)conv_a_w; (void)conv_a_g; (void)dn_conv_w; (void)dn_a_log; (void)dn_dt_bias; (void)dn_norm_g; (void)w_out; (void)ffn_g; (void)r_group_w; (void)r_exp_w; \
    (void)w_gate; (void)w_up; (void)w_down; (void)final_g; (void)cnt; (void)rstd2; (void)tok_e; (void)tok_g; (void)tok_p; (void)slot_tok; (void)bg; (void)win_t; (void)wout_t; (void)proj; (void)hb; (void)ymix; \
    (void)act; (void)yexp; (void)h2b; (void)wgu_t; (void)wd_t; (void)x1; (void)DB
    {
        volatile XLAS unsigned* xst_ = (volatile XLAS unsigned*)((XLAS unsigned char*)lds_raw + LDS_BYTES - 64);
        if (tid == 0) { xst_[0] = 0u; xst_[1] = 0u; }
        __syncthreads();
        (void)xcd_barrier_post((unsigned*)(p.ws + WS_BAR), xst_);
    }
#define MIXA_ROWS(first_, stride_) do { typedef unsigned u32x4_t __attribute__((ext_vector_type(4))); const int c0 = lane * 8; \
        for (int r0_ = (first_); r0_ < NTOK; r0_ += 2 * (stride_)) { \
            u32x4_t ahv[2][3], acv[2][3], abv[2]; float mk[2][3]; int rr_[2]; \
            _Pragma("unroll") for (int t = 0; t < 2; ++t) { const int r = (r0_ + t * (stride_) < NTOK) ? r0_ + t * (stride_) : r0_; rr_[t] = r; const int sq = r % SEQ; const bf16_t* pr = proj + (size_t)r * NPB; \
                _Pragma("unroll") for (int j = 0; j < 3; ++j) { const bool ok = sq + j - 2 >= 0; const bf16_t* pj = pr + (ok ? (ptrdiff_t)(j - 2) * NPB : 0); mk[t][j] = ok ? 1.f : 0.f; \
                    ahv[t][j] = *(const u32x4_t*)(pj + C_AH + c0); acv[t][j] = *(const u32x4_t*)(pj + C_AC + c0); } \
                abv[t] = *(const u32x4_t*)(pr + C_AB + c0); } \
            _Pragma("unroll") for (int t = 0; t < 2; ++t) { if (t == 1 && r0_ + (stride_) >= NTOK) break; const int r = rr_[t]; \
                float conv[8]; _Pragma("unroll") for (int i = 0; i < 8; ++i) conv[i] = 0.f; \
                _Pragma("unroll") for (int j = 0; j < 3; ++j) { const u32x4_t ah = ahv[t][j], ac = acv[t][j]; const float m_ = mk[t][j]; \
                    float4 w0 = *(const float4*)(conv_a_w + j * 512 + c0), w1 = *(const float4*)(conv_a_w + j * 512 + c0 + 4); \
                    w0.x *= m_; w0.y *= m_; w0.z *= m_; w0.w *= m_; w1.x *= m_; w1.y *= m_; w1.z *= m_; w1.w *= m_; \
                    conv[0] += dn::lo_f(ah.x) * dn::lo_f(ac.x) * w0.x; conv[1] += dn::hi_f(ah.x) * dn::hi_f(ac.x) * w0.y; conv[2] += dn::lo_f(ah.y) * dn::lo_f(ac.y) * w0.z; conv[3] += dn::hi_f(ah.y) * dn::hi_f(ac.y) * w0.w; \
                    conv[4] += dn::lo_f(ah.z) * dn::lo_f(ac.z) * w1.x; conv[5] += dn::hi_f(ah.z) * dn::hi_f(ac.z) * w1.y; conv[6] += dn::lo_f(ah.w) * dn::lo_f(ac.w) * w1.z; conv[7] += dn::hi_f(ah.w) * dn::hi_f(ac.w) * w1.w; } \
                const u32x4_t ab = abv[t]; \
                float yv[8] = {dn::lo_f(ab.x) * conv[0], dn::hi_f(ab.x) * conv[1], dn::lo_f(ab.y) * conv[2], dn::hi_f(ab.y) * conv[3], dn::lo_f(ab.z) * conv[4], dn::hi_f(ab.z) * conv[5], dn::lo_f(ab.w) * conv[6], dn::hi_f(ab.w) * conv[7]}; \
                float ss = 0.f; _Pragma("unroll") for (int i = 0; i < 8; ++i) ss += yv[i] * yv[i]; \
                ss += __shfl_xor(ss, 1); ss += __shfl_xor(ss, 2); ss += __shfl_xor(ss, 4); \
                const float rs = rsqrtf(ss * (1.f / 64.f) + EPS); \
                const float4 g0 = *(const float4*)(conv_a_g + c0), g1 = *(const float4*)(conv_a_g + c0 + 4); \
                u32x4_t w; w.x = dn::pkbf(yv[0] * rs * g0.x, yv[1] * rs * g0.y); w.y = dn::pkbf(yv[2] * rs * g0.z, yv[3] * rs * g0.w); w.z = dn::pkbf(yv[4] * rs * g1.x, yv[5] * rs * g1.y); w.w = dn::pkbf(yv[6] * rs * g1.z, yv[7] * rs * g1.w); \
                *(u32x4_t*)(ymix + (size_t)r * DM + c0) = w; } } } while (0)
    int* Loff = (int*)(lds_raw + LDS_TAB);
    int* Ltile = Loff + 64;
    int* Lend = Loff + 128;
    int* LsmE = Loff + 192;
    {
    LOADP();
    REP(0) {
    {
        float* scr = lds + wave * (64 * 33);
        constexpr int I_IN = (DM / 64) * (NPB / 32), I_OUT = (DM / 64) * (DM / 32);
        constexpr int I_G = NE * 16 * 16, I_D = NE * 8 * 32;
        for (int it = gw; it < I_IN; it += NGW) {
            const int kb = it / (NPB / 32), nb = it % (NPB / 32); transpose_item(w_in, NPROJ, kb * 64, nb * 32, win_t, DM, nb * 32, scr, lane);
        }
        (void)I_OUT;
        float wx[4][4][8];
#pragma unroll
        for (int j = 0; j < 4; ++j)
#pragma unroll
            for (int i = 0; i < 4; ++i) { const float* wr_ = w_in + (size_t)(4 * lane + 256 * j + i) * NPROJ + NPB; const float4 w0 = *(const float4*)wr_, w1 = *(const float4*)(wr_ + 4);
                wx[j][i][0] = w0.x; wx[j][i][1] = w0.y; wx[j][i][2] = w0.z; wx[j][i][3] = w0.w; wx[j][i][4] = w1.x; wx[j][i][5] = w1.y; wx[j][i][6] = w1.z; wx[j][i][7] = w1.w; }
        const int hsel = (lane >> 3) & 3; const bool is_alpha = lane >= 32;
        const float aneg = -expf(dn_a_log[hsel]), dtb = dn_dt_bias[hsel];
        float4 vnx[4];
        if (gw < NTOK) {
#pragma unroll
            for (int j = 0; j < 4; ++j) vnx[j] = ldnt4(x + (size_t)gw * DM + 4 * (lane + 64 * j)); }
        for (int r = gw; r < NTOK; r += NGW) {
            float4 v[4]; float s = 0.f;
#pragma unroll
            for (int j = 0; j < 4; ++j) { v[j] = vnx[j]; s += v[j].x * v[j].x + v[j].y * v[j].y + v[j].z * v[j].z + v[j].w * v[j].w; }
            const float rs = rsqrtf(wave_sum(s) * (1.f / DM) + EPS);
            float dots[8];
#pragma unroll
            for (int c = 0; c < 8; ++c) dots[c] = 0.f;
            unsigned long long* o8 = (unsigned long long*)(hb + (size_t)r * DM) + lane;
#pragma unroll
            for (int j = 0; j < 4; ++j) { const float4 g = ((const float4*)mix_g)[lane + 64 * j];
                v[j].x *= rs * g.x; v[j].y *= rs * g.y; v[j].z *= rs * g.z; v[j].w *= rs * g.w;
                o8[64 * j] = (unsigned long long)pk2(v[j].x, v[j].y) | ((unsigned long long)pk2(v[j].z, v[j].w) << 32);
                const float hv[4] = {v[j].x, v[j].y, v[j].z, v[j].w};
#pragma unroll
                for (int i = 0; i < 4; ++i)
#pragma unroll
                    for (int c = 0; c < 8; ++c) dots[c] += hv[i] * wx[j][i][c]; }
            const float tot = reduce8_tr(dots, lane);
            if ((lane & 7) == 0) bg[(size_t)r * 8 + (lane >> 3)] = is_alpha ? aneg * softplus_f(tot + dtb) : sigmoid_f(tot);
            if (r + NGW < NTOK) {
#pragma unroll
                for (int j = 0; j < 4; ++j) vnx[j] = ldnt4(x + (size_t)(r + NGW) * DM + 4 * (lane + 64 * j)); }
        }
    }
    }
    SEAM()
    REP(1) {
        pg8::Gemm g{hb, DM, nullptr}; pg8::DenseOrder S; S.init(NTOK, NPB, DM, win_t, G, bid);
        pg8::EpiBf16 E{proj, NPB};
        pg8::gemm_phase<pg8::EpiBf16, pg8::DenseOrder, false, true>((PG8_LAS unsigned char*)lds_raw, g, S, E);
    }
    SEAM()
    REP(3) dn::prep(lds_raw, tid, bid, G, proj, bg, dn_conv_w, DB, [&](int item, int w4, int lane_) {
        const __attribute__((address_space(4))) Params* Q_ = (const __attribute__((address_space(4))) Params*)__builtin_amdgcn_kernarg_segment_ptr(); asm volatile("" : "+s"(Q_));
        unsigned char* ws_ = Q_->ws;
        float* scr_ = (float*)(lds_raw + dn::P2_END + w4 * 4608);
        const int s0 = 5 * w4, ns = 5;
        conv_items(item * CV_PREP + s0, 1, ns, Q_->in[13], Q_->in[14], Q_->in[15], (bf16_t*)(ws_ + WS_WGU), (bf16_t*)(ws_ + WS_WD), scr_, lane_);
    });
    SEAM()
    REP(4) {
    constexpr int NSU = 2 * BATCH * NH;
    if (bid >= NSU || G <= NSU) {
        float* scr = lds + wave * (64 * 33);
        constexpr int I_G = NE * 16 * 16, I_D = NE * 8 * 32;
        const int nw = (G <= NSU) ? NGW : (G - NSU) * 8, w0 = (G <= NSU) ? gw : gw - NSU * 8;
        { const int it0 = CV_PREP * (BATCH * NH * (SEQ / 64)) + w0, tot = 2 * I_G + I_D; conv_items(it0, nw, it0 < tot ? (tot - it0 + nw - 1) / nw : 0, w_gate, w_up, w_down, wgu_t, wd_t, scr, lane); }
        for (int it = w0; it < (DM / 64) * (DM / 32); it += nw) { const int kb = it / (DM / 32), nb = it % (DM / 32); transpose_item(w_out, DM, kb * 64, nb * 32, wout_t, DM, nb * 32, scr, lane); }
        if (G > NSU) MIXA_ROWS(w0, nw);
    }
    unsigned* dnflags = (unsigned*)(ws + WS_CTL);
    if (bid < NSU || G <= NSU) dn::scan(lds_raw, tid, bid, G, DB, ymix, dnflags);
    if (bid >= NSU || G <= NSU) {
        typedef unsigned u32x4_t __attribute__((ext_vector_type(4)));
        const int c0 = lane * 8;
        const int nw = (G <= NSU) ? NGW : (G - NSU) * 8, w0 = (G <= NSU) ? gw : gw - NSU * 8;
        if (G <= NSU) MIXA_ROWS(gw, NGW);
        const int wq0 = ((G <= NSU) ? bid : bid - NSU) * 8;
        for (int q0 = wq0; q0 < NTOK / 4; q0 += nw) {
            const int q = q0 + wave;
            const int ch = q >> 7, bb = (q >> 4) & 7, i4 = q & 15;
            const int rbase = bb * SEQ + ch * 64 + i4 * 4;
            u32x4_t ovv[4], zvv[4];
#pragma unroll
            for (int t = 0; t < 4; ++t) zvv[t] = *(const u32x4_t*)(proj + (size_t)(rbase + t) * NPB + C_Z + c0);
            if (wave == 0) {
                unsigned* fl = dnflags + (bb * 32 + ch) * 32;
                for (unsigned spins = 0; spins < (1u << 21); ++spins) {
                    if ((unsigned)__builtin_amdgcn_readfirstlane(__hip_atomic_load(fl, __ATOMIC_RELAXED, __HIP_MEMORY_SCOPE_AGENT)) >= 32u) break;
                    __builtin_amdgcn_s_sleep(32);
                }
                __builtin_amdgcn_fence(__ATOMIC_ACQUIRE, "agent");
                asm volatile("s_waitcnt vmcnt(0)" ::: "memory");
            }
            __syncthreads();
#pragma unroll
            for (int t = 0; t < 4; ++t) {
                const int r = rbase + t;
                const int oi_ = r & 63, oitem_ = ((r / SEQ) * NH + (c0 >> 7)) * (SEQ / 64) + ((r % SEQ) >> 6);
                ovv[t] = *(const u32x4_t*)(DB.UT + ((size_t)oitem_ * 128 + (c0 & 112)) * 64 + (((oi_ >> 4) * 4 + (oi_ & 3)) * 4 + ((oi_ >> 2) & 3)) * 16 + (c0 & 15));
            }
#pragma unroll
            for (int t = 0; t < 4; ++t) {
                const int r = rbase + t;
                const u32x4_t ov = ovv[t], zv = zvv[t];
                float o[8] = {dn::lo_f(ov.x), dn::hi_f(ov.x), dn::lo_f(ov.y), dn::hi_f(ov.y), dn::lo_f(ov.z), dn::hi_f(ov.z), dn::lo_f(ov.w), dn::hi_f(ov.w)};
                const float z[8] = {dn::lo_f(zv.x), dn::hi_f(zv.x), dn::lo_f(zv.y), dn::hi_f(zv.y), dn::lo_f(zv.z), dn::hi_f(zv.z), dn::lo_f(zv.w), dn::hi_f(zv.w)};
                float ss = 0.f;
#pragma unroll
                for (int i = 0; i < 8; ++i) ss += o[i] * o[i];
                ss += __shfl_xor(ss, 1); ss += __shfl_xor(ss, 2); ss += __shfl_xor(ss, 4); ss += __shfl_xor(ss, 8);
                const float rs = rsqrtf(ss * (1.f / 128.f) + EPS);
                const float4 g0 = *(const float4*)(dn_norm_g + (c0 & 127)), g1 = *(const float4*)(dn_norm_g + (c0 & 127) + 4);
                const float gv[8] = {g0.x, g0.y, g0.z, g0.w, g1.x, g1.y, g1.z, g1.w};
#pragma unroll
                for (int i = 0; i < 8; ++i) o[i] = o[i] * rs * gv[i] * dn::silu_fast(z[i]);
                u32x4_t w; w.x = dn::pkbf(o[0], o[1]); w.y = dn::pkbf(o[2], o[3]); w.z = dn::pkbf(o[4], o[5]); w.w = dn::pkbf(o[6], o[7]);
                *(u32x4_t*)(ymix + (size_t)r * DM + 512 + c0) = w;
            }
        }
    }
    }
    SEAM()
    REP(5) {
        pg8::Gemm g{ymix, DM, nullptr}; pg8::DenseOrder S; S.init(NTOK, DM, DM, wout_t, G, bid);
        pg8::EpiResid E{x, x1, DM};
        pg8::gemm_phase<pg8::EpiResid, pg8::DenseOrder, false, true>((PG8_LAS unsigned char*)lds_raw, g, S, E);
    }
    SEAM()
    {
        constexpr int RB_STRIDE = 2064;
        constexpr int RB_PART = 48 * RB_STRIDE;
        unsigned char* ldsb = lds_raw;
        float* part = (float*)(lds_raw + RB_PART);
        float* rsl = (float*)(lds_raw + RB_PART + 16384);
        float* gfl = (float*)(lds_raw + RB_PART + 16384 + 256);
        int* lcnt = (int*)(lds_raw + LDS_TAB + 2048);
        for (int k = tid; k < DM; k += NT) {
            const float gk = ffn_g[k]; gfl[k] = gk;
            const float4* we = (const float4*)(r_exp_w + (size_t)k * 32);
#pragma unroll
            for (int q = 0; q < 8; ++q) { const float4 v = we[q];
                *(bf16_t*)(ldsb + (4 * q + 0) * RB_STRIDE + 2 * k) = (bf16_t)f2bf(v.x * gk); *(bf16_t*)(ldsb + (4 * q + 1) * RB_STRIDE + 2 * k) = (bf16_t)f2bf(v.y * gk);
                *(bf16_t*)(ldsb + (4 * q + 2) * RB_STRIDE + 2 * k) = (bf16_t)f2bf(v.z * gk); *(bf16_t*)(ldsb + (4 * q + 3) * RB_STRIDE + 2 * k) = (bf16_t)f2bf(v.w * gk); }
            const float4 vg = *(const float4*)(r_group_w + (size_t)k * 4);
            *(bf16_t*)(ldsb + 32 * RB_STRIDE + 2 * k) = (bf16_t)f2bf(vg.x * gk); *(bf16_t*)(ldsb + 33 * RB_STRIDE + 2 * k) = (bf16_t)f2bf(vg.y * gk);
            *(bf16_t*)(ldsb + 34 * RB_STRIDE + 2 * k) = (bf16_t)f2bf(vg.z * gk); *(bf16_t*)(ldsb + 35 * RB_STRIDE + 2 * k) = (bf16_t)f2bf(vg.w * gk);
#pragma unroll
            for (int c = 36; c < 48; ++c) *(bf16_t*)(ldsb + c * RB_STRIDE + 2 * k) = (bf16_t)0;
        }
        if (tid < NE) lcnt[tid] = 0;
        __syncthreads();
        const int kmax = (NTOK + NGW - 1) / NGW, ntile = (kmax + 1) >> 1;
        const int g = lane >> 4, cl = lane & 15, tl = wave >> 1, kh = wave & 1;
        for (int t0 = 0; t0 < ntile; t0 += 4) {
            const int tile = t0 + tl;
            const int rk = 2 * tile + (cl >> 3), rrow = bid * 8 + (cl & 7) + NGW * rk;
            const bool rv = tile < ntile && rk < kmax && rrow < NTOK;
            const int rc = rv ? rrow : bid * 8 + (cl & 7);
            const bf16_t* xrow = x1 + (size_t)rc * DM + 512 * kh + 8 * g;
            dn::f32x4 acc[3];
#pragma unroll
            for (int n = 0; n < 3; ++n) acc[n] = (dn::f32x4){0.f, 0.f, 0.f, 0.f};
            float ss = 0.f;
            typedef __attribute__((address_space(3))) unsigned char lds_u8;
            const lds_u8* bp0 = (const lds_u8*)ldsb + cl * RB_STRIDE + (512 * kh + 8 * g) * 2; asm volatile("" : "+v"(bp0));
            const lds_u8* bp1 = bp0 + 16 * RB_STRIDE; asm volatile("" : "+v"(bp1));
            const lds_u8* bp2 = bp0 + 32 * RB_STRIDE; asm volatile("" : "+v"(bp2));
#pragma unroll
            for (int s_ = 0; s_ < 16; ++s_) {
                const dn::bf16x8 afs = *(const dn::bf16x8*)(xrow + 32 * s_);
                { const dn::bf16x8 b0 = *(const __attribute__((address_space(3))) dn::bf16x8*)(bp0 + 64 * s_), b1 = *(const __attribute__((address_space(3))) dn::bf16x8*)(bp1 + 64 * s_), b2 = *(const __attribute__((address_space(3))) dn::bf16x8*)(bp2 + 64 * s_);
                  acc[0] = __builtin_amdgcn_mfma_f32_16x16x32_bf16(afs, b0, acc[0], 0, 0, 0); acc[1] = __builtin_amdgcn_mfma_f32_16x16x32_bf16(afs, b1, acc[1], 0, 0, 0); acc[2] = __builtin_amdgcn_mfma_f32_16x16x32_bf16(afs, b2, acc[2], 0, 0, 0); }
                const dn::u32x4 aw = __builtin_bit_cast(dn::u32x4, afs);
                const float v8[8] = {dn::lo_f(aw.x), dn::hi_f(aw.x), dn::lo_f(aw.y), dn::hi_f(aw.y), dn::lo_f(aw.z), dn::hi_f(aw.z), dn::lo_f(aw.w), dn::hi_f(aw.w)};
#pragma unroll
                for (int j = 0; j < 8; ++j) ss += v8[j] * v8[j];
            }
            ss += __shfl_xor(ss, 16); ss += __shfl_xor(ss, 32);
            if (kh == 1) { float* p = part + (tl * 64 + lane) * 16;
#pragma unroll
                for (int n = 0; n < 3; ++n) *(float4*)(p + 4 * n) = make_float4(acc[n][0], acc[n][1], acc[n][2], acc[n][3]);
                p[12] = ss; }
            __syncthreads();
            float rs_row = 0.f;
            if (kh == 0) { const float* p = part + (tl * 64 + lane) * 16;
#pragma unroll
                for (int n = 0; n < 3; ++n) { const float4 o = *(const float4*)(p + 4 * n); acc[n][0] += o.x; acc[n][1] += o.y; acc[n][2] += o.z; acc[n][3] += o.w; }
                rs_row = rsqrtf((ss + p[12]) * (1.f / DM) + EPS);
                if (g == 0) rsl[tl * 16 + cl] = rs_row; }
            __syncthreads();
            if (rv) {
                const float rsm = rsl[tl * 16 + cl];
                typedef __attribute__((address_space(3))) float lds_f32r;
                const lds_f32r* gp = (const lds_f32r*)gfl + 512 * kh + 8 * g; asm volatile("" : "+v"(gp));
#pragma unroll 8
                for (int s_ = 0; s_ < 16; ++s_) { const int k0_ = 512 * kh + 32 * s_ + 8 * g;
                    const dn::f32x4 ga_ = *(const __attribute__((address_space(3))) dn::f32x4*)(gp + 32 * s_), gb_ = *(const __attribute__((address_space(3))) dn::f32x4*)(gp + 32 * s_ + 4);
                    const float4 ga = make_float4(ga_[0], ga_[1], ga_[2], ga_[3]), gb = make_float4(gb_[0], gb_[1], gb_[2], gb_[3]);
                    const dn::u32x4 aw = *(const dn::u32x4*)(xrow + 32 * s_);
                    dn::u32x4 w; w.x = dn::pkbf(dn::lo_f(aw.x) * rsm * ga.x, dn::hi_f(aw.x) * rsm * ga.y); w.y = dn::pkbf(dn::lo_f(aw.y) * rsm * ga.z, dn::hi_f(aw.y) * rsm * ga.w);
                    w.z = dn::pkbf(dn::lo_f(aw.z) * rsm * gb.x, dn::hi_f(aw.z) * rsm * gb.y); w.w = dn::pkbf(dn::lo_f(aw.w) * rsm * gb.z, dn::hi_f(aw.w) * rsm * gb.w);
                    *(dn::u32x4*)(h2b + (size_t)rrow * DM + k0_) = w; }
            }
            if (kh == 0) {
#pragma unroll
                for (int x_ = 0; x_ < 4; ++x_) {
                    const int ri = 4 * g + x_, tk = 2 * tile + (ri >> 3), r = bid * 8 + (ri & 7) + NGW * tk;
                    const bool ok = tile < ntile && tk < kmax && r < NTOK;
                    const float rsx = __shfl(rs_row, ri);
                    const float e0 = acc[0][x_] * rsx, e1 = acc[1][x_] * rsx, gq = acc[2][x_] * rsx;
                    float gl[4];
#pragma unroll
                    for (int c = 0; c < 4; ++c) gl[c] = __shfl(gq, (lane & 48) + c);
                    int gi = 0; float gm = gl[0];
#pragma unroll
                    for (int c = 1; c < 4; ++c) if (gl[c] > gm) { gm = gl[c]; gi = c; }
                    float gs = 0.f;
#pragma unroll
                    for (int c = 0; c < 4; ++c) gs += expf(gl[c] - gm);
                    const float gprob = 1.f / gs;
                    const float emine = (gi >> 1) ? e1 : e0;
                    float el[8];
#pragma unroll
                    for (int e = 0; e < 8; ++e) el[e] = __shfl(emine, (lane & 48) + 8 * (gi & 1) + e);
                    int i1 = 0; float m1 = el[0];
#pragma unroll
                    for (int e = 1; e < 8; ++e) if (el[e] > m1) { m1 = el[e]; i1 = e; }
                    int i2 = -1; float m2 = -INFINITY;
#pragma unroll
                    for (int e = 0; e < 8; ++e) if (e != i1 && el[e] > m2) { m2 = el[e]; i2 = e; }
                    const float p2 = expf(m2 - m1), inv = 1.f / (1.f + p2);
                    if (cl == 0 && ok) {
                        const int e1_ = gi * 8 + i1, e2_ = gi * 8 + i2;
                        tok_e[2 * r] = e1_; tok_e[2 * r + 1] = e2_;
                        tok_g[2 * r] = gprob * inv; tok_g[2 * r + 1] = gprob * p2 * inv;
                        tok_p[2 * r] = atomicAdd(&lcnt[e1_], 1); tok_p[2 * r + 1] = atomicAdd(&lcnt[e2_], 1);
                    }
                }
            }
            __syncthreads();
        }
        if (tid < NE) ((int*)(ws + WS_CNTB))[bid * NE + tid] = lcnt[tid];
    }
    SEAM()
    {
        const int* cntb = (const int*)(ws + WS_CNTB);
        int* red = (int*)(lds_raw + LDS_TAB + 4096);
        int* Lbase = (int*)(lds_raw + LDS_TAB + 2048);
        { const int e = tid & 31, part = tid >> 5; int sall = 0, sbef = 0;
          for (int b_ = part; b_ < G; b_ += 16) { const int v = cntb[b_ * NE + e]; sall += v; sbef += (b_ < bid) ? v : 0; }
          red[part * 32 + e] = sall; red[512 + part * 32 + e] = sbef; }
        __syncthreads();
        if (tid < NE) { int a = 0, b_ = 0; for (int q = 0; q < 16; ++q) { a += red[q * 32 + tid]; b_ += red[512 + q * 32 + tid]; } red[1024 + tid] = a; Lbase[tid] = b_; }
        __syncthreads();
        if (tid == 0) { int o = 0, tl = 0, ns = 0;
            for (int e = 0; e < NE; ++e) { Loff[e] = o; Ltile[e] = tl; const int c = red[1024 + e], full = c >> 8, rem = c & 255;
                if (rem > 128 || rem == 0) { tl += full + (rem ? 1 : 0); Lend[e] = o + c; }
                else { tl += full; Lend[e] = o + 256 * full; LsmE[ns++] = e; }
                o += c; }
            Loff[NE] = o; Ltile[NE] = tl; LsmE[63] = ns; }
        __syncthreads();
        for (int q = tid; q < 16 * (NTOK / (8 * G) + 1); q += NT) {
            const int w = (q >> 1) & 7, k = q >> 4, r = bid * 8 + w + NGW * k, i = 2 * r + (q & 1);
            if (r < NTOK) { const int e = tok_e[i]; const int sl = Loff[e] + Lbase[e] + tok_p[i]; slot_tok[sl] = r; tok_p[i] = sl; }
        }
    }
    SEAM()
    REP(7) {
        pg8::Gemm g{h2b, DM, slot_tok};
        pg8::GroupedOrder S{Loff, Ltile, Lend, LsmE, Ltile[NE] * 4, (Ltile[NE] + LsmE[63]) * 4, G, bid, (const char*)wgu_t, (size_t)DM * DM * 2, (size_t)256 * DM * 2, 0};
        pg8::EpiAct E{act};
        pg8::gemm_phase<pg8::EpiAct, pg8::GroupedOrder, true, true>((PG8_LAS unsigned char*)lds_raw, g, S, E);
        if (G == 256) {
            unsigned* gbar = (unsigned*)(ws + WS_CTL + 36864) + ((bid & 7) + 8 * (bid >> 5)) * 32; unsigned* hd = (unsigned*)(ws + WS_CTL + 36864) + 64 * 32;
            if (tid == 0) {
                int nhm = 0; { pg8::Unit u_; for (int i = 0; S.next(i, u_); ++i) nhm += u_.half; }
                if (nhm) __hip_atomic_fetch_add(hd, (unsigned)nhm, __ATOMIC_RELAXED, __HIP_MEMORY_SCOPE_AGENT);
                __hip_atomic_fetch_add(gbar, 1u, __ATOMIC_RELAXED, __HIP_MEMORY_SCOPE_AGENT);
                for (unsigned spins = 0; spins < (1u << 22); ++spins) { if (__hip_atomic_load(gbar, __ATOMIC_RELAXED, __HIP_MEMORY_SCOPE_AGENT) >= 4u) break; __builtin_amdgcn_s_sleep(8); }
                __builtin_amdgcn_fence(__ATOMIC_ACQUIRE, "agent");
                asm volatile("s_waitcnt vmcnt(0)" ::: "memory");
            }
            __syncthreads();
        }
    }
    } if (G != 256) { GRID_SYNC(); } FRESH(); { LOADP();
    REP(8) {
        pg8::Gemm g{act, FF, nullptr};
        pg8::EpiBf16 E{yexp, DM};
        if (G == 256) {
            pg8::GroupedOrder S1{Loff, Ltile, Lend, LsmE, Ltile[NE] * 4, (Ltile[NE] + LsmE[63]) * 4, G, bid, (const char*)wd_t, (size_t)DM * FF * 2, (size_t)256 * FF * 2, 1};
            pg8::gemm_phase<pg8::EpiBf16, pg8::GroupedOrder, false, true>((PG8_LAS unsigned char*)lds_raw, g, S1, E);
            pg8::GroupedOrder S2{Loff, Ltile, Lend, LsmE, Ltile[NE] * 4, (Ltile[NE] + LsmE[63]) * 4, G, bid, (const char*)wd_t, (size_t)DM * FF * 2, (size_t)256 * FF * 2, 2};
            pg8::Unit u_;
            if (S2.next(0, u_)) {
                if (tid == 0) { const unsigned* hd = (const unsigned*)(ws + WS_CTL + 36864) + 64 * 32; const unsigned need = (unsigned)LsmE[63] * 4u;
                    for (unsigned spins = 0; spins < (1u << 22); ++spins) { if (__hip_atomic_load(hd, __ATOMIC_RELAXED, __HIP_MEMORY_SCOPE_AGENT) >= need) break; __builtin_amdgcn_s_sleep(8); }
                    __builtin_amdgcn_fence(__ATOMIC_ACQUIRE, "agent");
                    asm volatile("s_waitcnt vmcnt(0)" ::: "memory"); }
                __syncthreads();
                pg8::gemm_phase<pg8::EpiBf16, pg8::GroupedOrder, false, true>((PG8_LAS unsigned char*)lds_raw, g, S2, E);
            }
        } else {
            pg8::GroupedOrder S{Loff, Ltile, Lend, LsmE, Ltile[NE] * 4, (Ltile[NE] + LsmE[63]) * 4, G, bid, (const char*)wd_t, (size_t)DM * FF * 2, (size_t)256 * FF * 2, 0};
            pg8::gemm_phase<pg8::EpiBf16, pg8::GroupedOrder, false, true>((PG8_LAS unsigned char*)lds_raw, g, S, E);
        }
    }
    SEAM()
    {
        const int nmine = (NTOK - gw + NGW - 1) / NGW;
        const float4* fg = (const float4*)final_g + lane;
        float4 gfin[4];
#pragma unroll
        for (int j = 0; j < 4; ++j) gfin[j] = fg[64 * j];
        for (int k0 = 0; k0 < nmine; k0 += 16) {
            const int kk = k0 + (lane & 15), rr = gw + NGW * (kk < nmine ? kk : k0);
            const int2 sv = *(const int2*)(tok_p + 2 * rr); const float2 gv = *(const float2*)(tok_g + 2 * rr);
            for (int k = k0; k < nmine && k < k0 + 16; k += 4) {
                int rT[4]; bool has[4]; int s0[4], s1[4]; float g0[4], g1[4];
#pragma unroll
                for (int t = 0; t < 4; ++t) { has[t] = k + t < nmine; const int l_ = has[t] ? k + t - k0 : k - k0; rT[t] = gw + NGW * (has[t] ? k + t : k);
                    s0[t] = __shfl(sv.x, l_); s1[t] = __shfl(sv.y, l_); g0[t] = __shfl(gv.x, l_); g1[t] = __shfl(gv.y, l_); }
                float4 xv[4][4]; uint2 ya[4][4], yb[4][4];
#pragma unroll
                for (int t = 0; t < 4; ++t)
#pragma unroll
                    for (int j = 0; j < 4; ++j) { { const uint2 xr_ = ((const uint2*)(x1 + (size_t)rT[t] * DM) + lane)[64 * j]; xv[t][j] = make_float4(dn::lo_f(xr_.x), dn::hi_f(xr_.x), dn::lo_f(xr_.y), dn::hi_f(xr_.y)); } ya[t][j] = ((const uint2*)(yexp + (size_t)s0[t] * DM) + lane)[64 * j]; yb[t][j] = ((const uint2*)(yexp + (size_t)s1[t] * DM) + lane)[64 * j]; }
                float ssum[4];
#pragma unroll
                for (int t = 0; t < 4; ++t) { float a_ = 0.f;
#pragma unroll
                    for (int j = 0; j < 4; ++j) {
                        xv[t][j] = make_float4(xv[t][j].x + g0[t] * dn::lo_f(ya[t][j].x) + g1[t] * dn::lo_f(yb[t][j].x), xv[t][j].y + g0[t] * dn::hi_f(ya[t][j].x) + g1[t] * dn::hi_f(yb[t][j].x),
                                               xv[t][j].z + g0[t] * dn::lo_f(ya[t][j].y) + g1[t] * dn::lo_f(yb[t][j].y), xv[t][j].w + g0[t] * dn::hi_f(ya[t][j].y) + g1[t] * dn::hi_f(yb[t][j].y));
                        a_ += xv[t][j].x * xv[t][j].x + xv[t][j].y * xv[t][j].y + xv[t][j].z * xv[t][j].z + xv[t][j].w * xv[t][j].w; }
                    ssum[t] = a_; }
#pragma unroll
                for (int o = 1; o < 64; o <<= 1) {
#pragma unroll
                    for (int t = 0; t < 4; ++t) ssum[t] += __shfl_xor(ssum[t], o); }
#pragma unroll
                for (int t = 0; t < 4; ++t) { if (has[t]) { const float rs = rsqrtf(ssum[t] * (1.f / DM) + EPS); float4* od = (float4*)(outp + (size_t)rT[t] * DM) + lane;
#pragma unroll
                    for (int j = 0; j < 4; ++j) od[64 * j] = make_float4(xv[t][j].x * rs * gfin[j].x, xv[t][j].y * rs * gfin[j].y, xv[t][j].z * rs * gfin[j].z, xv[t][j].w * rs * gfin[j].w); } }
            }
        }
    }
    }
}

extern "C" void kernel_launch(void* const* d_in, const int* in_sizes, int n_in, void* d_out, int out_size, void* d_ws, size_t ws_size, hipStream_t stream) {
    static int grid_blocks = 0;
    if (!grid_blocks) {
        int dev = 0, cus = 0, per_cu = 0;
        (void)hipGetDevice(&dev);
        (void)hipDeviceGetAttribute(&cus, hipDeviceAttributeMultiprocessorCount, dev);
        (void)hipFuncSetAttribute((const void*)fwd_kernel, hipFuncAttributeMaxDynamicSharedMemorySize, LDS_BYTES);
        (void)hipOccupancyMaxActiveBlocksPerMultiprocessor(&per_cu, (const void*)fwd_kernel, NT, LDS_BYTES);
        if (per_cu < 1) per_cu = 1;
        if (per_cu > 1 && 2 * LDS_BYTES > 160 * 1024) per_cu = 1;
        grid_blocks = cus * per_cu;
        fprintf(stderr, "kernel_launch: cus %d per_cu %d grid %d ws_size %zu\n", cus, per_cu, grid_blocks, ws_size);
    }
    (void)hipMemsetAsync((char*)d_ws + WS_CTL, 0, CTL_ZERO_BYTES, stream);
    Params p{};
    for (int i = 0; i < 17; ++i) p.in[i] = (const float*)d_in[i];
    p.out = (float*)d_out; p.ws = (unsigned char*)d_ws;
    hipLaunchKernelGGL(fwd_kernel, dim3(grid_blocks), dim3(NT), LDS_BYTES, stream, p);
    hipError_t e = hipPeekAtLastError();
    if (e != hipSuccess) fprintf(stderr, "launch failed: %s (grid %d)\n", hipGetErrorString(e), grid_blocks);
}
```
